# Optimizing an MI355X kernel written in HIP

```python
import jax, jax.numpy as jnp
from jax import lax
import numpy as np

D_MODEL = 2048
BATCH = 4
SEQ = 2048
DEPTH = 1

HEAD_DIM = 64
SWA_HEADS = 16
SWA_KV_HEADS = 4
SWA_GROUP = SWA_HEADS // SWA_KV_HEADS
WINDOW = 128
DSA_HEADS = 16
IDX_HEADS = 16
IDX_DIM = 64
DSA_TOPK_MAX = 256
DSA_BLOCK = 128
SWA_Q_WIDTH = SWA_HEADS * HEAD_DIM
SWA_KV_WIDTH = SWA_KV_HEADS * HEAD_DIM
DSA_Q_WIDTH = DSA_HEADS * HEAD_DIM
IDX_Q_WIDTH = IDX_HEADS * IDX_DIM
IN_WIDTH = (SWA_Q_WIDTH + 2 * SWA_KV_WIDTH + DSA_Q_WIDTH + 2 * HEAD_DIM
            + IDX_Q_WIDTH + IDX_DIM + IDX_HEADS + 2 * D_MODEL)
N_ALIBI_HEADS = SWA_HEADS + DSA_HEADS
N_GROUPS = 4
EXPERTS_PER_GROUP = 8
N_EXPERTS = N_GROUPS * EXPERTS_PER_GROUP
EXPERT_TOP_K = 2
D_EXPERT = 512
RMS_EPS = 1e-6
NEG_INF = -1e30

kernel_name = "hybrid_swa_dsa_hmoe_block"


def rms_norm(x, g):
    xf = x.astype(jnp.float32)
    y = xf * lax.rsqrt(jnp.mean(xf * xf, axis=-1, keepdims=True) + RMS_EPS)
    return (y * g.astype(jnp.float32)).astype(x.dtype)


def alibi_slopes():
    i = jnp.arange(1, N_ALIBI_HEADS + 1, dtype=jnp.float32)
    return jnp.exp2(-8.0 * i / N_ALIBI_HEADS)


def swa_sink_attention(q, k, v, sinks, slopes, q_gain, k_gain):
    B, S = q.shape[0], q.shape[1]
    nb = S // WINDOW
    q = rms_norm(q, q_gain)
    k = rms_norm(k, k_gain)
    qb = q.reshape(B, nb, WINDOW, SWA_KV_HEADS, SWA_GROUP, HEAD_DIM)
    pad = jnp.zeros((B, WINDOW, SWA_KV_HEADS, HEAD_DIM), k.dtype)
    kp = jnp.concatenate([pad, k], axis=1)[:, :S]
    vp = jnp.concatenate([pad, v], axis=1)[:, :S]
    blk = (B, nb, WINDOW, SWA_KV_HEADS, HEAD_DIM)
    kw = jnp.concatenate([kp.reshape(blk), k.reshape(blk)], axis=2)
    vw = jnp.concatenate([vp.reshape(blk), v.reshape(blk)], axis=2)
    scale = HEAD_DIM ** -0.5
    s = jnp.einsum('bnqkgd,bnskd->bnkgqs', qb, kw).astype(jnp.float32) * scale
    rel = (jnp.arange(WINDOW)[:, None] + WINDOW - jnp.arange(2 * WINDOW)[None, :])
    kpos = jnp.arange(nb)[:, None] * WINDOW - WINDOW + jnp.arange(2 * WINDOW)[None, :]
    valid = ((rel >= 0) & (rel < WINDOW))[None] & (kpos >= 0)[:, None, :]
    sl = slopes.reshape(SWA_KV_HEADS, SWA_GROUP)[:, :, None, None]
    s = s - sl * rel.astype(jnp.float32)
    s = jnp.where(valid[None, :, None, None], s, NEG_INF)
    sink = sinks.astype(jnp.float32).reshape(SWA_KV_HEADS, SWA_GROUP)[None, None, :, :, None, None]
    m = jnp.maximum(jnp.max(s, axis=-1, keepdims=True), sink)
    e = jnp.exp(s - m)
    p = (e / (jnp.sum(e, axis=-1, keepdims=True) + jnp.exp(sink - m))).astype(v.dtype)
    o = jnp.einsum('bnkgqs,bnskd->bnqkgd', p, vw)
    return o.reshape(B, S, SWA_Q_WIDTH)


def dsa_attention(q, k, v, qi, ki, wi, slopes, q_gain, k_gain):
    B, S = q.shape[0], q.shape[1]
    topk = min(DSA_TOPK_MAX, S // 4)
    nb = S // DSA_BLOCK
    q = rms_norm(q, q_gain)
    k = rms_norm(k, k_gain)
    kif = ki.astype(jnp.float32)
    kpos = jnp.arange(S)
    scale = HEAD_DIM ** -0.5
    sl = slopes.astype(jnp.float32)[None, :, None, None]

    def to_blocks(a):
        return a.reshape((B, nb, DSA_BLOCK) + a.shape[2:]).swapaxes(0, 1)

    def block_fn(args):
        qb, qib, wib, start = args
        t = start + jnp.arange(DSA_BLOCK)
        logits = jnp.einsum('bqhd,bsd->bqhs', qib.astype(jnp.float32), kif) * IDX_DIM ** -0.5
        w = wib.astype(jnp.float32) * IDX_HEADS ** -0.5
        score = jnp.einsum('bqhs,bqh->bqs', jax.nn.relu(logits), w)
        causal = kpos[None, :] <= t[:, None]
        score = jnp.where(causal[None], score, -jnp.inf)
        _, idx = lax.top_k(score, topk)
        kg = jax.vmap(lambda kk, ii: kk[ii])(k, idx)
        vg = jax.vmap(lambda vv, ii: vv[ii])(v, idx)
        dist = t[None, :, None] - idx
        s = jnp.einsum('bqhd,bqkd->bhqk', qb, kg).astype(jnp.float32) * scale
        s = s - sl * dist[:, None].astype(jnp.float32)
        s = jnp.where((dist >= 0)[:, None], s, NEG_INF)
        p = jax.nn.softmax(s, axis=-1).astype(vg.dtype)
        return jnp.einsum('bhqk,bqkd->bqhd', p, vg)

    starts = jnp.arange(nb) * DSA_BLOCK
    o = lax.map(block_fn, (to_blocks(q), to_blocks(qi), to_blocks(wi), starts))
    return o.swapaxes(0, 1).reshape(B, S, DSA_Q_WIDTH)


def hybrid_mixer(h, slopes, w_in, swa_q_norm, swa_k_norm, swa_sinks, dsa_q_norm, dsa_k_norm,
                 w_branch_a, w_branch_b, w_out):
    B, S, _ = h.shape
    proj = h @ w_in
    sizes = [SWA_Q_WIDTH, SWA_KV_WIDTH, SWA_KV_WIDTH, DSA_Q_WIDTH, HEAD_DIM, HEAD_DIM,
             IDX_Q_WIDTH, IDX_DIM, IDX_HEADS, D_MODEL, D_MODEL]
    offs = np.cumsum(sizes)[:-1].tolist()
    qa, ka, va, qb, kb, vb, qi, ki, wi, ga, gb = jnp.split(proj, offs, axis=-1)
    oa = swa_sink_attention(qa.reshape(B, S, SWA_HEADS, HEAD_DIM),
                            ka.reshape(B, S, SWA_KV_HEADS, HEAD_DIM),
                            va.reshape(B, S, SWA_KV_HEADS, HEAD_DIM),
                            swa_sinks, slopes[:SWA_HEADS], swa_q_norm, swa_k_norm)
    ob = dsa_attention(qb.reshape(B, S, DSA_HEADS, HEAD_DIM), kb, vb,
                       qi.reshape(B, S, IDX_HEADS, IDX_DIM), ki, wi,
                       slopes[SWA_HEADS:], dsa_q_norm, dsa_k_norm)
    merged = jax.nn.sigmoid(ga) * (oa @ w_branch_a) + jax.nn.sigmoid(gb) * (ob @ w_branch_b)
    return merged @ w_out


def hier_moe(h, w_group, b_group, w_expert, b_expert, w_gate_up, w_up, w_down):
    B, S, D = h.shape
    hf = h.reshape(B * S, D)
    g_logits = (hf @ w_group).astype(jnp.float32) + b_group.astype(jnp.float32)
    g_prob = jax.nn.softmax(g_logits, axis=-1)
    g_idx = jnp.argmax(g_logits, axis=-1)
    p_g = jnp.take_along_axis(g_prob, g_idx[:, None], axis=1)[:, 0]
    e_logits = ((hf @ w_expert).astype(jnp.float32) + b_expert.astype(jnp.float32)
                ).reshape(-1, N_GROUPS, EXPERTS_PER_GROUP)
    e_sel = jnp.take_along_axis(e_logits, g_idx[:, None, None], axis=1)[:, 0]
    e_prob = jax.nn.softmax(e_sel, axis=-1)
    top_p, top_i = lax.top_k(e_prob, EXPERT_TOP_K)
    top_p = top_p / jnp.sum(top_p, axis=-1, keepdims=True)
    local = jnp.sum(jax.nn.one_hot(top_i, EXPERTS_PER_GROUP, dtype=jnp.float32) * top_p[..., None], axis=1)
    comb = (jax.nn.one_hot(g_idx, N_GROUPS, dtype=jnp.float32)[:, :, None]
            * (p_g[:, None] * local)[:, None, :]).astype(h.dtype)
    out = jnp.zeros_like(hf)
    for g in range(N_GROUPS):
        a = jnp.einsum('nd,edf->nef', hf, w_gate_up[g])
        u = jnp.einsum('nd,edf->nef', hf, w_up[g])
        act = jax.nn.silu(a) * u * comb[:, g, :, None]
        out = out + jnp.einsum('nef,efd->nd', act, w_down[g])
    return out.reshape(B, S, D)


def setup_inputs(seed: int = 0) -> dict:
    key = jax.random.key(seed)
    ks = jax.random.split(key, 24)
    f32 = jnp.float32
    L, D, F = DEPTH, D_MODEL, D_EXPERT

    def nrm(k, shape, scale):
        return jax.random.normal(k, shape, f32) * scale

    return {
        "x": nrm(ks[0], (BATCH, SEQ, D), 1.0),
        "c": nrm(ks[1], (BATCH, D), 1.0),
        "w_ada": nrm(ks[2], (L, D, 6 * D), 0.5 * D ** -0.5),
        "b_ada": nrm(ks[3], (L, 6 * D), 0.01),
        "ln1_g": 1.0 + nrm(ks[4], (L, D), 0.02),
        "w_in": nrm(ks[5], (L, D, IN_WIDTH), D ** -0.5),
        "swa_q_norm": 1.0 + nrm(ks[6], (L, HEAD_DIM), 0.02),
        "swa_k_norm": 1.0 + nrm(ks[7], (L, HEAD_DIM), 0.02),
        "swa_sinks": nrm(ks[8], (L, SWA_HEADS), 0.5),
        "dsa_q_norm": 1.0 + nrm(ks[9], (L, HEAD_DIM), 0.02),
        "dsa_k_norm": 1.0 + nrm(ks[10], (L, HEAD_DIM), 0.02),
        "w_branch_a": nrm(ks[11], (L, SWA_Q_WIDTH, D), SWA_Q_WIDTH ** -0.5),
        "w_branch_b": nrm(ks[12], (L, DSA_Q_WIDTH, D), DSA_Q_WIDTH ** -0.5),
        "w_out": nrm(ks[13], (L, D, D), D ** -0.5),
        "ln2_g": 1.0 + nrm(ks[14], (L, D), 0.02),
        "w_group": nrm(ks[15], (L, D, N_GROUPS), D ** -0.5),
        "b_group": nrm(ks[16], (L, N_GROUPS), 0.01),
        "w_expert": nrm(ks[17], (L, D, N_EXPERTS), D ** -0.5),
        "b_expert": nrm(ks[18], (L, N_EXPERTS), 0.01),
        "w_gate_up": nrm(ks[19], (L, N_GROUPS, EXPERTS_PER_GROUP, D, F), D ** -0.5),
        "w_up": nrm(ks[20], (L, N_GROUPS, EXPERTS_PER_GROUP, D, F), D ** -0.5),
        "w_down": nrm(ks[21], (L, N_GROUPS, EXPERTS_PER_GROUP, F, D), F ** -0.5),
    }


def reference(x, c, w_ada, b_ada, ln1_g, w_in, swa_q_norm, swa_k_norm, swa_sinks,
              dsa_q_norm, dsa_k_norm, w_branch_a, w_branch_b, w_out, ln2_g,
              w_group, b_group, w_expert, b_expert, w_gate_up, w_up, w_down):
    slopes = alibi_slopes()
    cond = jax.nn.silu(c)
    for l in range(DEPTH):
        mod = (cond @ w_ada[l] + b_ada[l])[:, None, :]
        sh1, sc1, gt1, sh2, sc2, gt2 = jnp.split(mod, 6, axis=-1)
        h = rms_norm(x, ln1_g[l]) * (1.0 + sc1) + sh1
        x = x + gt1 * hybrid_mixer(h, slopes, w_in[l], swa_q_norm[l], swa_k_norm[l], swa_sinks[l],
                                   dsa_q_norm[l], dsa_k_norm[l], w_branch_a[l], w_branch_b[l], w_out[l])
        h = rms_norm(x, ln2_g[l]) * (1.0 + sc2) + sh2
        x = x + gt2 * hier_moe(h, w_group[l], b_group[l], w_expert[l], b_expert[l],
                               w_gate_up[l], w_up[l], w_down[l])
    return x
```

```cpp
#include <hip/hip_runtime.h>
#include <cstdio>
#include <cstdint>

#ifndef MK_LAUNCH_PER_PHASE
#define MK_LAUNCH_PER_PHASE 0
#endif
#ifndef DBG_SKIP
#define DBG_SKIP 0
#endif

#define GAS __attribute__((address_space(1)))
#define LAS __attribute__((address_space(3)))
typedef unsigned short bf16;
typedef unsigned v4u __attribute__((ext_vector_type(4)));
typedef unsigned v2u __attribute__((ext_vector_type(2)));
typedef float f32x4 __attribute__((ext_vector_type(4)));
typedef float f32x16 __attribute__((ext_vector_type(16)));
typedef short bf16x8 __attribute__((ext_vector_type(8)));
typedef short s16x4 __attribute__((ext_vector_type(4)));
typedef GAS unsigned gu32;

constexpr int NB = 4, SEQ = 2048, DM = 2048, MTOK = NB * SEQ;
constexpr int NPROJ = 7888, NPROJP = 7936;
constexpr int C_QA = 0, C_KA = 1024, C_VA = 1280, C_QB = 1536, C_KB = 2560, C_VB = 2624, C_QI = 2688, C_KI = 3712, C_WI = 3776, C_GA = 3792, C_GB = 5840;
constexpr int NEXP = 32, DEXP = 512, ECAP = 8192, PADROWS = 24576;
constexpr float LOG2E = 1.4426950408889634f;
constexpr float RMS_EPS = 1e-6f;
constexpr float NEGBIG = -1e30f;

constexpr size_t MiB = 1u << 20;
constexpr size_t WS_CTL = 0, CTL_ZERO_BYTES = 1 * MiB;
constexpr size_t WS_MODP = 1 * MiB;
constexpr size_t WS_MODF = 2 * MiB;
constexpr size_t WS_CB   = 2 * MiB + 512 * 1024;
constexpr size_t WS_TOK  = 2 * MiB + 768 * 1024;
constexpr size_t WS_ROWTOK = 3 * MiB;
constexpr size_t WS_ROWW = 4 * MiB;
constexpr size_t WS_IDX  = 5 * MiB;
constexpr size_t WS_WTIN = 9 * MiB;
constexpr size_t WS_WTA  = 40 * MiB, WS_WTB = 44 * MiB, WS_WTO = 48 * MiB;
constexpr size_t WS_WTGU = 56 * MiB;
constexpr size_t WS_WTD  = 184 * MiB;
constexpr size_t WS_H    = 248 * MiB;
constexpr size_t WS_PROJ = 280 * MiB;
constexpr size_t WS_Y    = WS_PROJ;
constexpr size_t WS_OA   = 404 * MiB, WS_OB = 420 * MiB;
constexpr size_t WS_T    = 436 * MiB;
constexpr size_t WS_MRG  = 468 * MiB;
constexpr size_t WS_ACT  = 500 * MiB;
constexpr size_t WS_END  = 524 * MiB;
constexpr int CW_BAR = 4096;
constexpr int CW_ECNT = 16384;

constexpr int RING_BYTES = 131072;
constexpr int LDSCTL_OFF = RING_BYTES, MISC_OFF = LDSCTL_OFF + 320;
constexpr int MOE_TB_OFF = LDSCTL_OFF + 1024;
constexpr int MOE_NOFF = LDSCTL_OFF + 2048;
constexpr int LDS_BYTES = 147456;
constexpr int NWAVES = 8;

#define RLX_AGENT __ATOMIC_RELAXED, __HIP_MEMORY_SCOPE_AGENT
#define LDS_WAIT() asm volatile("s_waitcnt lgkmcnt(0)" ::: "memory")
#define VM_WAIT() asm volatile("s_waitcnt vmcnt(0)" ::: "memory")

__device__ __forceinline__ unsigned cvt_pk_bf16(float lo, float hi) { unsigned r; asm volatile("v_cvt_pk_bf16_f32 %0, %1, %2" : "=v"(r) : "v"(lo), "v"(hi)); return r; }
__device__ __forceinline__ float bflo(unsigned w) { return __uint_as_float(w << 16); }
__device__ __forceinline__ float bfhi(unsigned w) { return __uint_as_float(w & 0xffff0000u); }
__device__ __forceinline__ float fast_exp2(float x) { return __builtin_amdgcn_exp2f(x); }
__device__ __forceinline__ float fast_rcp(float x) { return __builtin_amdgcn_rcpf(x); }
__device__ __forceinline__ float sigmoidf_(float x) { return fast_rcp(1.f + fast_exp2(-x * LOG2E)); }
__device__ __forceinline__ float wave_sum(float v) {
#pragma unroll
    for (int o = 1; o < 64; o <<= 1) v += __shfl_xor(v, o);
    return v;
}
__device__ __forceinline__ s16x4 tr_read(LAS const unsigned char* p) {
    typedef short v4i16_t __attribute__((ext_vector_type(4)));
    return __builtin_bit_cast(s16x4, __builtin_amdgcn_ds_read_tr16_b64_v4i16((LAS v4i16_t*)p));
}
__device__ __forceinline__ int crow(int r, int hi) { return (r & 3) + 8 * (r >> 2) + 4 * hi; }

namespace pg8 {
typedef unsigned short bf16_t;
typedef unsigned u32x4 __attribute__((ext_vector_type(4)));
constexpr int BM = 256, BK = 64, HALF = 128, HTB = HALF * BK * 2, STAGE_BYTES = 8 * HTB, NXCD = 8, WGM = 8;
__host__ __device__ __forceinline__ int lds_byte(int r, int c) { const int st = (r >> 4) * 2 + (c >> 5), rr = r & 15, cc = c & 31, ob = rr * 64 + cc * 2; return st * 1024 + (ob ^ (((ob >> 9) & 1) << 5)); }
__host__ __device__ __forceinline__ void stage_rc(int b, int& R, int& C) { const int st = b / 1024, sb = b % 1024, swz = sb ^ (((sb >> 9) & 1) << 5); R = (st >> 1) * 16 + swz / 64; C = (st & 1) * 32 + (swz % 64) / 2; }
__host__ __device__ __forceinline__ int perm32(int rho) { const int n = rho >> 4, i = rho & 15; return 8 * (i >> 2) + 4 * n + (i & 3); }

struct Unit { int pm, pn, pb, ga; };
struct Gemm { const bf16_t* A0; const bf16_t* A1; const bf16_t* B0; const bf16_t* B1; int K; };

struct StaticOrder {
    static constexpr bool PAIR = false;
    int nM, nN, nwg, G, c;
    __device__ void init(int M, int N, int G_, int c_) { nM = M / BM; nN = N / BM; nwg = nM * nN; G = G_; c = c_; }
    __device__ bool next(int i, Unit& u) const {
        const long L = (long)i * G + c; if (L >= nwg) return false;
        int wgid = (int)L; { const int q = nwg / NXCD, r = nwg % NXCD, xcd = wgid % NXCD, off = wgid / NXCD; wgid = (xcd < r ? xcd * (q + 1) : r * (q + 1) + (xcd - r) * q) + off; }
        const int nig = WGM * nN, gid = wgid / nig, fm = gid * WGM, gsz = (nM - fm) < WGM ? (nM - fm) : WGM;
        u.pm = fm + ((wgid % nig) % gsz); u.pn = (wgid % nig) / gsz; u.pb = u.pn; u.ga = 0; return true;
    }
    __device__ __forceinline__ unsigned arow(const Unit&, int) const { return 0u; }
};
struct PairOrder {
    static constexpr bool PAIR = true;
    int nM, nN, nwg, G, c;
    __device__ void init(int M, int N, int G_, int c_) { nM = M / BM; nN = N / BM; nwg = nM * nN; G = G_; c = c_; }
    __device__ bool next(int i, Unit& u) const {
        const long L = (long)(i >> 1) * G + c; if (L >= nwg) return false;
        int wgid = (int)L; { const int q = nwg / NXCD, r = nwg % NXCD, xcd = wgid % NXCD, off = wgid / NXCD; wgid = (xcd < r ? xcd * (q + 1) : r * (q + 1) + (xcd - r) * q) + off; }
        const int nig = WGM * nN, gid = wgid / nig, fm = gid * WGM, gsz = (nM - fm) < WGM ? (nM - fm) : WGM;
        u.pm = fm + ((wgid % nig) % gsz); u.pn = (wgid % nig) / gsz; u.pb = u.pn; u.ga = i & 1; return true;
    }
    __device__ __forceinline__ unsigned arow(const Unit&, int) const { return 0u; }
};
struct MoeOrder {
    static constexpr bool PAIR = false;
    const LAS int* tb; const LAS int* cnt; const int* rowtok; int npn, G, c, total; bool gather;
    __device__ bool next(int i, Unit& u) const {
        const int L = i * G + c; if (L >= total) return false;
        const int tile = L / npn, pn = L - tile * npn; int e = 0;
#pragma unroll
        for (int j = 1; j < NEXP; ++j) e += (tile >= tb[j]) ? 1 : 0;
        u.pm = tile; u.pn = pn; u.pb = e * npn + pn; u.ga = e; return true;
    }
    __device__ __forceinline__ unsigned arow(const Unit& u, int r) const {
        const int e = u.ga, local = (u.pm - tb[e]) * 256 + r;
        return (local < cnt[e]) ? (unsigned)rowtok[e * ECAP + local] : 0u;
    }
};

template <class Epi, class Sched, bool ALIGN_EPI, bool GATHER>
__device__ __forceinline__ void gemm_phase(LAS unsigned char* lds, const Gemm g, const Sched& S, const Epi& E) {
    const int tid = threadIdx.x, wid = __builtin_amdgcn_readfirstlane(tid >> 6), lane = tid & 63, wr = wid >> 2, wc = wid & 3, fr = lane & 15, fq = lane >> 4;
    const int K = g.K, nt = K / BK;
    unsigned voffA[2], voffB[2]; int RA[2], CA[2];
#pragma unroll
    for (int i = 0; i < 2; ++i) { int R, C; stage_rc(tid * 16 + i * 8192, R, C); const int Rb = Epi::PERM ? ((R & ~31) + perm32(R & 31)) : R;
        RA[i] = R; CA[i] = C; voffA[i] = (unsigned)(R * K + C) * 2u; voffB[i] = (unsigned)(Rb * K + C) * 2u; }
    const size_t kstep = (size_t)(BK * 2);
    const size_t hstep = (size_t)HALF * K * 2;
    const size_t tstep = 2 * hstep;
    const unsigned ldsw = (unsigned)wid * 1024u;
    const int aoff = lds_byte(wr * 64 + fr, fq * 8), boff = lds_byte(wc * 32 + fr, fq * 8);
    LAS unsigned* noff = (LAS unsigned*)(lds + MOE_NOFF) + tid * 4;
#define PG8_SA(b, h) (((b) * 2 + (h)) * HTB)
#define PG8_SB(b, h) ((4 + (b) * 2 + (h)) * HTB)
#define PG8_STAGE(bufoff, gbase, voff) do { _Pragma("unroll") for (int _i = 0; _i < 2; ++_i) \
        __builtin_amdgcn_global_load_lds((const unsigned*)((const char*)(gbase) + (voff)[_i]), (LAS unsigned*)(lds + (bufoff) + ldsw + _i * 8192), 16, 0, 0); } while (0)
#define PG8_LDA(dst, b, h) do { _Pragma("unroll") for (int m = 0; m < 4; ++m) _Pragma("unroll") for (int k = 0; k < 2; ++k) dst[m][k] = *(const LAS bf16x8*)(lds + PG8_SA(b, h) + aoff + m * 2048 + k * 1024); } while (0)
#define PG8_LDB(dst, b, h) do { _Pragma("unroll") for (int n = 0; n < 2; ++n) _Pragma("unroll") for (int k = 0; k < 2; ++k) dst[n][k] = *(const LAS bf16x8*)(lds + PG8_SB(b, h) + boff + n * 2048 + k * 1024); } while (0)
#define PG8_MMA(ai, bj, At, Bt) do { __builtin_amdgcn_s_setprio(1); _Pragma("unroll") for (int m = 0; m < 4; ++m) _Pragma("unroll") for (int n = 0; n < 2; ++n) _Pragma("unroll") for (int k = 0; k < 2; ++k) \
        acc[ai][bj][m][n] = __builtin_amdgcn_mfma_f32_16x16x32_bf16(Bt[n][k], At[m][k], acc[ai][bj][m][n], 0, 0, 0); __builtin_amdgcn_s_setprio(0); } while (0)
#define PG8_WAIT_V(n) asm volatile("s_waitcnt vmcnt(" #n ")" ::: "memory")
#define PG8_WAIT_L(n) asm volatile("s_waitcnt lgkmcnt(" #n ")" ::: "memory")
#define PG8_BAR __builtin_amdgcn_s_barrier()
#define PG8_SCHED __builtin_amdgcn_sched_barrier(0)
    Unit cur, nxt; int ui = 0;
    if (!S.next(0, cur)) return;
    f32x4 acc[2][2][4][2];
#pragma unroll
    for (int a = 0; a < 2; ++a)
#pragma unroll
        for (int b = 0; b < 2; ++b)
#pragma unroll
            for (int m = 0; m < 4; ++m)
#pragma unroll
                for (int n = 0; n < 2; ++n) acc[a][b][m][n] = (f32x4){0.f, 0.f, 0.f, 0.f};
    bf16x8 At[4][2], B0[2][2], B1[2][2];
    unsigned cO0[2], cO1[2];
    const char* cA; const char* cB;
    if constexpr (GATHER) {
        cA = (const char*)g.A0;
#pragma unroll
        for (int i = 0; i < 2; ++i) { cO0[i] = S.arow(cur, RA[i]) * (unsigned)(K * 2) + (unsigned)CA[i] * 2u; cO1[i] = S.arow(cur, HALF + RA[i]) * (unsigned)(K * 2) + (unsigned)CA[i] * 2u; }
    } else {
        cA = (const char*)((Sched::PAIR && cur.ga) ? g.A1 : g.A0) + (size_t)cur.pm * tstep;
#pragma unroll
        for (int i = 0; i < 2; ++i) { cO0[i] = voffA[i]; cO1[i] = voffA[i] + (unsigned)hstep; }
    }
    cB = (const char*)((Sched::PAIR && cur.ga) ? g.B1 : g.B0) + (size_t)cur.pb * tstep;
    PG8_STAGE(PG8_SB(0, 0), cB, voffB); PG8_STAGE(PG8_SB(0, 1), cB + hstep, voffB); PG8_STAGE(PG8_SA(0, 0), cA, cO0); PG8_STAGE(PG8_SA(0, 1), cA, cO1);
    if (wr == 1) PG8_BAR;
    PG8_WAIT_V(2); PG8_BAR;
    PG8_STAGE(PG8_SB(1, 0), cB + kstep, voffB); PG8_STAGE(PG8_SA(1, 0), cA + kstep, cO0); PG8_STAGE(PG8_SB(1, 1), cB + hstep + kstep, voffB);
    PG8_WAIT_V(6); PG8_BAR;
    for (;;) {
        const bool has_next = S.next(ui + 1, nxt);
        const char* nA; const char* nB;
        if constexpr (GATHER) {
            nA = cA;
            if (has_next) {
                u32x4 o; o.x = S.arow(nxt, RA[0]) * (unsigned)(K * 2) + (unsigned)CA[0] * 2u; o.y = S.arow(nxt, RA[1]) * (unsigned)(K * 2) + (unsigned)CA[1] * 2u;
                o.z = S.arow(nxt, HALF + RA[0]) * (unsigned)(K * 2) + (unsigned)CA[0] * 2u; o.w = S.arow(nxt, HALF + RA[1]) * (unsigned)(K * 2) + (unsigned)CA[1] * 2u;
                *(LAS u32x4*)noff = o;
            } else { u32x4 o; o.x = cO0[0]; o.y = cO0[1]; o.z = cO1[0]; o.w = cO1[1]; *(LAS u32x4*)noff = o; }
        } else {
            nA = has_next ? (const char*)((Sched::PAIR && nxt.ga) ? g.A1 : g.A0) + (size_t)nxt.pm * tstep : cA;
        }
        nB = has_next ? (const char*)((Sched::PAIR && nxt.ga) ? g.B1 : g.B0) + (size_t)nxt.pb * tstep : cB;
        for (int t = 0; t < nt; t += 2) {
            const bool last = (t == nt - 2);
            const char* a1 = cA + (size_t)(t + 1) * kstep;
            const char* a2 = last ? nA : cA + (size_t)(t + 2) * kstep; const char* b2 = last ? nB : cB + (size_t)(t + 2) * kstep;
            const char* a3 = a2 + kstep; const char* b3 = b2 + kstep;
            unsigned sO0[2], sO1[2];
            if constexpr (GATHER) {
                if (last) { const u32x4 o = *(const LAS u32x4*)noff; sO0[0] = o.x; sO0[1] = o.y; sO1[0] = o.z; sO1[1] = o.w; }
                else { sO0[0] = cO0[0]; sO0[1] = cO0[1]; sO1[0] = cO1[0]; sO1[1] = cO1[1]; }
            } else { sO0[0] = cO0[0]; sO0[1] = cO0[1]; sO1[0] = cO1[0]; sO1[1] = cO1[1]; }
            PG8_LDB(B0, 0, 0); PG8_LDB(B1, 0, 1); PG8_SCHED; PG8_LDA(At, 0, 0); PG8_STAGE(PG8_SA(1, 1), a1, cO1);
            PG8_WAIT_V(8); PG8_WAIT_L(0); PG8_BAR; PG8_MMA(0, 0, At, B0); PG8_MMA(0, 1, At, B1); PG8_BAR; PG8_SCHED;
            PG8_LDA(At, 0, 1); PG8_STAGE(PG8_SB(0, 0), b2, voffB); PG8_STAGE(PG8_SB(0, 1), b2 + hstep, voffB); PG8_STAGE(PG8_SA(0, 0), a2, sO0);
            PG8_WAIT_V(8); PG8_WAIT_L(0); PG8_BAR; PG8_MMA(1, 0, At, B0); PG8_MMA(1, 1, At, B1); PG8_BAR; PG8_SCHED;
            PG8_LDB(B0, 1, 0); PG8_LDB(B1, 1, 1); PG8_SCHED; PG8_LDA(At, 1, 0); PG8_STAGE(PG8_SA(0, 1), a2, sO1);
            PG8_WAIT_V(8); PG8_WAIT_L(0); PG8_BAR; PG8_MMA(0, 0, At, B0); PG8_MMA(0, 1, At, B1); PG8_BAR; PG8_SCHED;
            PG8_LDA(At, 1, 1); PG8_STAGE(PG8_SB(1, 0), b3, voffB); PG8_STAGE(PG8_SB(1, 1), b3 + hstep, voffB); PG8_STAGE(PG8_SA(1, 0), a3, sO0);
            PG8_WAIT_V(8); PG8_WAIT_L(0); PG8_BAR; PG8_MMA(1, 0, At, B0); PG8_MMA(1, 1, At, B1); PG8_BAR; PG8_SCHED;
        }
        if constexpr (ALIGN_EPI) { if (wr == 0) PG8_BAR; }
        E(acc, cur, wr, wc, fr, fq);
        if (!has_next) break;
#pragma unroll
        for (int a = 0; a < 2; ++a)
#pragma unroll
            for (int b = 0; b < 2; ++b)
#pragma unroll
                for (int m = 0; m < 4; ++m)
#pragma unroll
                    for (int n = 0; n < 2; ++n) acc[a][b][m][n] = (f32x4){0.f, 0.f, 0.f, 0.f};
        cur = nxt; cA = nA; cB = nB; ++ui;
        if constexpr (GATHER) { const u32x4 o = *(const LAS u32x4*)noff; cO0[0] = o.x; cO0[1] = o.y; cO1[0] = o.z; cO1[1] = o.w; }
        if constexpr (ALIGN_EPI) { if (wr == 1) PG8_BAR; }
    }
    PG8_WAIT_V(0);
    if constexpr (!ALIGN_EPI) { if (wr == 0) PG8_BAR; }
    PG8_BAR;
#undef PG8_SA
#undef PG8_SB
#undef PG8_STAGE
#undef PG8_LDA
#undef PG8_LDB
#undef PG8_MMA
#undef PG8_WAIT_V
#undef PG8_WAIT_L
#undef PG8_BAR
#undef PG8_SCHED
}

struct EpiStore {
    static constexpr bool PERM = true;
    bf16_t* O; int ldc;
    __device__ __forceinline__ void operator()(const f32x4 (&acc)[2][2][4][2], const Unit& u, int wr, int wc, int fr, int fq) const {
        const int row0 = u.pm * BM + wr * 64 + fr, col0 = u.pn * BM + wc * 32 + 8 * fq;
#pragma unroll
        for (int ai = 0; ai < 2; ++ai)
#pragma unroll
            for (int m = 0; m < 4; ++m) { bf16_t* rowp = O + (size_t)(row0 + ai * HALF + m * 16) * ldc + col0;
#pragma unroll
                for (int bj = 0; bj < 2; ++bj) { const f32x4 v0 = acc[ai][bj][m][0], v1 = acc[ai][bj][m][1];
                    u32x4 w; w.x = cvt_pk_bf16(v0[0], v0[1]); w.y = cvt_pk_bf16(v0[2], v0[3]); w.z = cvt_pk_bf16(v1[0], v1[1]); w.w = cvt_pk_bf16(v1[2], v1[3]);
                    *(u32x4*)(rowp + bj * HALF) = w; } }
    }
};
struct EpiGate {
    static constexpr bool PERM = true;
    const bf16_t* proj; bf16_t* T; bf16_t* mrg;
    __device__ __forceinline__ void operator()(const f32x4 (&acc)[2][2][4][2], const Unit& u, int wr, int wc, int fr, int fq) const {
        const int row0 = u.pm * BM + wr * 64 + fr, col0 = u.pn * BM + wc * 32 + 8 * fq;
        const int gcol = (u.ga ? C_GB : C_GA) + col0;
#pragma unroll
        for (int ai = 0; ai < 2; ++ai)
#pragma unroll
            for (int m = 0; m < 4; ++m) { const size_t row = (size_t)(row0 + ai * HALF + m * 16);
#pragma unroll
                for (int bj = 0; bj < 2; ++bj) { const f32x4 v0 = acc[ai][bj][m][0], v1 = acc[ai][bj][m][1];
                    const u32x4 gt = *(const u32x4*)(proj + row * NPROJP + gcol + bj * HALF);
                    float r[8];
                    r[0] = v0[0] * sigmoidf_(bflo(gt.x)); r[1] = v0[1] * sigmoidf_(bfhi(gt.x)); r[2] = v0[2] * sigmoidf_(bflo(gt.y)); r[3] = v0[3] * sigmoidf_(bfhi(gt.y));
                    r[4] = v1[0] * sigmoidf_(bflo(gt.z)); r[5] = v1[1] * sigmoidf_(bfhi(gt.z)); r[6] = v1[2] * sigmoidf_(bflo(gt.w)); r[7] = v1[3] * sigmoidf_(bfhi(gt.w));
                    bf16_t* tp = T + row * DM + col0 + bj * HALF;
                    if (u.ga) { const u32x4 tv = *(const u32x4*)tp;
                        r[0] += bflo(tv.x); r[1] += bfhi(tv.x); r[2] += bflo(tv.y); r[3] += bfhi(tv.y); r[4] += bflo(tv.z); r[5] += bfhi(tv.z); r[6] += bflo(tv.w); r[7] += bfhi(tv.w); }
                    u32x4 w; w.x = cvt_pk_bf16(r[0], r[1]); w.y = cvt_pk_bf16(r[2], r[3]); w.z = cvt_pk_bf16(r[4], r[5]); w.w = cvt_pk_bf16(r[6], r[7]);
                    *(u32x4*)((u.ga ? mrg : T) + row * DM + col0 + bj * HALF) = w; } }
    }
};
struct EpiOut {
    static constexpr bool PERM = true;
    const float* x; const float* modf; float* out;
    __device__ __forceinline__ void operator()(const f32x4 (&acc)[2][2][4][2], const Unit& u, int wr, int wc, int fr, int fq) const {
        const int row0 = u.pm * BM + wr * 64 + fr, col0 = u.pn * BM + wc * 32 + 8 * fq;
        const int b = (u.pm * BM) >> 11;
        f32x4 gv[2][2];
#pragma unroll
        for (int bj = 0; bj < 2; ++bj)
#pragma unroll
            for (int n = 0; n < 2; ++n) gv[bj][n] = *(const f32x4*)(modf + b * 12288 + 4096 + col0 + bj * HALF + 4 * n);
#pragma unroll
        for (int ai = 0; ai < 2; ++ai)
#pragma unroll
            for (int m = 0; m < 4; ++m) { const size_t off = (size_t)(row0 + ai * HALF + m * 16) * DM + col0;
#pragma unroll
                for (int bj = 0; bj < 2; ++bj)
#pragma unroll
                    for (int n = 0; n < 2; ++n) { const f32x4 xv = *(const f32x4*)(x + off + bj * HALF + 4 * n);
                        *(f32x4*)(out + off + bj * HALF + 4 * n) = xv + gv[bj][n] * acc[ai][bj][m][n]; } }
    }
};
struct EpiMoeGU {
    static constexpr bool PERM = true;
    bf16_t* act; const float* roww; const LAS int* tb; const LAS int* cnt;
    __device__ __forceinline__ void operator()(const f32x4 (&acc)[2][2][4][2], const Unit& u, int wr, int wc, int fr, int fq) const {
        const int e = u.ga, lbase = (u.pm - tb[e]) * 256, n_e = cnt[e];
        const int r0 = wr * 64 + fr, col0 = u.pn * HALF + wc * 32 + 8 * fq;
#pragma unroll
        for (int ai = 0; ai < 2; ++ai)
#pragma unroll
            for (int m = 0; m < 4; ++m) { const int r = r0 + ai * HALF + m * 16; const int local = lbase + r;
                const float w = (local < n_e) ? roww[e * ECAP + local] : 0.f;
                float o[8];
#pragma unroll
                for (int n = 0; n < 2; ++n)
#pragma unroll
                    for (int j = 0; j < 4; ++j) { const float gte = acc[ai][0][m][n][j], up = acc[ai][1][m][n][j]; o[4 * n + j] = gte * sigmoidf_(gte) * up * w; }
                u32x4 wv; wv.x = cvt_pk_bf16(o[0], o[1]); wv.y = cvt_pk_bf16(o[2], o[3]); wv.z = cvt_pk_bf16(o[4], o[5]); wv.w = cvt_pk_bf16(o[6], o[7]);
                *(u32x4*)(act + (size_t)(u.pm * 256 + r) * DEXP + col0) = wv; }
    }
};
}

#define XB_TMO      128
#define XB_XCNT(j)  (256  + 64 * (j))
#define XB_XSUB(j)  (1280 + 64 * (j))
#define XB_XGEN(j)  (2304 + 64 * (j))
#define XB_TOP      3328
#define XB_TOPGEN   3392
#define XCD_BAR_WORDS 3456
#define XB_SPIN_CAP (1u << 18)
__device__ __forceinline__ unsigned xb_ld(unsigned* p)              { return __hip_atomic_load(p, __ATOMIC_RELAXED, __HIP_MEMORY_SCOPE_AGENT); }
__device__ __forceinline__ unsigned xb_add(unsigned* p, unsigned v) { return __hip_atomic_fetch_add(p, v, __ATOMIC_RELAXED, __HIP_MEMORY_SCOPE_AGENT); }
__device__ __forceinline__ unsigned xb_xcc_id() { return (unsigned)__builtin_amdgcn_s_getreg((3 << 11) | 20) & 0xFu; }
#define XB_SPIN(cond, bar) do { unsigned _sp = 0; while (cond) { __builtin_amdgcn_s_sleep(1); \
    if ((++_sp & 255u) == 0u) { if (xb_ld(&(bar)[XB_TMO])) break; if (_sp > XB_SPIN_CAP) { atomicAdd(&(bar)[XB_TMO], 1u); break; } } } } while (0)
struct XcdBarrier { unsigned* bar; unsigned x; volatile LAS unsigned* st; };
__device__ __forceinline__ XcdBarrier xcd_barrier_post(unsigned* bar, volatile LAS unsigned* st) {
    XcdBarrier b; b.bar = bar; b.x = xb_xcc_id(); b.st = st;
    if (threadIdx.x == 0) (void)xb_add(&bar[XB_XCNT(b.x)], 1u);
    return b;
}
__device__ __forceinline__ void xcd_barrier_complete(unsigned* bar, unsigned x, unsigned& nloc, unsigned& nx) {
    const unsigned G = gridDim.x * gridDim.y * gridDim.z;
    unsigned sum, cnt, mine, sp = 0u;
    for (;;) {
        sum = 0u; cnt = 0u; mine = 0u;
#pragma unroll
        for (unsigned j = 0; j < 16; ++j) { const unsigned c = xb_ld(&bar[XB_XCNT(j)]); sum += c; cnt += (c > 0u) ? 1u : 0u; mine = (j == x) ? c : mine; }
        if (sum == G) break;
        __builtin_amdgcn_s_sleep(1);
        if ((++sp & 255u) == 0u) { if (xb_ld(&bar[XB_TMO])) break; if (sp > XB_SPIN_CAP) { atomicAdd(&bar[XB_TMO], 1u); break; } }
    }
    nloc = mine > 0u ? mine : 1u; nx = cnt > 0u ? cnt : 1u;
}
__device__ __forceinline__ void xcd_barrier(const XcdBarrier& b) {
    asm volatile("s_waitcnt vmcnt(0)" ::: "memory");
    __syncthreads();
    if (threadIdx.x == 0) {
        unsigned* bar = b.bar;
        __builtin_amdgcn_s_waitcnt(0);
        unsigned nloc = b.st[0], nx = b.st[1];
        if (nloc == 0u) { xcd_barrier_complete(bar, b.x, nloc, nx); b.st[0] = nloc; b.st[1] = nx; }
        const unsigned old = xb_add(&bar[XB_XSUB(b.x)], 1u);
        const unsigned gen = old / nloc;
        if (old + 1u == (gen + 1u) * nloc) {
            __builtin_amdgcn_fence(__ATOMIC_RELEASE, "agent");
            asm volatile("s_waitcnt vmcnt(0)" ::: "memory");
            const unsigned og = xb_add(&bar[XB_TOP], 1u);
            const unsigned tg = og / nx;
            if (og + 1u == (tg + 1u) * nx) xb_add(&bar[XB_TOPGEN], 1u);
            else XB_SPIN(xb_ld(&bar[XB_TOPGEN]) == tg, bar);
            __builtin_amdgcn_fence(__ATOMIC_ACQUIRE, "agent");
            xb_add(&bar[XB_XGEN(b.x)], 1u);
            asm volatile("s_waitcnt vmcnt(0)" ::: "memory");
        } else {
            XB_SPIN(xb_ld(&bar[XB_XGEN(b.x)]) == gen, bar);
            __builtin_amdgcn_fence(__ATOMIC_ACQUIRE, "agent");
            asm volatile("s_waitcnt vmcnt(0)" ::: "memory");
        }
    }
    __syncthreads();
}

struct Args { const float* in[22]; float* out; unsigned char* ws; int ph_lo, ph_hi; };
enum { I_X = 0, I_C, I_WADA, I_BADA, I_LN1G, I_WIN, I_SWAQN, I_SWAKN, I_SINKS, I_DSAQN, I_DSAKN, I_WBA, I_WBB, I_WOUT, I_LN2G, I_WGRP, I_BGRP, I_WEXP, I_BEXP, I_WGU, I_WUP, I_WDN };

__device__ __forceinline__ void p0_adaln_item(const Args& a, LAS unsigned char* lds, int j, int tid) {
    LAS float* condl = (LAS float*)lds;
    LAS float* red = (LAS float*)(lds + 8192);
    const int cr = j & 63, kq = j >> 6;
    const float* cin = a.in[I_C];
    for (int i = tid; i < 2048; i += 512) { const int kk = i >> 2, b = i & 3; const float c = cin[b * 2048 + kq * 512 + kk]; condl[kk * 4 + b] = c * fast_rcp(1.f + __expf(-c)); }
    __syncthreads();
    if (tid < 480) {
        const int cg = tid % 48, ks = tid / 48;
        const float* wp = a.in[I_WADA] + (size_t)(kq * 512) * 12288 + cr * 192 + cg * 4;
        f32x4 acc[4];
#pragma unroll
        for (int b = 0; b < 4; ++b) acc[b] = (f32x4){0.f, 0.f, 0.f, 0.f};
#pragma unroll 4
        for (int kk = ks; kk < 512; kk += 10) {
            const f32x4 w = *(const f32x4*)(wp + (size_t)kk * 12288);
            const f32x4 c = *(const LAS f32x4*)(condl + kk * 4);
            acc[0] += c.x * w; acc[1] += c.y * w; acc[2] += c.z * w; acc[3] += c.w * w;
        }
#pragma unroll
        for (int b = 0; b < 4; ++b) *(LAS f32x4*)(red + (ks * 4 + b) * 192 + cg * 4) = acc[b];
    }
    __syncthreads();
    float* modp = (float*)(a.ws + WS_MODP);
    for (int o = tid; o < 768; o += 512) { const int b = o / 192, col = o % 192; float s = 0.f;
#pragma unroll
        for (int ks = 0; ks < 10; ++ks) s += red[(ks * 4 + b) * 192 + col];
        modp[(kq * 4 + b) * 12288 + cr * 192 + col] = s; }
    __syncthreads();
}
__device__ __forceinline__ void tr_item(const float* W, int N, int Nvalid, int K, bf16* WT, int drow0, int k0, int n0, LAS float* scr, int lane) {
    const bool ok = (n0 + (lane & 31)) < Nvalid;
#pragma unroll 8
    for (int i = 0; i < 32; ++i) { const int kk = 2 * i + (lane >> 5); scr[kk * 33 + (lane & 31)] = ok ? W[(size_t)(k0 + kk) * N + n0 + (lane & 31)] : 0.f; }
    LDS_WAIT(); asm volatile("" ::: "memory");
    const int c = lane & 7;
#pragma unroll
    for (int j = 0; j < 4; ++j) { const int n = (lane >> 3) + 8 * j; const LAS float* s = scr + (8 * c) * 33 + n;
        v4u o; o.x = cvt_pk_bf16(s[0 * 33], s[1 * 33]); o.y = cvt_pk_bf16(s[2 * 33], s[3 * 33]); o.z = cvt_pk_bf16(s[4 * 33], s[5 * 33]); o.w = cvt_pk_bf16(s[6 * 33], s[7 * 33]);
        *(v4u*)(WT + (size_t)(drow0 + n) * K + k0 + 8 * c) = o; }
    LDS_WAIT(); asm volatile("" ::: "memory");
}
__device__ __forceinline__ void p0_prologue(const Args& a, LAS unsigned char* lds, int vcu, int G, int tid, int lane, int wave) {
    for (int j = vcu; j < 256; j += G) p0_adaln_item(a, lds, j, tid);
    LAS float* scr = (LAS float*)(lds + wave * 16384);
    const int gw = vcu * NWAVES + wave, NGW = G * NWAVES;
    constexpr int I_IN = 32 * 248, I_BR = 16 * 64, I_OUT = 32 * 64, I_GU = 32 * 16, I_DN = 8 * 64;
    constexpr int NITEMS = I_IN + 2 * I_BR + I_OUT + NEXP * (2 * I_GU + I_DN);
    unsigned char* ws = a.ws;
    for (int it = gw; it < NITEMS; it += NGW) {
        int r = it;
        if (r < I_IN) { const int kb = r / 248, nb = r % 248; tr_item(a.in[I_WIN], NPROJ, NPROJ, 2048, (bf16*)(ws + WS_WTIN), 32 * nb, 64 * kb, 32 * nb, scr, lane); continue; } r -= I_IN;
        if (r < I_BR) { const int kb = r / 64, nb = r % 64; tr_item(a.in[I_WBA], 2048, 2048, 1024, (bf16*)(ws + WS_WTA), 32 * nb, 64 * kb, 32 * nb, scr, lane); continue; } r -= I_BR;
        if (r < I_BR) { const int kb = r / 64, nb = r % 64; tr_item(a.in[I_WBB], 2048, 2048, 1024, (bf16*)(ws + WS_WTB), 32 * nb, 64 * kb, 32 * nb, scr, lane); continue; } r -= I_BR;
        if (r < I_OUT) { const int kb = r / 64, nb = r % 64; tr_item(a.in[I_WOUT], 2048, 2048, 2048, (bf16*)(ws + WS_WTO), 32 * nb, 64 * kb, 32 * nb, scr, lane); continue; } r -= I_OUT;
        const int e = r / (2 * I_GU + I_DN); r -= e * (2 * I_GU + I_DN);
        if (r < 2 * I_GU) {
            const int which = r / I_GU; r -= which * I_GU; const int kb = r / 16, nb = r % 16, n0 = 32 * nb;
            const float* W = (which ? a.in[I_WUP] : a.in[I_WGU]) + (size_t)e * 2048 * 512;
            tr_item(W, 512, 512, 2048, (bf16*)(ws + WS_WTGU) + (size_t)e * 1024 * 2048, (n0 >> 7) * 256 + which * 128 + (n0 & 127), 64 * kb, n0, scr, lane); continue; }
        r -= 2 * I_GU;
        { const int kb = r / 64, nb = r % 64; tr_item(a.in[I_WDN] + (size_t)e * 512 * 2048, 2048, 2048, 512, (bf16*)(ws + WS_WTD) + (size_t)e * 2048 * 512, 32 * nb, 64 * kb, 32 * nb, scr, lane); }
    }
}

__device__ __forceinline__ float modval(const float* modp, const float* bada, int b, int n) {
    return ((modp[(0 * 4 + b) * 12288 + n] + modp[(1 * 4 + b) * 12288 + n]) + (modp[(2 * 4 + b) * 12288 + n] + modp[(3 * 4 + b) * 12288 + n])) + bada[n];
}
__device__ __forceinline__ void p1_norm1(const Args& a, LAS unsigned char* lds, int vcu, int G, int tid, int lane, int wave) {
    const float* modp = (const float*)(a.ws + WS_MODP); const float* bada = a.in[I_BADA];
    float* modf = (float*)(a.ws + WS_MODF);
    LAS float* A4 = (LAS float*)lds; LAS float* B4 = A4 + 8192;
    const float* g1 = a.in[I_LN1G];
    for (int i = tid; i < 8192; i += 512) { const int b = i >> 11, k = i & 2047; A4[i] = g1[k] * (1.f + modval(modp, bada, b, 2048 + k)); B4[i] = modval(modp, bada, b, k); }
    for (int i = vcu * 512 + tid; i < 4 * 12288; i += G * 512) { const int b = i / 12288, n = i % 12288; modf[i] = modval(modp, bada, b, n); }
    const int gw = vcu * NWAVES + wave, NGW = G * NWAVES;
    for (int id = gw; id < 144; id += NGW) { const int b = id / 36, j = id % 36; float s = 0.f;
        for (int k = lane; k < 2048; k += 64) { const float sh = modval(modp, bada, b, 6144 + k); const float w = (j < 32) ? a.in[I_WEXP][k * 32 + j] : a.in[I_WGRP][k * 4 + (j - 32)]; s += sh * w; }
        s = wave_sum(s);
        if (lane == 0) ((float*)(a.ws + WS_CB))[b * 36 + j] = s + ((j < 32) ? a.in[I_BEXP][j] : a.in[I_BGRP][j - 32]); }
    __syncthreads();
    const float* x = a.in[I_X]; bf16* H = (bf16*)(a.ws + WS_H);
    for (int m = gw; m < MTOK; m += NGW) {
        const int b = m >> 11;
        const f32x4* xr = (const f32x4*)(x + (size_t)m * DM) + lane;
        f32x4 v[8]; float s = 0.f;
#pragma unroll
        for (int j = 0; j < 8; ++j) { v[j] = xr[64 * j]; s += (v[j].x * v[j].x + v[j].y * v[j].y) + (v[j].z * v[j].z + v[j].w * v[j].w); }
        const float rstd = 1.f / sqrtf(wave_sum(s) * (1.f / DM) + RMS_EPS);
        unsigned long long* o8 = (unsigned long long*)(H + (size_t)m * DM) + lane;
#pragma unroll
        for (int j = 0; j < 8; ++j) { const int k = 4 * lane + 256 * j; const f32x4 A = *(const LAS f32x4*)(A4 + b * 2048 + k), Bv = *(const LAS f32x4*)(B4 + b * 2048 + k);
            const f32x4 y = v[j] * rstd * A + Bv;
            o8[64 * j] = (unsigned long long)cvt_pk_bf16(y.x, y.y) | ((unsigned long long)cvt_pk_bf16(y.z, y.w) << 32); }
    }
}

__device__ __forceinline__ void prep_norms(const Args& a, int vcu, int G, int lane, int wave) {
    bf16* proj = (bf16*)(a.ws + WS_PROJ);
    const int gw = vcu * NWAVES + wave, NGW = G * NWAVES;
    const int sub = lane & 7, grp = lane >> 3;
    const float qs = 0.125f * LOG2E;
    for (int m = gw; m < MTOK; m += NGW) {
#pragma unroll
        for (int s = 0; s < 5; ++s) {
            const int hv = 8 * s + grp;
            if (hv < 37) {
                const int col = (hv < 20) ? 64 * hv : 256 + 64 * hv;
                const float* gain = (hv < 16) ? a.in[I_SWAQN] : (hv < 20) ? a.in[I_SWAKN] : (hv < 36) ? a.in[I_DSAQN] : a.in[I_DSAKN];
                const float sc = (hv < 16 || (hv >= 20 && hv < 36)) ? qs : 1.f;
                bf16* p = proj + (size_t)m * NPROJP + col + sub * 8;
                const v4u w = *(const v4u*)p;
                float f[8] = {bflo(w.x), bfhi(w.x), bflo(w.y), bfhi(w.y), bflo(w.z), bfhi(w.z), bflo(w.w), bfhi(w.w)};
                float ss = 0.f;
#pragma unroll
                for (int i = 0; i < 8; ++i) ss += f[i] * f[i];
                ss += __shfl_xor(ss, 1); ss += __shfl_xor(ss, 2); ss += __shfl_xor(ss, 4);
                const float r = sc / sqrtf(ss * (1.f / 64.f) + RMS_EPS);
                const f32x4 g0 = *(const f32x4*)(gain + sub * 8), g1 = *(const f32x4*)(gain + sub * 8 + 4);
                v4u o; o.x = cvt_pk_bf16(f[0] * r * g0.x, f[1] * r * g0.y); o.y = cvt_pk_bf16(f[2] * r * g0.z, f[3] * r * g0.w);
                o.z = cvt_pk_bf16(f[4] * r * g1.x, f[5] * r * g1.y); o.w = cvt_pk_bf16(f[6] * r * g1.z, f[7] * r * g1.w);
                *(v4u*)p = o;
            }
        }
    }
}
__device__ __forceinline__ unsigned f2key(float f) { const unsigned u = __float_as_uint(f); return (u & 0x80000000u) ? ~u : (u | 0x80000000u); }
__device__ __forceinline__ unsigned half_sum(unsigned v) {
    v += (unsigned)__builtin_amdgcn_update_dpp(0, (int)v, 0xB1, 0xF, 0xF, false);
    v += (unsigned)__builtin_amdgcn_update_dpp(0, (int)v, 0x4E, 0xF, 0xF, false);
    v += (unsigned)__builtin_amdgcn_update_dpp(0, (int)v, 0x141, 0xF, 0xF, false);
    v += (unsigned)__builtin_amdgcn_update_dpp(0, (int)v, 0x140, 0xF, 0xF, false);
    v += (unsigned)__builtin_amdgcn_ds_swizzle((int)v, 0x401F);
    return v;
}
constexpr int IX_KBUF = 36864;
constexpr int IX_LST = 2 * IX_KBUF;
__device__ __forceinline__ void indexer_unit(const bf16* proj, unsigned short* idxo, LAS unsigned char* lds, int u, int tid, int lane, int wave) {
    const int b = u >> 7, q0 = (u & 127) << 4;
    const int r32 = lane & 31, hi = lane >> 5;
    const int tq = q0 + 2 * wave + hi;
    const int NT = (q0 + 47) >> 5, NC = (NT + 7) >> 3;
    bf16x8 aq[4]; float wv[16];
    {
        const int sel = (r32 >> 2) & 1, head = (r32 & 3) + 4 * (r32 >> 3);
        const bf16* qrow = proj + (size_t)(b * SEQ + q0 + 2 * wave + sel) * NPROJP + C_QI + head * 64 + hi * 8;
#pragma unroll
        for (int ks = 0; ks < 4; ++ks) aq[ks] = *(const bf16x8*)(qrow + 16 * ks);
        const bf16* wrow = proj + (size_t)(b * SEQ + tq) * NPROJP + C_WI;
        const v4u w0 = *(const v4u*)wrow, w1 = *(const v4u*)(wrow + 8);
        const float c = 0.25f * 0.125f;
        wv[0] = bflo(w0.x) * c; wv[1] = bfhi(w0.x) * c; wv[2] = bflo(w0.y) * c; wv[3] = bfhi(w0.y) * c; wv[4] = bflo(w0.z) * c; wv[5] = bfhi(w0.z) * c; wv[6] = bflo(w0.w) * c; wv[7] = bfhi(w0.w) * c;
        wv[8] = bflo(w1.x) * c; wv[9] = bfhi(w1.x) * c; wv[10] = bflo(w1.y) * c; wv[11] = bfhi(w1.y) * c; wv[12] = bflo(w1.z) * c; wv[13] = bfhi(w1.z) * c; wv[14] = bflo(w1.w) * c; wv[15] = bfhi(w1.w) * c;
    }
    unsigned key[64];
    const bf16* kibase = proj + (size_t)(b * SEQ) * NPROJP + C_KI;
    v4u st[4];
#define IX_LOAD(c) do { _Pragma("unroll") for (int i = 0; i < 4; ++i) { const int p = tid + 512 * i; st[i] = *(const v4u*)(kibase + (size_t)(256 * (c) + (p >> 3)) * NPROJP + (p & 7) * 8); } } while (0)
#define IX_WRITE(buf) do { _Pragma("unroll") for (int i = 0; i < 4; ++i) { const int p = tid + 512 * i; *(LAS v4u*)(lds + (buf) * IX_KBUF + (p >> 3) * 144 + (p & 7) * 16) = st[i]; } } while (0)
    IX_LOAD(0); IX_WRITE(0);
    __syncthreads();
#pragma unroll
    for (int c = 0; c < 8; ++c) {
        if (c < NC) {
            if (c + 1 < NC) IX_LOAD(c + 1);
#pragma unroll
            for (int tt = 0; tt < 8; ++tt) {
                const int T = 8 * c + tt;
                if (T < NT) {
                    LAS const unsigned char* kb = lds + (c & 1) * IX_KBUF + (32 * tt + r32) * 144 + 16 * hi;
                    f32x16 C = {};
#pragma unroll
                    for (int ks = 0; ks < 4; ++ks) { const bf16x8 bk = *(const LAS bf16x8*)(kb + 32 * ks); C = __builtin_amdgcn_mfma_f32_32x32x16_bf16(aq[ks], bk, C, 0, 0, 0); }
                    float sc = 0.f;
#pragma unroll
                    for (int r = 0; r < 16; ++r) sc += fmaxf(C[r], 0.f) * wv[r];
                    unsigned kk = f2key(sc); kk = kk < 1u ? 1u : kk;
                    key[T] = ((32 * T + r32) <= tq) ? kk : 0u;
                } else key[T] = 0u;
            }
            if (c + 1 < NC) IX_WRITE((c + 1) & 1);
            __syncthreads();
        } else {
#pragma unroll
            for (int tt = 0; tt < 8; ++tt) key[8 * c + tt] = 0u;
        }
    }
#undef IX_LOAD
#undef IX_WRITE
    unsigned T = 0u, need = 0u, cgt = 0u;
    const bool small = (q0 + 2 * wave + 1) < 256;
    if (!small) {
        unsigned prefix = 0u; bool done = false;
        for (int bit = 31; bit >= 0; --bit) {
            const unsigned cand = prefix | (1u << bit);
            unsigned cnt = 0u;
#pragma unroll
            for (int r = 0; r < 64; ++r) cnt += (key[r] >= cand) ? 1u : 0u;
            cnt = half_sum(cnt);
            const bool take = !done && cnt >= 256u;
            prefix = take ? cand : prefix;
            done = done || (take && cnt == 256u);
            if (__all(done)) break;
        }
        if (done) { T = prefix - 1u; need = 0u; cgt = 256u; }
        else {
            T = prefix; unsigned cnt = 0u;
#pragma unroll
            for (int r = 0; r < 64; ++r) cnt += (key[r] > T) ? 1u : 0u;
            cgt = half_sum(cnt); need = 256u - cgt;
        }
    }
    LAS unsigned char* lst = lds + IX_LST + wave * 1024;
    *(LAS v4u*)(lst + lane * 16) = (v4u){0xFFFFFFFFu, 0xFFFFFFFFu, 0xFFFFFFFFu, 0xFFFFFFFFu};
    LDS_WAIT();
    LAS unsigned short* lq = (LAS unsigned short*)(lst + hi * 512);
    unsigned base_gt = 0u, base_eq = 0u;
#pragma unroll
    for (int r = 0; r < 64; ++r) {
        const bool gt = key[r] > T, eq = key[r] == T;
        const unsigned long long mg = __ballot(gt), me = __ballot(eq);
        const unsigned mgh = hi ? (unsigned)(mg >> 32) : (unsigned)mg, meh = hi ? (unsigned)(me >> 32) : (unsigned)me;
        const unsigned below = (1u << r32) - 1u;
        const unsigned rg = __popc(mgh & below), re = __popc(meh & below);
        if (gt) lq[base_gt + rg] = (unsigned short)(32 * r + r32);
        if (eq && (base_eq + re) < need) lq[cgt + base_eq + re] = (unsigned short)(32 * r + r32);
        base_gt += __popc(mgh); base_eq += __popc(meh);
    }
    LDS_WAIT();
    const v4u lo = *(const LAS v4u*)(lst + lane * 16);
    *(v4u*)(idxo + ((size_t)(b * SEQ + q0 + 2 * wave + hi)) * 256 + r32 * 8) = lo;
    __syncthreads();
}

constexpr int SW_V = 36864, SW_WS = SW_V + 32768;
__device__ __forceinline__ void swa_unit(const bf16* proj, bf16* oa, const float* sinks, LAS unsigned char* lds, int u, int tid, int lane, int wave) {
    const int b = u >> 6, nblk = (u >> 2) & 15, kvh = u & 3;
    const int r32 = lane & 31, hi = lane >> 5;
#pragma unroll
    for (int i = 0; i < 4; ++i) {
        const int p = tid + 512 * i, kw = p >> 3, part = p & 7; const int spos = 128 * (nblk - 1) + kw;
        if (spos >= 0) {
            const bf16* src = proj + (size_t)(b * SEQ + spos) * NPROJP;
            const v4u kv = *(const v4u*)(src + C_KA + kvh * 64 + part * 8), vv = *(const v4u*)(src + C_VA + kvh * 64 + part * 8);
            *(LAS v4u*)(lds + kw * 144 + part * 16) = kv;
            *(LAS v4u*)(lds + SW_V + (part >> 2) * 16384 + kw * 64 + (part & 3) * 16) = vv;
        }
    }
    __syncthreads();
    const int hq = kvh * 4 + (wave >> 1);
    const float sink2 = sinks[hq] * LOG2E, slope2 = exp2f(-(float)(hq + 1) * 0.25f) * LOG2E;
    LAS float* wsf = (LAS float*)(lds + SW_WS) + wave * 32;
#pragma unroll 1
    for (int qq = 0; qq < 2; ++qq) {
        const int qt = 2 * (wave & 1) + qq, t0 = 128 * nblk + 32 * qt;
        const bf16* qrow = proj + (size_t)(b * SEQ + t0 + r32) * NPROJP + C_QA + hq * 64 + hi * 8;
        bf16x8 qr[4];
#pragma unroll
        for (int d0 = 0; d0 < 4; ++d0) qr[d0] = *(const bf16x8*)(qrow + 16 * d0);
        float mx = sink2;
        const int jlo = (nblk == 0) ? ((4 - qt) > 0 ? (4 - qt) : 0) : 0;
#pragma unroll 1
        for (int j = jlo; j < 5; ++j) {
            const int kt = qt + j;
            LAS const unsigned char* kb = lds + (32 * kt + r32) * 144 + 16 * hi;
            f32x16 C = {};
#pragma unroll
            for (int d0 = 0; d0 < 4; ++d0) { const bf16x8 kf = *(const LAS bf16x8*)(kb + 32 * d0); C = __builtin_amdgcn_mfma_f32_32x32x16_bf16(kf, qr[d0], C, 0, 0, 0); }
#pragma unroll
            for (int r = 0; r < 16; ++r) { const int rel = (128 + 32 * qt + r32) - (32 * kt + crow(r, hi));
                const float v = (rel >= 0 && rel < 128) ? C[r] - slope2 * (float)rel : NEGBIG; mx = fmaxf(mx, v); }
        }
        mx = fmaxf(mx, __shfl_xor(mx, 32));
        float lsum = 0.f;
        f32x16 o[2]; o[0] = (f32x16){}; o[1] = (f32x16){};
#pragma unroll 1
        for (int j = jlo; j < 5; ++j) {
            const int kt = qt + j;
            LAS const unsigned char* kb = lds + (32 * kt + r32) * 144 + 16 * hi;
            f32x16 C = {};
#pragma unroll
            for (int d0 = 0; d0 < 4; ++d0) { const bf16x8 kf = *(const LAS bf16x8*)(kb + 32 * d0); C = __builtin_amdgcn_mfma_f32_32x32x16_bf16(kf, qr[d0], C, 0, 0, 0); }
#pragma unroll
            for (int r = 0; r < 16; ++r) { const int rel = (128 + 32 * qt + r32) - (32 * kt + crow(r, hi));
                const float v = (rel >= 0 && rel < 128) ? C[r] - slope2 * (float)rel : NEGBIG; const float p = fast_exp2(v - mx); C[r] = p; lsum += p; }
#pragma unroll
            for (int ks = 0; ks < 2; ++ks) {
                v4u pw; pw.x = cvt_pk_bf16(C[8 * ks + 0], C[8 * ks + 1]); pw.y = cvt_pk_bf16(C[8 * ks + 2], C[8 * ks + 3]);
                pw.z = cvt_pk_bf16(C[8 * ks + 4], C[8 * ks + 5]); pw.w = cvt_pk_bf16(C[8 * ks + 6], C[8 * ks + 7]);
                const bf16x8 pa = __builtin_bit_cast(bf16x8, pw);
#pragma unroll
                for (int d0 = 0; d0 < 2; ++d0) {
                    LAS const unsigned char* vp = lds + SW_V + d0 * 16384 + (32 * kt + 16 * ks + 4 * hi + ((lane & 15) >> 2)) * 64 + ((lane >> 4) & 1) * 32 + (lane & 3) * 8;
                    const s16x4 vl = tr_read(vp), vh = tr_read(vp + 512);
                    const bf16x8 vf = (bf16x8){vl[0], vl[1], vl[2], vl[3], vh[0], vh[1], vh[2], vh[3]};
                    o[d0] = __builtin_amdgcn_mfma_f32_32x32x16_bf16(pa, vf, o[d0], 0, 0, 0);
                }
            }
        }
        lsum += __shfl_xor(lsum, 32); lsum += fast_exp2(sink2 - mx);
        if (hi == 0) wsf[r32] = fast_rcp(lsum);
        LDS_WAIT();
        bf16* orow = oa + (size_t)(b * SEQ + t0) * 1024 + hq * 64 + r32;
#pragma unroll
        for (int r = 0; r < 16; ++r) { const int q = crow(r, hi); const float rl = wsf[q];
            const unsigned w0 = cvt_pk_bf16(o[0][r] * rl, 0.f), w1 = cvt_pk_bf16(o[1][r] * rl, 0.f);
            orow[(size_t)q * 1024] = (bf16)(w0 & 0xffffu); orow[(size_t)q * 1024 + 32] = (bf16)(w1 & 0xffffu); }
        LDS_WAIT();
    }
    __syncthreads();
}

constexpr int DS_WAVE = 10240 + 512;
__device__ __forceinline__ void dsa_query(const bf16* proj, const unsigned short* idx, bf16* ob, LAS unsigned char* wl, int b, int t, int lane) {
    const int i16 = lane & 15, g = lane >> 4;
    const int nsel = (t + 1) < 256 ? (t + 1) : 256;
    LAS unsigned char* lst = wl + 10240;
    { const v2u li = *(const v2u*)(idx + ((size_t)(b * SEQ + t)) * 256 + lane * 4); *(LAS v2u*)(lst + lane * 8) = li; }
    const bf16* qrow = proj + (size_t)(b * SEQ + t) * NPROJP + C_QB + i16 * 64 + 8 * g;
    const bf16x8 qf0 = *(const bf16x8*)qrow, qf1 = *(const bf16x8*)(qrow + 32);
    const float slope2 = exp2f(-(float)(17 + i16) * 0.25f) * LOG2E;
    const bf16* pb = proj + (size_t)(b * SEQ) * NPROJP;
    LDS_WAIT();
    LAS const unsigned short* l16 = (LAS const unsigned short*)lst;
    f32x4 s[16]; float mx = NEGBIG;
#pragma unroll
    for (int T = 0; T < 16; ++T) {
        const int pos = 16 * T + i16; int kidx = l16[pos]; kidx = (pos < nsel) ? kidx : 0;
        const bf16* krow = pb + (size_t)kidx * NPROJP + C_KB + 8 * g;
        const bf16x8 kf0 = *(const bf16x8*)krow, kf1 = *(const bf16x8*)(krow + 32);
        f32x4 c = {0.f, 0.f, 0.f, 0.f};
        c = __builtin_amdgcn_mfma_f32_16x16x32_bf16(kf0, qf0, c, 0, 0, 0);
        c = __builtin_amdgcn_mfma_f32_16x16x32_bf16(kf1, qf1, c, 0, 0, 0);
        const v2u i4 = *(const LAS v2u*)(lst + (16 * T + 4 * g) * 2);
        const int id0 = i4.x & 0xffff, id1 = i4.x >> 16, id2 = i4.y & 0xffff, id3 = i4.y >> 16;
        const int p0 = 16 * T + 4 * g;
        c[0] = (p0 + 0 < nsel) ? c[0] - slope2 * (float)(t - id0) : NEGBIG;
        c[1] = (p0 + 1 < nsel) ? c[1] - slope2 * (float)(t - id1) : NEGBIG;
        c[2] = (p0 + 2 < nsel) ? c[2] - slope2 * (float)(t - id2) : NEGBIG;
        c[3] = (p0 + 3 < nsel) ? c[3] - slope2 * (float)(t - id3) : NEGBIG;
        s[T] = c; mx = fmaxf(fmaxf(mx, fmaxf(c[0], c[1])), fmaxf(c[2], c[3]));
    }
    mx = fmaxf(mx, __shfl_xor(mx, 16)); mx = fmaxf(mx, __shfl_xor(mx, 32));
    float lsum = 0.f;
#pragma unroll
    for (int T = 0; T < 16; ++T)
#pragma unroll
        for (int r = 0; r < 4; ++r) { const float p = fast_exp2(s[T][r] - mx); s[T][r] = p; lsum += p; }
    lsum += __shfl_xor(lsum, 16); lsum += __shfl_xor(lsum, 32);
    f32x4 o[4];
#pragma unroll
    for (int dt = 0; dt < 4; ++dt) o[dt] = (f32x4){0.f, 0.f, 0.f, 0.f};
#pragma unroll
    for (int c = 0; c < 4; ++c) {
        v4u vv[8];
#pragma unroll
        for (int i = 0; i < 8; ++i) { const int pos = 64 * c + 8 * i + (lane >> 3); int vidx = l16[pos]; vidx = (pos < nsel) ? vidx : 0;
            vv[i] = *(const v4u*)(pb + (size_t)vidx * NPROJP + C_VB + (lane & 7) * 8); }
#pragma unroll
        for (int i = 0; i < 8; ++i) *(LAS v4u*)(wl + (8 * i + (lane >> 3)) * 160 + (lane & 7) * 16) = vv[i];
        LDS_WAIT();
#pragma unroll
        for (int s2 = 0; s2 < 2; ++s2) {
            const int ks = 2 * c + s2;
            v4u pw; pw.x = cvt_pk_bf16(s[2 * ks][0], s[2 * ks][1]); pw.y = cvt_pk_bf16(s[2 * ks][2], s[2 * ks][3]);
            pw.z = cvt_pk_bf16(s[2 * ks + 1][0], s[2 * ks + 1][1]); pw.w = cvt_pk_bf16(s[2 * ks + 1][2], s[2 * ks + 1][3]);
            const bf16x8 pbv = __builtin_bit_cast(bf16x8, pw);
#pragma unroll
            for (int dt = 0; dt < 4; ++dt) {
                LAS const unsigned char* vp = wl + (32 * s2 + 4 * g + (i16 >> 2)) * 160 + (16 * dt + 4 * (i16 & 3)) * 2;
                const s16x4 vl = tr_read(vp), vh = tr_read(vp + 16 * 160);
                const bf16x8 vf = (bf16x8){vl[0], vl[1], vl[2], vl[3], vh[0], vh[1], vh[2], vh[3]};
                o[dt] = __builtin_amdgcn_mfma_f32_16x16x32_bf16(vf, pbv, o[dt], 0, 0, 0);
            }
        }
        LDS_WAIT();
    }
    const float rl = fast_rcp(lsum);
    bf16* orow = ob + (size_t)(b * SEQ + t) * 1024 + i16 * 64 + 4 * g;
#pragma unroll
    for (int dt = 0; dt < 4; ++dt) { v2u w; w.x = cvt_pk_bf16(o[dt][0] * rl, o[dt][1] * rl); w.y = cvt_pk_bf16(o[dt][2] * rl, o[dt][3] * rl); *(v2u*)(orow + 16 * dt) = w; }
}

constexpr int RT_W = 0, RT_F = 73728, RT_RS = RT_F + 2048, RT_LG = RT_RS + 128;
__device__ __forceinline__ void router_unit(const Args& a, LAS unsigned char* lds, int u, int tid, int lane, int wave) {
    const float* x2 = a.out; const float* modf = (const float*)(a.ws + WS_MODF); const float* g2 = a.in[I_LN2G];
    bf16* H2 = (bf16*)(a.ws + WS_H);
    const int row0 = u * 32, b = row0 >> 11;
    LAS float* rs = (LAS float*)(lds + RT_RS);
#pragma unroll 1
    for (int i = 0; i < 4; ++i) {
        const int m = row0 + 4 * wave + i;
        const f32x4* xr = (const f32x4*)(x2 + (size_t)m * DM) + lane;
        f32x4 v[8]; float s = 0.f;
#pragma unroll
        for (int j = 0; j < 8; ++j) { v[j] = xr[64 * j]; s += (v[j].x * v[j].x + v[j].y * v[j].y) + (v[j].z * v[j].z + v[j].w * v[j].w); }
        const float rstd = 1.f / sqrtf(wave_sum(s) * (1.f / DM) + RMS_EPS);
        if (lane == 0) rs[4 * wave + i] = rstd;
        unsigned long long* o8 = (unsigned long long*)(H2 + (size_t)m * DM) + lane;
#pragma unroll
        for (int j = 0; j < 8; ++j) { const int k = 4 * lane + 256 * j;
            const f32x4 gk = *(const f32x4*)(g2 + k), sc = *(const f32x4*)(modf + b * 12288 + 8192 + k), sh = *(const f32x4*)(modf + b * 12288 + 6144 + k);
            const f32x4 y = v[j] * rstd * gk * (sc + 1.f) + sh;
            o8[64 * j] = (unsigned long long)cvt_pk_bf16(y.x, y.y) | ((unsigned long long)cvt_pk_bf16(y.z, y.w) << 32); }
    }
    const int tk = tid & 31, sl = tid >> 5;
    float acc[36];
#pragma unroll
    for (int j = 0; j < 36; ++j) acc[j] = 0.f;
    LAS float* Wl = (LAS float*)(lds + RT_W); LAS float* fl = (LAS float*)(lds + RT_F);
#pragma unroll 1
    for (int ch = 0; ch < 4; ++ch) {
        __syncthreads();
        for (int i = tid; i < 512 * 8; i += 512) { const int kk = i >> 3, part = i & 7; *(LAS f32x4*)(Wl + kk * 36 + part * 4) = *(const f32x4*)(a.in[I_WEXP] + (size_t)(ch * 512 + kk) * 32 + part * 4); }
        { const int kk = tid; *(LAS f32x4*)(Wl + kk * 36 + 32) = *(const f32x4*)(a.in[I_WGRP] + (size_t)(ch * 512 + kk) * 4);
          fl[kk] = g2[ch * 512 + kk] * (1.f + modf[b * 12288 + 8192 + ch * 512 + kk]); }
        __syncthreads();
        const float* xp = x2 + (size_t)(row0 + tk) * DM + ch * 512 + sl * 32;
#pragma unroll 2
        for (int i4 = 0; i4 < 8; ++i4) {
            const f32x4 xv = *(const f32x4*)(xp + 4 * i4);
#pragma unroll
            for (int e = 0; e < 4; ++e) {
                const int kk = sl * 32 + 4 * i4 + e; const float xs = xv[e] * fl[kk];
                const LAS f32x4* wr = (const LAS f32x4*)(Wl + kk * 36);
#pragma unroll
                for (int q = 0; q < 9; ++q) { const f32x4 w = wr[q]; acc[4 * q] += xs * w.x; acc[4 * q + 1] += xs * w.y; acc[4 * q + 2] += xs * w.z; acc[4 * q + 3] += xs * w.w; }
            }
        }
    }
    __syncthreads();
    LAS float* red = (LAS float*)(lds + RT_W);
#pragma unroll
    for (int j = 0; j < 36; ++j) red[(sl * 32 + tk) * 37 + j] = acc[j];
    __syncthreads();
    LAS float* lg = (LAS float*)(lds + RT_LG);
    const float* cb = (const float*)(a.ws + WS_CB);
    for (int o = tid; o < 32 * 36; o += 512) { const int t2 = o / 36, j = o % 36; float s = 0.f;
#pragma unroll
        for (int q = 0; q < 16; ++q) s += red[(q * 32 + t2) * 37 + j];
        lg[t2 * 36 + j] = s * rs[t2] + cb[b * 36 + j]; }
    __syncthreads();
    if (tid < 32) {
        const LAS float* l = lg + tid * 36;
        int gi = 0; float gm = l[32];
#pragma unroll
        for (int j = 1; j < 4; ++j) if (l[32 + j] > gm) { gm = l[32 + j]; gi = j; }
        float gs = 0.f;
#pragma unroll
        for (int j = 0; j < 4; ++j) gs += __expf(l[32 + j] - gm);
        const float pg = 1.f / gs;
        float e[8];
#pragma unroll
        for (int j = 0; j < 8; ++j) e[j] = (gi == 0) ? l[j] : (gi == 1) ? l[8 + j] : (gi == 2) ? l[16 + j] : l[24 + j];
        int i1 = 0; float m1 = e[0];
#pragma unroll
        for (int j = 1; j < 8; ++j) if (e[j] > m1) { m1 = e[j]; i1 = j; }
        int i2 = -1; float m2 = -3.0e38f;
#pragma unroll
        for (int j = 0; j < 8; ++j) if (j != i1 && e[j] > m2) { m2 = e[j]; i2 = j; }
        const float p2 = __expf(m2 - m1), inv = 1.f / (1.f + p2);
        const float c1 = pg * inv, c2 = pg * p2 * inv;
        const int e1 = gi * 8 + i1, e2 = gi * 8 + i2, m = row0 + tid;
        unsigned* ecnt = (unsigned*)(a.ws + WS_CTL) + CW_ECNT;
        const int pos1 = (int)atomicAdd(ecnt + e1, 1u), pos2 = (int)atomicAdd(ecnt + e2, 1u);
        int* rowtok = (int*)(a.ws + WS_ROWTOK); float* roww = (float*)(a.ws + WS_ROWW);
        rowtok[e1 * ECAP + pos1] = m; roww[e1 * ECAP + pos1] = c1;
        rowtok[e2 * ECAP + pos2] = m; roww[e2 * ECAP + pos2] = c2;
        int* tokinfo = (int*)(a.ws + WS_TOK) + m * 4;
        tokinfo[0] = e1; tokinfo[1] = pos1; tokinfo[2] = e2; tokinfo[3] = pos2;
    }
    __syncthreads();
}
__device__ __forceinline__ void moe_table(const Args& a, LAS unsigned char* lds, int tid) {
    LAS int* tb = (LAS int*)(lds + MOE_TB_OFF); LAS int* cn = tb + 40;
    if (tid == 0) {
        const unsigned* ecnt = (const unsigned*)(a.ws + WS_CTL) + CW_ECNT; int acc = 0;
        for (int e = 0; e < NEXP; ++e) { const int c = (int)__hip_atomic_load(ecnt + e, RLX_AGENT); tb[e] = acc; cn[e] = c; acc += (c + 255) >> 8; }
        tb[NEXP] = acc;
    }
    __syncthreads();
}

constexpr int NPHASE = 11;
__global__ void __launch_bounds__(NWAVES * 64, 2) mk_fwd(Args args) {
    extern __shared__ __attribute__((aligned(16))) unsigned char lds_raw[];
    LAS unsigned char* lds = (LAS unsigned char*)lds_raw;
    volatile LAS unsigned* MISC = (volatile LAS unsigned*)(lds + MISC_OFF);
    const int tid = threadIdx.x, lane = tid & 63, wave = __builtin_amdgcn_readfirstlane(tid >> 6);
    const int G = gridDim.x; const int bx = blockIdx.x; const int vcu = (G % 8 == 0) ? (bx % 8) * (G / 8) + bx / 8 : bx;
    unsigned char* ws = args.ws;
    gu32* ctl = (gu32*)(ws + WS_CTL);
    for (int u = tid; u < (LDS_BYTES - LDSCTL_OFF) / 4; u += NWAVES * 64) ((LAS unsigned*)(lds + LDSCTL_OFF))[u] = 0u;
    __syncthreads();
    XcdBarrier bar; bar.bar = (unsigned*)ctl + CW_BAR; bar.x = 0; bar.st = nullptr;
    if (!MK_LAUNCH_PER_PHASE) bar = xcd_barrier_post((unsigned*)ctl + CW_BAR, MISC + 8);
    const int lo = args.ph_lo, hi = args.ph_hi;
#ifndef PH_MASK
#define PH_MASK 0x7ff
#endif
#define IN(k) (((PH_MASK >> (k)) & 1) && lo <= (k) && (k) < hi)
#define SEAM(k) do { if (IN(k) && IN((k) + 1)) { if (!MK_LAUNCH_PER_PHASE) xcd_barrier(bar); } } while (0)
    bf16* PROJ = (bf16*)(ws + WS_PROJ);

    if (IN(0)) { p0_prologue(args, lds, vcu, G, tid, lane, wave); }
    SEAM(0);
    if (IN(1)) { p1_norm1(args, lds, vcu, G, tid, lane, wave); }
    SEAM(1);
    if (IN(2)) {
        pg8::Gemm g{(const bf16*)(ws + WS_H), nullptr, (const bf16*)(ws + WS_WTIN), nullptr, DM};
        pg8::StaticOrder S; S.init(MTOK, NPROJP, G, bx);
        pg8::EpiStore E{PROJ, NPROJP};
        pg8::gemm_phase<pg8::EpiStore, pg8::StaticOrder, true, false>(lds, g, S, E);
    }
    SEAM(2);
    if (IN(3)) {
        prep_norms(args, vcu, G, lane, wave);
        if (!(DBG_SKIP & 2)) {
            unsigned short* idxo = (unsigned short*)(ws + WS_IDX);
            for (int i = vcu; i < 512; i += G) { const int u = (i < 256) ? i : 767 - i;
                indexer_unit(PROJ, idxo, lds, (u & 3) * 128 + (u >> 2), tid, lane, wave); }
        }
    }
    SEAM(3);
    if (IN(4)) {
        bf16* OA = (bf16*)(ws + WS_OA); bf16* OB = (bf16*)(ws + WS_OB);
        if (!(DBG_SKIP & 1)) { for (int u = vcu; u < 256; u += G) swa_unit(PROJ, OA, args.in[I_SINKS], lds, u, tid, lane, wave); }
        else { for (size_t i = (size_t)bx * 512 + tid; i < (size_t)MTOK * 1024 / 8; i += (size_t)G * 512) ((v4u*)OA)[i] = (v4u){0u, 0u, 0u, 0u}; }
        if (!(DBG_SKIP & 2)) {
            const unsigned short* idx = (const unsigned short*)(ws + WS_IDX);
            LAS unsigned char* wl = lds + wave * DS_WAVE;
            const int gw = vcu * NWAVES + wave, NGW = G * NWAVES;
            for (int q = gw; q < MTOK; q += NGW) { const int qq = (q & 1) ? (MTOK - 1 - (q >> 1)) : (q >> 1); dsa_query(PROJ, idx, OB, wl, qq >> 11, qq & 2047, lane); }
        } else { for (size_t i = (size_t)bx * 512 + tid; i < (size_t)MTOK * 1024 / 8; i += (size_t)G * 512) ((v4u*)OB)[i] = (v4u){0u, 0u, 0u, 0u}; }
        __syncthreads();
    }
    SEAM(4);
    if (IN(5)) {
        pg8::Gemm g{(const bf16*)(ws + WS_OA), (const bf16*)(ws + WS_OB), (const bf16*)(ws + WS_WTA), (const bf16*)(ws + WS_WTB), 1024};
        pg8::PairOrder S; S.init(MTOK, DM, G, bx);
        pg8::EpiGate E{PROJ, (bf16*)(ws + WS_T), (bf16*)(ws + WS_MRG)};
        pg8::gemm_phase<pg8::EpiGate, pg8::PairOrder, true, false>(lds, g, S, E);
    }
    SEAM(5);
    if (IN(6)) {
        pg8::Gemm g{(const bf16*)(ws + WS_MRG), nullptr, (const bf16*)(ws + WS_WTO), nullptr, DM};
        pg8::StaticOrder S; S.init(MTOK, DM, G, bx);
        pg8::EpiOut E{args.in[I_X], (const float*)(ws + WS_MODF), args.out};
        pg8::gemm_phase<pg8::EpiOut, pg8::StaticOrder, true, false>(lds, g, S, E);
    }
    SEAM(6);
    if (IN(7)) { if (!(DBG_SKIP & 4)) for (int u = vcu; u < 256; u += G) router_unit(args, lds, u, tid, lane, wave); }
    SEAM(7);
    if (IN(8)) { if (!(DBG_SKIP & 4)) {
        moe_table(args, lds, tid);
        const LAS int* tb = (const LAS int*)(lds + MOE_TB_OFF); const LAS int* cn = tb + 40;
        pg8::Gemm g{(const bf16*)(ws + WS_H), nullptr, (const bf16*)(ws + WS_WTGU), nullptr, DM};
        pg8::MoeOrder S{tb, cn, (const int*)(ws + WS_ROWTOK), 4, G, bx, tb[NEXP] * 4, true};
        pg8::EpiMoeGU E{(bf16*)(ws + WS_ACT), (const float*)(ws + WS_ROWW), tb, cn};
        pg8::gemm_phase<pg8::EpiMoeGU, pg8::MoeOrder, true, true>(lds, g, S, E);
    } }
    SEAM(8);
    if (IN(9)) { if (!(DBG_SKIP & 4)) {
        moe_table(args, lds, tid);
        const LAS int* tb = (const LAS int*)(lds + MOE_TB_OFF); const LAS int* cn = tb + 40;
        pg8::Gemm g{(const bf16*)(ws + WS_ACT), nullptr, (const bf16*)(ws + WS_WTD), nullptr, DEXP};
        pg8::MoeOrder S{tb, cn, (const int*)(ws + WS_ROWTOK), 8, G, bx, tb[NEXP] * 8, false};
        pg8::EpiStore E{(bf16*)(ws + WS_Y), DM};
        pg8::gemm_phase<pg8::EpiStore, pg8::MoeOrder, true, false>(lds, g, S, E);
    } }
    SEAM(9);
    if (IN(10)) { if (!(DBG_SKIP & 4)) {
        moe_table(args, lds, tid);
        const LAS int* tb = (const LAS int*)(lds + MOE_TB_OFF);
        const int gw = vcu * NWAVES + wave, NGW = G * NWAVES;
        const float* modf = (const float*)(ws + WS_MODF); const bf16* Y = (const bf16*)(ws + WS_Y);
        for (int m = gw; m < MTOK; m += NGW) {
            const int b = m >> 11; const int* ti = (const int*)(ws + WS_TOK) + m * 4;
            const size_t r1 = (size_t)tb[ti[0]] * 256 + ti[1], r2 = (size_t)tb[ti[2]] * 256 + ti[3];
            float* orow = args.out + (size_t)m * DM;
#pragma unroll
            for (int j = 0; j < 4; ++j) { const int k = 8 * lane + 512 * j;
                const v4u y1 = *(const v4u*)(Y + r1 * DM + k), y2 = *(const v4u*)(Y + r2 * DM + k);
                const f32x4 g0 = *(const f32x4*)(modf + b * 12288 + 10240 + k), g1 = *(const f32x4*)(modf + b * 12288 + 10240 + k + 4);
                f32x4 x0 = *(const f32x4*)(orow + k), x1 = *(const f32x4*)(orow + k + 4);
                x0.x += g0.x * (bflo(y1.x) + bflo(y2.x)); x0.y += g0.y * (bfhi(y1.x) + bfhi(y2.x)); x0.z += g0.z * (bflo(y1.y) + bflo(y2.y)); x0.w += g0.w * (bfhi(y1.y) + bfhi(y2.y));
                x1.x += g1.x * (bflo(y1.z) + bflo(y2.z)); x1.y += g1.y * (bfhi(y1.z) + bfhi(y2.z)); x1.z += g1.z * (bflo(y1.w) + bflo(y2.w)); x1.w += g1.w * (bfhi(y1.w) + bfhi(y2.w));
                *(f32x4*)(orow + k) = x0; *(f32x4*)(orow + k + 4) = x1; }
        }
    } }
#undef IN
#undef SEAM
}

extern "C" void kernel_launch(void* const* d_in, const int* in_sizes, int n_in, void* d_out, int out_size, void* d_ws, size_t ws_size, hipStream_t stream) {
    static int grid = 0;
    if (grid == 0) {
        if (n_in != 22 || out_size != MTOK * DM || ws_size < WS_END) { fprintf(stderr, "kernel_launch: unexpected shapes (n_in %d, out %d, ws %zu < %zu)\n", n_in, out_size, ws_size, (size_t)WS_END); grid = -1; return; }
        int dev = 0, cus = 0;
        if (hipGetDevice(&dev) != hipSuccess || hipDeviceGetAttribute(&cus, hipDeviceAttributeMultiprocessorCount, dev) != hipSuccess) { grid = -1; return; }
        if (hipFuncSetAttribute((const void*)mk_fwd, hipFuncAttributeMaxDynamicSharedMemorySize, LDS_BYTES) != hipSuccess) { fprintf(stderr, "kernel_launch: hipFuncSetAttribute failed\n"); grid = -1; return; }
        int per_cu = 0;
        if (hipOccupancyMaxActiveBlocksPerMultiprocessor(&per_cu, (const void*)mk_fwd, NWAVES * 64, LDS_BYTES) != hipSuccess || per_cu < 1) fprintf(stderr, "kernel_launch: occupancy query says %d\n", per_cu);
        (void)hipGetLastError();
        grid = cus;
    }
    if (grid < 0) return;
    if (hipMemsetAsync((char*)d_ws + WS_CTL, 0, CTL_ZERO_BYTES, stream) != hipSuccess) { fprintf(stderr, "kernel_launch: memset failed\n"); return; }
    Args a{};
    for (int i = 0; i < 22; ++i) a.in[i] = (const float*)d_in[i];
    a.out = (float*)d_out; a.ws = (unsigned char*)d_ws;
#if MK_LAUNCH_PER_PHASE
    for (int p = 0; p < NPHASE; ++p) { a.ph_lo = p; a.ph_hi = p + 1; hipLaunchKernelGGL(mk_fwd, dim3(grid), dim3(NWAVES * 64), LDS_BYTES, stream, a); }
#else
    a.ph_lo = 0; a.ph_hi = NPHASE;
    hipLaunchKernelGGL(mk_fwd, dim3(grid), dim3(NWAVES * 64), LDS_BYTES, stream, a);
#endif
    const hipError_t le = hipPeekAtLastError();
    if (le != hipSuccess) fprintf(stderr, "kernel_launch: launch failed: %s\n", hipGetErrorName(le));
}
```

```cpp
#include <hip/hip_runtime.h>
#include <cstdio>
#include <cstdint>

#ifndef MK_LAUNCH_PER_PHASE
#define MK_LAUNCH_PER_PHASE 0
#endif
#ifndef DBG_SKIP
#define DBG_SKIP 0
#endif

#define GAS __attribute__((address_space(1)))
#define LAS __attribute__((address_space(3)))
typedef unsigned short bf16;
typedef unsigned v4u __attribute__((ext_vector_type(4)));
typedef unsigned v2u __attribute__((ext_vector_type(2)));
typedef float f32x4 __attribute__((ext_vector_type(4)));
typedef float f32x16 __attribute__((ext_vector_type(16)));
typedef short bf16x8 __attribute__((ext_vector_type(8)));
typedef short s16x4 __attribute__((ext_vector_type(4)));
typedef GAS unsigned gu32;

constexpr int NB = 4, SEQ = 2048, DM = 2048, MTOK = NB * SEQ;
constexpr int NPROJ = 7888, NPROJP = 7936;
constexpr int C_QA = 0, C_KA = 1024, C_VA = 1280, C_QB = 1536, C_KB = 2560, C_VB = 2624, C_QI = 2688, C_KI = 3712, C_WI = 3776, C_GA = 3792, C_GB = 5840;
constexpr int NEXP = 32, DEXP = 512, ECAP = 8192, PADROWS = 24576;
constexpr float LOG2E = 1.4426950408889634f;
constexpr float RMS_EPS = 1e-6f;
constexpr float NEGBIG = -1e30f;

constexpr size_t MiB = 1u << 20;
constexpr size_t WS_CTL = 0, CTL_ZERO_BYTES = 1 * MiB;
constexpr size_t WS_MODP = 1 * MiB;
constexpr size_t WS_MODF = 2 * MiB;
constexpr size_t WS_CB   = 2 * MiB + 512 * 1024;
constexpr size_t WS_TOK  = 2 * MiB + 768 * 1024;
constexpr size_t WS_ROWTOK = 3 * MiB;
constexpr size_t WS_ROWW = 4 * MiB;
constexpr size_t WS_IDX  = 5 * MiB;
constexpr size_t WS_WTIN = 9 * MiB;
constexpr size_t WS_WTA  = 40 * MiB, WS_WTB = 44 * MiB, WS_WTO = 48 * MiB;
constexpr size_t WS_WRH = 56 * MiB, WS_WRL = 57 * MiB;
constexpr size_t WS_WTGU = 60 * MiB;
constexpr size_t WS_WTD  = 184 * MiB;
constexpr size_t WS_H    = 248 * MiB;
constexpr size_t WS_PROJ = 280 * MiB;
constexpr size_t WS_Y    = WS_PROJ;
constexpr size_t WS_OA   = 404 * MiB, WS_OB = 420 * MiB;
constexpr size_t WS_T    = 436 * MiB;
constexpr size_t WS_MRG  = 468 * MiB;
constexpr size_t WS_ACT  = 500 * MiB;
constexpr size_t WS_END  = 524 * MiB;
constexpr int CW_BAR = 4096;
constexpr int CW_ECNT = 16384;

constexpr int RING_BYTES = 131072;
constexpr int LDSCTL_OFF = RING_BYTES, MISC_OFF = LDSCTL_OFF + 320;
constexpr int MOE_TB_OFF = LDSCTL_OFF + 1024;
constexpr int MOE_NOFF = LDSCTL_OFF + 2048;
constexpr int LDS_BYTES = 147456;
constexpr int NWAVES = 8;

#define RLX_AGENT __ATOMIC_RELAXED, __HIP_MEMORY_SCOPE_AGENT
#define LDS_WAIT() asm volatile("s_waitcnt lgkmcnt(0)" ::: "memory")
#define VM_WAIT() asm volatile("s_waitcnt vmcnt(0)" ::: "memory")

__device__ __forceinline__ unsigned cvt_pk_bf16(float lo, float hi) { unsigned r; asm volatile("v_cvt_pk_bf16_f32 %0, %1, %2" : "=v"(r) : "v"(lo), "v"(hi)); return r; }
__device__ __forceinline__ float bflo(unsigned w) { return __uint_as_float(w << 16); }
__device__ __forceinline__ float bfhi(unsigned w) { return __uint_as_float(w & 0xffff0000u); }
__device__ __forceinline__ float fast_exp2(float x) { return __builtin_amdgcn_exp2f(x); }
__device__ __forceinline__ float fast_rcp(float x) { return __builtin_amdgcn_rcpf(x); }
__device__ __forceinline__ float sigmoidf_(float x) { return fast_rcp(1.f + fast_exp2(-x * LOG2E)); }
__device__ __forceinline__ float wave_sum(float v) {
#pragma unroll
    for (int o = 1; o < 64; o <<= 1) v += __shfl_xor(v, o);
    return v;
}
__device__ __forceinline__ s16x4 tr_read(LAS const unsigned char* p) {
    typedef short v4i16_t __attribute__((ext_vector_type(4)));
    return __builtin_bit_cast(s16x4, __builtin_amdgcn_ds_read_tr16_b64_v4i16((LAS v4i16_t*)p));
}
__device__ __forceinline__ int crow(int r, int hi) { return (r & 3) + 8 * (r >> 2) + 4 * hi; }

namespace pg8 {
typedef unsigned short bf16_t;
typedef unsigned u32x4 __attribute__((ext_vector_type(4)));
constexpr int BM = 256, BK = 64, HALF = 128, HTB = HALF * BK * 2, STAGE_BYTES = 8 * HTB, NXCD = 8, WGM = 8;
__host__ __device__ __forceinline__ int lds_byte(int r, int c) { const int st = (r >> 4) * 2 + (c >> 5), rr = r & 15, cc = c & 31, ob = rr * 64 + cc * 2; return st * 1024 + (ob ^ (((ob >> 9) & 1) << 5)); }
__host__ __device__ __forceinline__ void stage_rc(int b, int& R, int& C) { const int st = b / 1024, sb = b % 1024, swz = sb ^ (((sb >> 9) & 1) << 5); R = (st >> 1) * 16 + swz / 64; C = (st & 1) * 32 + (swz % 64) / 2; }
__host__ __device__ __forceinline__ int perm32(int rho) { const int n = rho >> 4, i = rho & 15; return 8 * (i >> 2) + 4 * n + (i & 3); }

struct Unit { int pm, pn, pb, ga; };
struct Gemm { const bf16_t* A0; const bf16_t* A1; const bf16_t* B0; const bf16_t* B1; int K; };

struct StaticOrder {
    static constexpr bool PAIR = false;
    int nM, nN, nwg, G, c;
    __device__ void init(int M, int N, int G_, int c_) { nM = M / BM; nN = N / BM; nwg = nM * nN; G = G_; c = c_; }
    __device__ bool next(int i, Unit& u) const {
        const long L = (long)i * G + c; if (L >= nwg) return false;
        int wgid = (int)L; { const int q = nwg / NXCD, r = nwg % NXCD, xcd = wgid % NXCD, off = wgid / NXCD; wgid = (xcd < r ? xcd * (q + 1) : r * (q + 1) + (xcd - r) * q) + off; }
        const int nig = WGM * nN, gid = wgid / nig, fm = gid * WGM, gsz = (nM - fm) < WGM ? (nM - fm) : WGM;
        u.pm = fm + ((wgid % nig) % gsz); u.pn = (wgid % nig) / gsz; u.pb = u.pn; u.ga = 0; return true;
    }
    __device__ __forceinline__ unsigned arow(const Unit&, int) const { return 0u; }
};
struct PairOrder {
    static constexpr bool PAIR = true;
    int nM, nN, nwg, G, c;
    __device__ void init(int M, int N, int G_, int c_) { nM = M / BM; nN = N / BM; nwg = nM * nN; G = G_; c = c_; }
    __device__ bool next(int i, Unit& u) const {
        const long L = (long)(i >> 1) * G + c; if (L >= nwg) return false;
        int wgid = (int)L; { const int q = nwg / NXCD, r = nwg % NXCD, xcd = wgid % NXCD, off = wgid / NXCD; wgid = (xcd < r ? xcd * (q + 1) : r * (q + 1) + (xcd - r) * q) + off; }
        const int nig = WGM * nN, gid = wgid / nig, fm = gid * WGM, gsz = (nM - fm) < WGM ? (nM - fm) : WGM;
        u.pm = fm + ((wgid % nig) % gsz); u.pn = (wgid % nig) / gsz; u.pb = u.pn; u.ga = i & 1; return true;
    }
    __device__ __forceinline__ unsigned arow(const Unit&, int) const { return 0u; }
};
struct MoeOrder {
    static constexpr bool PAIR = false;
    const LAS int* tb; const LAS int* cnt; const int* rowtok; int npn, G, c, total; bool gather;
    __device__ bool next(int i, Unit& u) const {
        const int L = i * G + c; if (L >= total) return false;
        const int tile = L / npn, pn = L - tile * npn; int e = 0;
#pragma unroll
        for (int j = 1; j < NEXP; ++j) e += (tile >= tb[j]) ? 1 : 0;
        u.pm = tile; u.pn = pn; u.pb = e * npn + pn; u.ga = e; return true;
    }
    __device__ __forceinline__ unsigned arow(const Unit& u, int r) const {
        const int e = u.ga, local = (u.pm - tb[e]) * 256 + r;
        return (local < cnt[e]) ? (unsigned)rowtok[e * ECAP + local] : 0u;
    }
};

template <class Epi, class Sched, bool ALIGN_EPI, bool GATHER>
__device__ __forceinline__ void gemm_phase(LAS unsigned char* lds, const Gemm g, const Sched& S, const Epi& E) {
    const int tid = threadIdx.x, wid = __builtin_amdgcn_readfirstlane(tid >> 6), lane = tid & 63, wr = wid >> 2, wc = wid & 3, fr = lane & 15, fq = lane >> 4;
    const int K = g.K, nt = K / BK;
    unsigned voffA[2], voffB[2]; int RA[2], CA[2];
#pragma unroll
    for (int i = 0; i < 2; ++i) { int R, C; stage_rc(tid * 16 + i * 8192, R, C); const int Rb = Epi::PERM ? ((R & ~31) + perm32(R & 31)) : R;
        RA[i] = R; CA[i] = C; voffA[i] = (unsigned)(R * K + C) * 2u; voffB[i] = (unsigned)(Rb * K + C) * 2u; }
    const size_t kstep = (size_t)(BK * 2);
    const size_t hstep = (size_t)HALF * K * 2;
    const size_t tstep = 2 * hstep;
    const unsigned ldsw = (unsigned)wid * 1024u;
    const int aoff = lds_byte(wr * 64 + fr, fq * 8), boff = lds_byte(wc * 32 + fr, fq * 8);
    LAS unsigned* noff = (LAS unsigned*)(lds + MOE_NOFF) + tid * 4;
#define PG8_SA(b, h) (((b) * 2 + (h)) * HTB)
#define PG8_SB(b, h) ((4 + (b) * 2 + (h)) * HTB)
#define PG8_STAGE(bufoff, gbase, voff) do { _Pragma("unroll") for (int _i = 0; _i < 2; ++_i) \
        __builtin_amdgcn_global_load_lds((const unsigned*)((const char*)(gbase) + (voff)[_i]), (LAS unsigned*)(lds + (bufoff) + ldsw + _i * 8192), 16, 0, 0); } while (0)
#define PG8_LDA(dst, b, h) do { _Pragma("unroll") for (int m = 0; m < 4; ++m) _Pragma("unroll") for (int k = 0; k < 2; ++k) dst[m][k] = *(const LAS bf16x8*)(lds + PG8_SA(b, h) + aoff + m * 2048 + k * 1024); } while (0)
#define PG8_LDB(dst, b, h) do { _Pragma("unroll") for (int n = 0; n < 2; ++n) _Pragma("unroll") for (int k = 0; k < 2; ++k) dst[n][k] = *(const LAS bf16x8*)(lds + PG8_SB(b, h) + boff + n * 2048 + k * 1024); } while (0)
#define PG8_MMA(ai, bj, At, Bt) do { __builtin_amdgcn_s_setprio(1); _Pragma("unroll") for (int m = 0; m < 4; ++m) _Pragma("unroll") for (int n = 0; n < 2; ++n) _Pragma("unroll") for (int k = 0; k < 2; ++k) \
        acc[ai][bj][m][n] = __builtin_amdgcn_mfma_f32_16x16x32_bf16(Bt[n][k], At[m][k], acc[ai][bj][m][n], 0, 0, 0); __builtin_amdgcn_s_setprio(0); } while (0)
#define PG8_WAIT_V(n) asm volatile("s_waitcnt vmcnt(" #n ")" ::: "memory")
#define PG8_WAIT_L(n) asm volatile("s_waitcnt lgkmcnt(" #n ")" ::: "memory")
#define PG8_BAR __builtin_amdgcn_s_barrier()
#define PG8_SCHED __builtin_amdgcn_sched_barrier(0)
    Unit cur, nxt; int ui = 0;
    if (!S.next(0, cur)) return;
    f32x4 acc[2][2][4][2];
#pragma unroll
    for (int a = 0; a < 2; ++a)
#pragma unroll
        for (int b = 0; b < 2; ++b)
#pragma unroll
            for (int m = 0; m < 4; ++m)
#pragma unroll
                for (int n = 0; n < 2; ++n) acc[a][b][m][n] = (f32x4){0.f, 0.f, 0.f, 0.f};
    bf16x8 At[4][2], B0[2][2], B1[2][2];
    unsigned cO0[2], cO1[2];
    const char* cA; const char* cB;
    if constexpr (GATHER) {
        cA = (const char*)g.A0;
#pragma unroll
        for (int i = 0; i < 2; ++i) { cO0[i] = S.arow(cur, RA[i]) * (unsigned)(K * 2) + (unsigned)CA[i] * 2u; cO1[i] = S.arow(cur, HALF + RA[i]) * (unsigned)(K * 2) + (unsigned)CA[i] * 2u; }
    } else {
        cA = (const char*)((Sched::PAIR && cur.ga) ? g.A1 : g.A0) + (size_t)cur.pm * tstep;
#pragma unroll
        for (int i = 0; i < 2; ++i) { cO0[i] = voffA[i]; cO1[i] = voffA[i] + (unsigned)hstep; }
    }
    cB = (const char*)((Sched::PAIR && cur.ga) ? g.B1 : g.B0) + (size_t)cur.pb * tstep;
    PG8_STAGE(PG8_SB(0, 0), cB, voffB); PG8_STAGE(PG8_SB(0, 1), cB + hstep, voffB); PG8_STAGE(PG8_SA(0, 0), cA, cO0); PG8_STAGE(PG8_SA(0, 1), cA, cO1);
    if (wr == 1) PG8_BAR;
    PG8_WAIT_V(2); PG8_BAR;
    PG8_STAGE(PG8_SB(1, 0), cB + kstep, voffB); PG8_STAGE(PG8_SA(1, 0), cA + kstep, cO0); PG8_STAGE(PG8_SB(1, 1), cB + hstep + kstep, voffB);
    PG8_WAIT_V(6); PG8_BAR;
    for (;;) {
        const bool has_next = S.next(ui + 1, nxt);
        const char* nA; const char* nB;
        if constexpr (GATHER) {
            nA = cA;
            if (has_next) {
                u32x4 o; o.x = S.arow(nxt, RA[0]) * (unsigned)(K * 2) + (unsigned)CA[0] * 2u; o.y = S.arow(nxt, RA[1]) * (unsigned)(K * 2) + (unsigned)CA[1] * 2u;
                o.z = S.arow(nxt, HALF + RA[0]) * (unsigned)(K * 2) + (unsigned)CA[0] * 2u; o.w = S.arow(nxt, HALF + RA[1]) * (unsigned)(K * 2) + (unsigned)CA[1] * 2u;
                *(LAS u32x4*)noff = o;
            } else { u32x4 o; o.x = cO0[0]; o.y = cO0[1]; o.z = cO1[0]; o.w = cO1[1]; *(LAS u32x4*)noff = o; }
        } else {
            nA = has_next ? (const char*)((Sched::PAIR && nxt.ga) ? g.A1 : g.A0) + (size_t)nxt.pm * tstep : cA;
        }
        nB = has_next ? (const char*)((Sched::PAIR && nxt.ga) ? g.B1 : g.B0) + (size_t)nxt.pb * tstep : cB;
        for (int t = 0; t < nt; t += 2) {
            const bool last = (t == nt - 2);
            const char* a1 = cA + (size_t)(t + 1) * kstep;
            const char* a2 = last ? nA : cA + (size_t)(t + 2) * kstep; const char* b2 = last ? nB : cB + (size_t)(t + 2) * kstep;
            const char* a3 = a2 + kstep; const char* b3 = b2 + kstep;
            unsigned sO0[2], sO1[2];
            if constexpr (GATHER) {
                if (last) { const u32x4 o = *(const LAS u32x4*)noff; sO0[0] = o.x; sO0[1] = o.y; sO1[0] = o.z; sO1[1] = o.w; }
                else { sO0[0] = cO0[0]; sO0[1] = cO0[1]; sO1[0] = cO1[0]; sO1[1] = cO1[1]; }
            } else { sO0[0] = cO0[0]; sO0[1] = cO0[1]; sO1[0] = cO1[0]; sO1[1] = cO1[1]; }
            PG8_LDB(B0, 0, 0); PG8_LDB(B1, 0, 1); PG8_SCHED; PG8_LDA(At, 0, 0); PG8_STAGE(PG8_SA(1, 1), a1, cO1);
            PG8_WAIT_V(8); PG8_WAIT_L(0); PG8_BAR; PG8_MMA(0, 0, At, B0); PG8_MMA(0, 1, At, B1); PG8_BAR; PG8_SCHED;
            PG8_LDA(At, 0, 1); PG8_STAGE(PG8_SB(0, 0), b2, voffB); PG8_STAGE(PG8_SB(0, 1), b2 + hstep, voffB); PG8_STAGE(PG8_SA(0, 0), a2, sO0);
            PG8_WAIT_V(8); PG8_WAIT_L(0); PG8_BAR; PG8_MMA(1, 0, At, B0); PG8_MMA(1, 1, At, B1); PG8_BAR; PG8_SCHED;
            PG8_LDB(B0, 1, 0); PG8_LDB(B1, 1, 1); PG8_SCHED; PG8_LDA(At, 1, 0); PG8_STAGE(PG8_SA(0, 1), a2, sO1);
            PG8_WAIT_V(8); PG8_WAIT_L(0); PG8_BAR; PG8_MMA(0, 0, At, B0); PG8_MMA(0, 1, At, B1); PG8_BAR; PG8_SCHED;
            PG8_LDA(At, 1, 1); PG8_STAGE(PG8_SB(1, 0), b3, voffB); PG8_STAGE(PG8_SB(1, 1), b3 + hstep, voffB); PG8_STAGE(PG8_SA(1, 0), a3, sO0);
            PG8_WAIT_V(8); PG8_WAIT_L(0); PG8_BAR; PG8_MMA(1, 0, At, B0); PG8_MMA(1, 1, At, B1); PG8_BAR; PG8_SCHED;
        }
        if constexpr (ALIGN_EPI) { if (wr == 0) PG8_BAR; }
        E(acc, cur, wr, wc, fr, fq);
        if (!has_next) break;
#pragma unroll
        for (int a = 0; a < 2; ++a)
#pragma unroll
            for (int b = 0; b < 2; ++b)
#pragma unroll
                for (int m = 0; m < 4; ++m)
#pragma unroll
                    for (int n = 0; n < 2; ++n) acc[a][b][m][n] = (f32x4){0.f, 0.f, 0.f, 0.f};
        cur = nxt; cA = nA; cB = nB; ++ui;
        if constexpr (GATHER) { const u32x4 o = *(const LAS u32x4*)noff; cO0[0] = o.x; cO0[1] = o.y; cO1[0] = o.z; cO1[1] = o.w; }
        if constexpr (ALIGN_EPI) { if (wr == 1) PG8_BAR; }
    }
    PG8_WAIT_V(0);
    if constexpr (!ALIGN_EPI) { if (wr == 0) PG8_BAR; }
    PG8_BAR;
#undef PG8_SA
#undef PG8_SB
#undef PG8_STAGE
#undef PG8_LDA
#undef PG8_LDB
#undef PG8_MMA
#undef PG8_WAIT_V
#undef PG8_WAIT_L
#undef PG8_BAR
#undef PG8_SCHED
}

struct EpiStore {
    static constexpr bool PERM = true;
    bf16_t* O; int ldc;
    __device__ __forceinline__ void operator()(const f32x4 (&acc)[2][2][4][2], const Unit& u, int wr, int wc, int fr, int fq) const {
        const int row0 = u.pm * BM + wr * 64 + fr, col0 = u.pn * BM + wc * 32 + 8 * fq;
#pragma unroll
        for (int ai = 0; ai < 2; ++ai)
#pragma unroll
            for (int m = 0; m < 4; ++m) { bf16_t* rowp = O + (size_t)(row0 + ai * HALF + m * 16) * ldc + col0;
#pragma unroll
                for (int bj = 0; bj < 2; ++bj) { const f32x4 v0 = acc[ai][bj][m][0], v1 = acc[ai][bj][m][1];
                    u32x4 w; w.x = cvt_pk_bf16(v0[0], v0[1]); w.y = cvt_pk_bf16(v0[2], v0[3]); w.z = cvt_pk_bf16(v1[0], v1[1]); w.w = cvt_pk_bf16(v1[2], v1[3]);
                    *(u32x4*)(rowp + bj * HALF) = w; } }
    }
};
struct EpiGate {
    static constexpr bool PERM = true;
    const bf16_t* proj; bf16_t* T; bf16_t* mrg;
    __device__ __forceinline__ void operator()(const f32x4 (&acc)[2][2][4][2], const Unit& u, int wr, int wc, int fr, int fq) const {
        const int row0 = u.pm * BM + wr * 64 + fr, col0 = u.pn * BM + wc * 32 + 8 * fq;
        const int gcol = (u.ga ? C_GB : C_GA) + col0;
#pragma unroll
        for (int ai = 0; ai < 2; ++ai)
#pragma unroll
            for (int m = 0; m < 4; ++m) { const size_t row = (size_t)(row0 + ai * HALF + m * 16);
#pragma unroll
                for (int bj = 0; bj < 2; ++bj) { const f32x4 v0 = acc[ai][bj][m][0], v1 = acc[ai][bj][m][1];
                    const u32x4 gt = *(const u32x4*)(proj + row * NPROJP + gcol + bj * HALF);
                    float r[8];
                    r[0] = v0[0] * sigmoidf_(bflo(gt.x)); r[1] = v0[1] * sigmoidf_(bfhi(gt.x)); r[2] = v0[2] * sigmoidf_(bflo(gt.y)); r[3] = v0[3] * sigmoidf_(bfhi(gt.y));
                    r[4] = v1[0] * sigmoidf_(bflo(gt.z)); r[5] = v1[1] * sigmoidf_(bfhi(gt.z)); r[6] = v1[2] * sigmoidf_(bflo(gt.w)); r[7] = v1[3] * sigmoidf_(bfhi(gt.w));
                    bf16_t* tp = T + row * DM + col0 + bj * HALF;
                    if (u.ga) { const u32x4 tv = *(const u32x4*)tp;
                        r[0] += bflo(tv.x); r[1] += bfhi(tv.x); r[2] += bflo(tv.y); r[3] += bfhi(tv.y); r[4] += bflo(tv.z); r[5] += bfhi(tv.z); r[6] += bflo(tv.w); r[7] += bfhi(tv.w); }
                    u32x4 w; w.x = cvt_pk_bf16(r[0], r[1]); w.y = cvt_pk_bf16(r[2], r[3]); w.z = cvt_pk_bf16(r[4], r[5]); w.w = cvt_pk_bf16(r[6], r[7]);
                    *(u32x4*)((u.ga ? mrg : T) + row * DM + col0 + bj * HALF) = w; } }
    }
};
struct EpiOut {
    static constexpr bool PERM = true;
    const float* x; const float* modf; float* out;
    __device__ __forceinline__ void operator()(const f32x4 (&acc)[2][2][4][2], const Unit& u, int wr, int wc, int fr, int fq) const {
        const int row0 = u.pm * BM + wr * 64 + fr, col0 = u.pn * BM + wc * 32 + 8 * fq;
        const int b = (u.pm * BM) >> 11;
        f32x4 gv[2][2];
#pragma unroll
        for (int bj = 0; bj < 2; ++bj)
#pragma unroll
            for (int n = 0; n < 2; ++n) gv[bj][n] = *(const f32x4*)(modf + b * 12288 + 4096 + col0 + bj * HALF + 4 * n);
#pragma unroll
        for (int ai = 0; ai < 2; ++ai)
#pragma unroll
            for (int m = 0; m < 4; ++m) { const size_t off = (size_t)(row0 + ai * HALF + m * 16) * DM + col0;
#pragma unroll
                for (int bj = 0; bj < 2; ++bj)
#pragma unroll
                    for (int n = 0; n < 2; ++n) { const f32x4 xv = *(const f32x4*)(x + off + bj * HALF + 4 * n);
                        *(f32x4*)(out + off + bj * HALF + 4 * n) = xv + gv[bj][n] * acc[ai][bj][m][n]; } }
    }
};
struct EpiMoeGU {
    static constexpr bool PERM = true;
    bf16_t* act; const float* roww; const LAS int* tb; const LAS int* cnt;
    __device__ __forceinline__ void operator()(const f32x4 (&acc)[2][2][4][2], const Unit& u, int wr, int wc, int fr, int fq) const {
        const int e = u.ga, lbase = (u.pm - tb[e]) * 256, n_e = cnt[e];
        const int r0 = wr * 64 + fr, col0 = u.pn * HALF + wc * 32 + 8 * fq;
#pragma unroll
        for (int ai = 0; ai < 2; ++ai)
#pragma unroll
            for (int m = 0; m < 4; ++m) { const int r = r0 + ai * HALF + m * 16; const int local = lbase + r;
                const float w = (local < n_e) ? roww[e * ECAP + local] : 0.f;
                float o[8];
#pragma unroll
                for (int n = 0; n < 2; ++n)
#pragma unroll
                    for (int j = 0; j < 4; ++j) { const float gte = acc[ai][0][m][n][j], up = acc[ai][1][m][n][j]; o[4 * n + j] = gte * sigmoidf_(gte) * up * w; }
                u32x4 wv; wv.x = cvt_pk_bf16(o[0], o[1]); wv.y = cvt_pk_bf16(o[2], o[3]); wv.z = cvt_pk_bf16(o[4], o[5]); wv.w = cvt_pk_bf16(o[6], o[7]);
                *(u32x4*)(act + (size_t)(u.pm * 256 + r) * DEXP + col0) = wv; }
    }
};
}

#define XB_TMO      128
#define XB_XCNT(j)  (256  + 64 * (j))
#define XB_XSUB(j)  (1280 + 64 * (j))
#define XB_XGEN(j)  (2304 + 64 * (j))
#define XB_TOP      3328
#define XB_TOPGEN   3392
#define XCD_BAR_WORDS 3456
#define XB_SPIN_CAP (1u << 18)
__device__ __forceinline__ unsigned xb_ld(unsigned* p)              { return __hip_atomic_load(p, __ATOMIC_RELAXED, __HIP_MEMORY_SCOPE_AGENT); }
__device__ __forceinline__ unsigned xb_add(unsigned* p, unsigned v) { return __hip_atomic_fetch_add(p, v, __ATOMIC_RELAXED, __HIP_MEMORY_SCOPE_AGENT); }
__device__ __forceinline__ unsigned xb_xcc_id() { return (unsigned)__builtin_amdgcn_s_getreg((3 << 11) | 20) & 0xFu; }
#define XB_SPIN(cond, bar) do { unsigned _sp = 0; while (cond) { __builtin_amdgcn_s_sleep(1); \
    if ((++_sp & 255u) == 0u) { if (xb_ld(&(bar)[XB_TMO])) break; if (_sp > XB_SPIN_CAP) { atomicAdd(&(bar)[XB_TMO], 1u); break; } } } } while (0)
struct XcdBarrier { unsigned* bar; unsigned x; volatile LAS unsigned* st; };
__device__ __forceinline__ XcdBarrier xcd_barrier_post(unsigned* bar, volatile LAS unsigned* st) {
    XcdBarrier b; b.bar = bar; b.x = xb_xcc_id(); b.st = st;
    if (threadIdx.x == 0) (void)xb_add(&bar[XB_XCNT(b.x)], 1u);
    return b;
}
__device__ __forceinline__ void xcd_barrier_complete(unsigned* bar, unsigned x, unsigned& nloc, unsigned& nx) {
    const unsigned G = gridDim.x * gridDim.y * gridDim.z;
    unsigned sum, cnt, mine, sp = 0u;
    for (;;) {
        sum = 0u; cnt = 0u; mine = 0u;
#pragma unroll
        for (unsigned j = 0; j < 16; ++j) { const unsigned c = xb_ld(&bar[XB_XCNT(j)]); sum += c; cnt += (c > 0u) ? 1u : 0u; mine = (j == x) ? c : mine; }
        if (sum == G) break;
        __builtin_amdgcn_s_sleep(1);
        if ((++sp & 255u) == 0u) { if (xb_ld(&bar[XB_TMO])) break; if (sp > XB_SPIN_CAP) { atomicAdd(&bar[XB_TMO], 1u); break; } }
    }
    nloc = mine > 0u ? mine : 1u; nx = cnt > 0u ? cnt : 1u;
}
__device__ __forceinline__ void xcd_barrier(const XcdBarrier& b) {
    asm volatile("s_waitcnt vmcnt(0)" ::: "memory");
    __syncthreads();
    if (threadIdx.x == 0) {
        unsigned* bar = b.bar;
        __builtin_amdgcn_s_waitcnt(0);
        unsigned nloc = b.st[0], nx = b.st[1];
        if (nloc == 0u) { xcd_barrier_complete(bar, b.x, nloc, nx); b.st[0] = nloc; b.st[1] = nx; }
        const unsigned old = xb_add(&bar[XB_XSUB(b.x)], 1u);
        const unsigned gen = old / nloc;
        if (old + 1u == (gen + 1u) * nloc) {
            __builtin_amdgcn_fence(__ATOMIC_RELEASE, "agent");
            asm volatile("s_waitcnt vmcnt(0)" ::: "memory");
            const unsigned og = xb_add(&bar[XB_TOP], 1u);
            const unsigned tg = og / nx;
            if (og + 1u == (tg + 1u) * nx) xb_add(&bar[XB_TOPGEN], 1u);
            else XB_SPIN(xb_ld(&bar[XB_TOPGEN]) == tg, bar);
            __builtin_amdgcn_fence(__ATOMIC_ACQUIRE, "agent");
            xb_add(&bar[XB_XGEN(b.x)], 1u);
            asm volatile("s_waitcnt vmcnt(0)" ::: "memory");
        } else {
            XB_SPIN(xb_ld(&bar[XB_XGEN(b.x)]) == gen, bar);
            __builtin_amdgcn_fence(__ATOMIC_ACQUIRE, "agent");
            asm volatile("s_waitcnt vmcnt(0)" ::: "memory");
        }
    }
    __syncthreads();
}

struct Args { const float* in[22]; float* out; unsigned char* ws; int ph_lo, ph_hi; };
typedef __attribute__((address_space(4))) const Args KArgs;
__device__ __forceinline__ KArgs* kargs() { KArgs* p = (KArgs*)__builtin_amdgcn_kernarg_segment_ptr(); asm volatile("" : "+s"(p)); return p; }
enum { I_X = 0, I_C, I_WADA, I_BADA, I_LN1G, I_WIN, I_SWAQN, I_SWAKN, I_SINKS, I_DSAQN, I_DSAKN, I_WBA, I_WBB, I_WOUT, I_LN2G, I_WGRP, I_BGRP, I_WEXP, I_BEXP, I_WGU, I_WUP, I_WDN };

__device__ __forceinline__ void p0_adaln_item(KArgs& a, LAS unsigned char* lds, int j, int tid) {
    LAS float* condl = (LAS float*)lds;
    LAS float* red = (LAS float*)(lds + 8192);
    const int cr = j & 63, kq = j >> 6;
    const float* cin = a.in[I_C];
    for (int i = tid; i < 2048; i += 512) { const int kk = i >> 2, b = i & 3; const float c = cin[b * 2048 + kq * 512 + kk]; condl[kk * 4 + b] = c * fast_rcp(1.f + __expf(-c)); }
    __syncthreads();
    if (tid < 480) {
        const int cg = tid % 48, ks = tid / 48;
        const float* wp = a.in[I_WADA] + (size_t)(kq * 512) * 12288 + cr * 192 + cg * 4;
        f32x4 acc[4];
#pragma unroll
        for (int b = 0; b < 4; ++b) acc[b] = (f32x4){0.f, 0.f, 0.f, 0.f};
#pragma unroll 4
        for (int kk = ks; kk < 512; kk += 10) {
            const f32x4 w = *(const f32x4*)(wp + (size_t)kk * 12288);
            const f32x4 c = *(const LAS f32x4*)(condl + kk * 4);
            acc[0] += c.x * w; acc[1] += c.y * w; acc[2] += c.z * w; acc[3] += c.w * w;
        }
#pragma unroll
        for (int b = 0; b < 4; ++b) *(LAS f32x4*)(red + (ks * 4 + b) * 192 + cg * 4) = acc[b];
    }
    __syncthreads();
    float* modp = (float*)(a.ws + WS_MODP);
    for (int o = tid; o < 768; o += 512) { const int b = o / 192, col = o % 192; float s = 0.f;
#pragma unroll
        for (int ks = 0; ks < 10; ++ks) s += red[(ks * 4 + b) * 192 + col];
        modp[(kq * 4 + b) * 12288 + cr * 192 + col] = s; }
    __syncthreads();
}
__device__ __forceinline__ void tr_item(const float* W, int N, int Nvalid, int K, bf16* WT, int drow0, int k0, int n0, LAS float* scr, int lane) {
    const bool ok = (n0 + (lane & 31)) < Nvalid;
#pragma unroll 8
    for (int i = 0; i < 32; ++i) { const int kk = 2 * i + (lane >> 5); scr[kk * 33 + (lane & 31)] = ok ? W[(size_t)(k0 + kk) * N + n0 + (lane & 31)] : 0.f; }
    LDS_WAIT(); asm volatile("" ::: "memory");
    const int c = lane & 7;
#pragma unroll
    for (int j = 0; j < 4; ++j) { const int n = (lane >> 3) + 8 * j; const LAS float* s = scr + (8 * c) * 33 + n;
        v4u o; o.x = cvt_pk_bf16(s[0 * 33], s[1 * 33]); o.y = cvt_pk_bf16(s[2 * 33], s[3 * 33]); o.z = cvt_pk_bf16(s[4 * 33], s[5 * 33]); o.w = cvt_pk_bf16(s[6 * 33], s[7 * 33]);
        *(v4u*)(WT + (size_t)(drow0 + n) * K + k0 + 8 * c) = o; }
    LDS_WAIT(); asm volatile("" ::: "memory");
}
__device__ __forceinline__ void p0_prologue(KArgs& a, LAS unsigned char* lds, int vcu, int G, int tid, int lane, int wave) {
    for (int j = vcu; j < 256; j += G) p0_adaln_item(a, lds, j, tid);
    LAS float* scr = (LAS float*)(lds + wave * 16384);
    const int gw = vcu * NWAVES + wave, NGW = G * NWAVES;
    constexpr int I_IN = 32 * 248, I_BR = 16 * 64, I_OUT = 32 * 64, I_GU = 32 * 16, I_DN = 8 * 64;
    constexpr int NITEMS = I_IN + 2 * I_BR + I_OUT;
    unsigned char* ws = a.ws;
    for (int it = gw; it < NITEMS; it += NGW) {
        int r = it;
        if (r < I_IN) { const int kb = r / 248, nb = r % 248; tr_item(a.in[I_WIN], NPROJ, NPROJ, 2048, (bf16*)(ws + WS_WTIN), 32 * nb, 64 * kb, 32 * nb, scr, lane); continue; } r -= I_IN;
        if (r < I_BR) { const int kb = r / 64, nb = r % 64; tr_item(a.in[I_WBA], 2048, 2048, 1024, (bf16*)(ws + WS_WTA), 32 * nb, 64 * kb, 32 * nb, scr, lane); continue; } r -= I_BR;
        if (r < I_BR) { const int kb = r / 64, nb = r % 64; tr_item(a.in[I_WBB], 2048, 2048, 1024, (bf16*)(ws + WS_WTB), 32 * nb, 64 * kb, 32 * nb, scr, lane); continue; } r -= I_BR;
        if (r < I_OUT) { const int kb = r / 64, nb = r % 64; tr_item(a.in[I_WOUT], 2048, 2048, 2048, (bf16*)(ws + WS_WTO), 32 * nb, 64 * kb, 32 * nb, scr, lane); continue; } r -= I_OUT;
        const int e = r / (2 * I_GU + I_DN); r -= e * (2 * I_GU + I_DN);
        if (r < 2 * I_GU) {
            const int which = r / I_GU; r -= which * I_GU; const int kb = r / 16, nb = r % 16, n0 = 32 * nb;
            const float* W = (which ? a.in[I_WUP] : a.in[I_WGU]) + (size_t)e * 2048 * 512;
            tr_item(W, 512, 512, 2048, (bf16*)(ws + WS_WTGU) + (size_t)e * 1024 * 2048, (n0 >> 7) * 256 + which * 128 + (n0 & 127), 64 * kb, n0, scr, lane); continue; }
        r -= 2 * I_GU;
        { const int kb = r / 64, nb = r % 64; tr_item(a.in[I_WDN] + (size_t)e * 512 * 2048, 2048, 2048, 512, (bf16*)(ws + WS_WTD) + (size_t)e * 2048 * 512, 32 * nb, 64 * kb, 32 * nb, scr, lane); }
    }
    __syncthreads();
}

__device__ __forceinline__ float modval(const float* modp, const float* bada, int b, int n) {
    return ((modp[(0 * 4 + b) * 12288 + n] + modp[(1 * 4 + b) * 12288 + n]) + (modp[(2 * 4 + b) * 12288 + n] + modp[(3 * 4 + b) * 12288 + n])) + bada[n];
}
__device__ __forceinline__ void p1_norm1(KArgs& a, LAS unsigned char* lds, int vcu, int G, int tid, int lane, int wave) {
    const float* modp = (const float*)(a.ws + WS_MODP); const float* bada = a.in[I_BADA];
    float* modf = (float*)(a.ws + WS_MODF);
    LAS float* A4 = (LAS float*)lds; LAS float* B4 = A4 + 2048;
    const float* g1 = a.in[I_LN1G];
    for (int i = vcu * 512 + tid; i < 4 * 12288; i += G * 512) { const int b = i / 12288, n = i % 12288; modf[i] = modval(modp, bada, b, n); }
    { bf16* wrh = (bf16*)(a.ws + WS_WRH); bf16* wrl = (bf16*)(a.ws + WS_WRL);
      for (int i = vcu * 512 + tid; i < 64 * 2048; i += G * 512) { const int n = i >> 11, k = i & 2047;
          const float w = (n < 32) ? a.in[I_WEXP][k * 32 + n] : (n < 36) ? a.in[I_WGRP][k * 4 + (n - 32)] : 0.f;
          const unsigned hi = cvt_pk_bf16(w, 0.f) & 0xffffu; const float lo = w - bflo(hi);
          wrh[i] = (bf16)hi; wrl[i] = (bf16)(cvt_pk_bf16(lo, 0.f) & 0xffffu); } }
    const float* x = a.in[I_X]; bf16* H = (bf16*)(a.ws + WS_H);
    for (int blk = vcu; blk < 256; blk += G) {
        const int b = blk >> 6;
        __syncthreads();
        for (int k = tid; k < 2048; k += 512) { A4[k] = g1[k] * (1.f + modval(modp, bada, b, 2048 + k)); B4[k] = modval(modp, bada, b, k); }
        __syncthreads();
#pragma unroll 1
        for (int i = 0; i < 4; ++i) {
            const int m = blk * 32 + wave * 4 + i;
            const f32x4* xr = (const f32x4*)(x + (size_t)m * DM) + lane;
            f32x4 v[8]; float s = 0.f;
#pragma unroll
            for (int j = 0; j < 8; ++j) { v[j] = xr[64 * j]; s += (v[j].x * v[j].x + v[j].y * v[j].y) + (v[j].z * v[j].z + v[j].w * v[j].w); }
            const float rstd = 1.f / sqrtf(wave_sum(s) * (1.f / DM) + RMS_EPS);
            unsigned long long* o8 = (unsigned long long*)(H + (size_t)m * DM) + lane;
#pragma unroll
            for (int j = 0; j < 8; ++j) { const int k = 4 * lane + 256 * j; const f32x4 A = *(const LAS f32x4*)(A4 + k), Bv = *(const LAS f32x4*)(B4 + k);
                const f32x4 y = v[j] * rstd * A + Bv;
                o8[64 * j] = (unsigned long long)cvt_pk_bf16(y.x, y.y) | ((unsigned long long)cvt_pk_bf16(y.z, y.w) << 32); }
        }
    }
}

__device__ __forceinline__ void prep_norms(KArgs& a, int vcu, int G, int lane, int wave) {
    bf16* proj = (bf16*)(a.ws + WS_PROJ);
    const int gw = vcu * NWAVES + wave, NGW = G * NWAVES;
    const int sub = lane & 7, grp = lane >> 3;
    const float qs = 0.125f * LOG2E;
    for (int m = gw; m < MTOK; m += NGW) {
#pragma unroll
        for (int s = 0; s < 5; ++s) {
            const int hv = 8 * s + grp;
            if (hv < 37) {
                const int col = (hv < 20) ? 64 * hv : 256 + 64 * hv;
                const float* gain = (hv < 16) ? a.in[I_SWAQN] : (hv < 20) ? a.in[I_SWAKN] : (hv < 36) ? a.in[I_DSAQN] : a.in[I_DSAKN];
                const float sc = (hv < 16 || (hv >= 20 && hv < 36)) ? qs : 1.f;
                bf16* p = proj + (size_t)m * NPROJP + col + sub * 8;
                const v4u w = *(const v4u*)p;
                float f[8] = {bflo(w.x), bfhi(w.x), bflo(w.y), bfhi(w.y), bflo(w.z), bfhi(w.z), bflo(w.w), bfhi(w.w)};
                float ss = 0.f;
#pragma unroll
                for (int i = 0; i < 8; ++i) ss += f[i] * f[i];
                ss += __shfl_xor(ss, 1); ss += __shfl_xor(ss, 2); ss += __shfl_xor(ss, 4);
                const float r = sc / sqrtf(ss * (1.f / 64.f) + RMS_EPS);
                const f32x4 g0 = *(const f32x4*)(gain + sub * 8), g1 = *(const f32x4*)(gain + sub * 8 + 4);
                v4u o; o.x = cvt_pk_bf16(f[0] * r * g0.x, f[1] * r * g0.y); o.y = cvt_pk_bf16(f[2] * r * g0.z, f[3] * r * g0.w);
                o.z = cvt_pk_bf16(f[4] * r * g1.x, f[5] * r * g1.y); o.w = cvt_pk_bf16(f[6] * r * g1.z, f[7] * r * g1.w);
                *(v4u*)p = o;
            }
        }
    }
}
__device__ __forceinline__ unsigned f2key(float f) { const unsigned u = __float_as_uint(f); return (u & 0x80000000u) ? ~u : (u | 0x80000000u); }
__device__ __forceinline__ unsigned half_sum(unsigned v) {
    v += (unsigned)__builtin_amdgcn_update_dpp(0, (int)v, 0xB1, 0xF, 0xF, false);
    v += (unsigned)__builtin_amdgcn_update_dpp(0, (int)v, 0x4E, 0xF, 0xF, false);
    v += (unsigned)__builtin_amdgcn_update_dpp(0, (int)v, 0x141, 0xF, 0xF, false);
    v += (unsigned)__builtin_amdgcn_update_dpp(0, (int)v, 0x140, 0xF, 0xF, false);
    v += (unsigned)__builtin_amdgcn_ds_swizzle((int)v, 0x401F);
    return v;
}
constexpr int IX_KBUF = 36864;
constexpr int IX_LST = 2 * IX_KBUF;
__device__ __forceinline__ void indexer_unit(const bf16* proj, unsigned short* idxo, LAS unsigned char* lds, int u, int tid, int lane, int wave) {
    const int b = u >> 7, q0 = (u & 127) << 4;
    const int r32 = lane & 31, hi = lane >> 5;
    const int tq = q0 + 2 * wave + hi;
    const int NT = (q0 + 47) >> 5, NC = (NT + 7) >> 3;
    bf16x8 aq[4]; float wv[16];
    {
        const int sel = (r32 >> 2) & 1, head = (r32 & 3) + 4 * (r32 >> 3);
        const bf16* qrow = proj + (size_t)(b * SEQ + q0 + 2 * wave + sel) * NPROJP + C_QI + head * 64 + hi * 8;
#pragma unroll
        for (int ks = 0; ks < 4; ++ks) aq[ks] = *(const bf16x8*)(qrow + 16 * ks);
        const bf16* wrow = proj + (size_t)(b * SEQ + tq) * NPROJP + C_WI;
        const v4u w0 = *(const v4u*)wrow, w1 = *(const v4u*)(wrow + 8);
        const float c = 0.25f * 0.125f;
        wv[0] = bflo(w0.x) * c; wv[1] = bfhi(w0.x) * c; wv[2] = bflo(w0.y) * c; wv[3] = bfhi(w0.y) * c; wv[4] = bflo(w0.z) * c; wv[5] = bfhi(w0.z) * c; wv[6] = bflo(w0.w) * c; wv[7] = bfhi(w0.w) * c;
        wv[8] = bflo(w1.x) * c; wv[9] = bfhi(w1.x) * c; wv[10] = bflo(w1.y) * c; wv[11] = bfhi(w1.y) * c; wv[12] = bflo(w1.z) * c; wv[13] = bfhi(w1.z) * c; wv[14] = bflo(w1.w) * c; wv[15] = bfhi(w1.w) * c;
    }
    unsigned key[64];
    const bf16* kibase = proj + (size_t)(b * SEQ) * NPROJP + C_KI;
    v4u st[4];
#define IX_LOAD(c) do { _Pragma("unroll") for (int i = 0; i < 4; ++i) { const int p = tid + 512 * i; st[i] = *(const v4u*)(kibase + (size_t)(256 * (c) + (p >> 3)) * NPROJP + (p & 7) * 8); } } while (0)
#define IX_WRITE(buf) do { _Pragma("unroll") for (int i = 0; i < 4; ++i) { const int p = tid + 512 * i; *(LAS v4u*)(lds + (buf) * IX_KBUF + (p >> 3) * 144 + (p & 7) * 16) = st[i]; } } while (0)
    IX_LOAD(0); IX_WRITE(0);
    __syncthreads();
#pragma unroll
    for (int c = 0; c < 8; ++c) {
        if (c < NC) {
            if (c + 1 < NC) IX_LOAD(c + 1);
#pragma unroll
            for (int tt = 0; tt < 8; ++tt) {
                const int T = 8 * c + tt;
                if (T < NT) {
                    LAS const unsigned char* kb = lds + (c & 1) * IX_KBUF + (32 * tt + r32) * 144 + 16 * hi;
                    f32x16 C = {};
#pragma unroll
                    for (int ks = 0; ks < 4; ++ks) { const bf16x8 bk = *(const LAS bf16x8*)(kb + 32 * ks); C = __builtin_amdgcn_mfma_f32_32x32x16_bf16(aq[ks], bk, C, 0, 0, 0); }
                    float sc = 0.f;
#pragma unroll
                    for (int r = 0; r < 16; ++r) sc += fmaxf(C[r], 0.f) * wv[r];
                    unsigned kk = f2key(sc); kk = kk < 1u ? 1u : kk;
                    key[T] = ((32 * T + r32) <= tq) ? kk : 0u;
                } else key[T] = 0u;
            }
            if (c + 1 < NC) IX_WRITE((c + 1) & 1);
            __syncthreads();
        } else {
#pragma unroll
            for (int tt = 0; tt < 8; ++tt) key[8 * c + tt] = 0u;
        }
    }
#undef IX_LOAD
#undef IX_WRITE
    unsigned T = 0u, need = 0u, cgt = 0u;
    const bool small = (q0 + 2 * wave + 1) < 256;
    if (!small) {
        unsigned prefix = 0u; bool done = false;
        for (int bit = 31; bit >= 0; --bit) {
            const unsigned cand = prefix | (1u << bit);
            unsigned cnt = 0u;
#pragma unroll
            for (int r = 0; r < 64; ++r) cnt += (key[r] >= cand) ? 1u : 0u;
            cnt = half_sum(cnt);
            const bool take = !done && cnt >= 256u;
            prefix = take ? cand : prefix;
            done = done || (take && cnt == 256u);
            if (__all(done)) break;
        }
        if (done) { T = prefix - 1u; need = 0u; cgt = 256u; }
        else {
            T = prefix; unsigned cnt = 0u;
#pragma unroll
            for (int r = 0; r < 64; ++r) cnt += (key[r] > T) ? 1u : 0u;
            cgt = half_sum(cnt); need = 256u - cgt;
        }
    }
    LAS unsigned char* lst = lds + IX_LST + wave * 1024;
    *(LAS v4u*)(lst + lane * 16) = (v4u){0xFFFFFFFFu, 0xFFFFFFFFu, 0xFFFFFFFFu, 0xFFFFFFFFu};
    LDS_WAIT();
    LAS unsigned short* lq = (LAS unsigned short*)(lst + hi * 512);
    unsigned base_gt = 0u, base_eq = 0u;
#pragma unroll
    for (int r = 0; r < 64; ++r) {
        const bool gt = key[r] > T, eq = key[r] == T;
        const unsigned long long mg = __ballot(gt), me = __ballot(eq);
        const unsigned mgh = hi ? (unsigned)(mg >> 32) : (unsigned)mg, meh = hi ? (unsigned)(me >> 32) : (unsigned)me;
        const unsigned below = (1u << r32) - 1u;
        const unsigned rg = __popc(mgh & below), re = __popc(meh & below);
        if (gt) lq[base_gt + rg] = (unsigned short)(32 * r + r32);
        if (eq && (base_eq + re) < need) lq[cgt + base_eq + re] = (unsigned short)(32 * r + r32);
        base_gt += __popc(mgh); base_eq += __popc(meh);
    }
    LDS_WAIT();
    const v4u lo = *(const LAS v4u*)(lst + lane * 16);
    *(v4u*)(idxo + ((size_t)(b * SEQ + q0 + 2 * wave + hi)) * 256 + r32 * 8) = lo;
    __syncthreads();
}

constexpr int SW_V = 36864, SW_WS = SW_V + 32768;
__device__ __forceinline__ void swa_unit(const bf16* proj, bf16* oa, const float* sinks, LAS unsigned char* lds, int u, int tid, int lane, int wave) {
    const int b = u >> 6, nblk = (u >> 2) & 15, kvh = u & 3;
    const int r32 = lane & 31, hi = lane >> 5;
#pragma unroll
    for (int i = 0; i < 4; ++i) {
        const int p = tid + 512 * i, kw = p >> 3, part = p & 7; const int spos = 128 * (nblk - 1) + kw;
        if (spos >= 0) {
            const bf16* src = proj + (size_t)(b * SEQ + spos) * NPROJP;
            const v4u kv = *(const v4u*)(src + C_KA + kvh * 64 + part * 8), vv = *(const v4u*)(src + C_VA + kvh * 64 + part * 8);
            *(LAS v4u*)(lds + kw * 144 + part * 16) = kv;
            *(LAS v4u*)(lds + SW_V + (part >> 2) * 16384 + kw * 64 + (part & 3) * 16) = vv;
        }
    }
    __syncthreads();
    const int hq = kvh * 4 + (wave >> 1);
    const float sink2 = sinks[hq] * LOG2E, slope2 = exp2f(-(float)(hq + 1) * 0.25f) * LOG2E;
    LAS float* wsf = (LAS float*)(lds + SW_WS) + wave * 32;
#pragma unroll 1
    for (int qq = 0; qq < 2; ++qq) {
        const int qt = 2 * (wave & 1) + qq, t0 = 128 * nblk + 32 * qt;
        const bf16* qrow = proj + (size_t)(b * SEQ + t0 + r32) * NPROJP + C_QA + hq * 64 + hi * 8;
        bf16x8 qr[4];
#pragma unroll
        for (int d0 = 0; d0 < 4; ++d0) qr[d0] = *(const bf16x8*)(qrow + 16 * d0);
        float mx = sink2;
        const int jlo = (nblk == 0) ? ((4 - qt) > 0 ? (4 - qt) : 0) : 0;
#pragma unroll 1
        for (int j = jlo; j < 5; ++j) {
            const int kt = qt + j;
            LAS const unsigned char* kb = lds + (32 * kt + r32) * 144 + 16 * hi;
            f32x16 C = {};
#pragma unroll
            for (int d0 = 0; d0 < 4; ++d0) { const bf16x8 kf = *(const LAS bf16x8*)(kb + 32 * d0); C = __builtin_amdgcn_mfma_f32_32x32x16_bf16(kf, qr[d0], C, 0, 0, 0); }
#pragma unroll
            for (int r = 0; r < 16; ++r) { const int rel = (128 + 32 * qt + r32) - (32 * kt + crow(r, hi));
                const float v = (rel >= 0 && rel < 128) ? C[r] - slope2 * (float)rel : NEGBIG; mx = fmaxf(mx, v); }
        }
        mx = fmaxf(mx, __shfl_xor(mx, 32));
        float lsum = 0.f;
        f32x16 o[2]; o[0] = (f32x16){}; o[1] = (f32x16){};
#pragma unroll 1
        for (int j = jlo; j < 5; ++j) {
            const int kt = qt + j;
            LAS const unsigned char* kb = lds + (32 * kt + r32) * 144 + 16 * hi;
            f32x16 C = {};
#pragma unroll
            for (int d0 = 0; d0 < 4; ++d0) { const bf16x8 kf = *(const LAS bf16x8*)(kb + 32 * d0); C = __builtin_amdgcn_mfma_f32_32x32x16_bf16(kf, qr[d0], C, 0, 0, 0); }
#pragma unroll
            for (int r = 0; r < 16; ++r) { const int rel = (128 + 32 * qt + r32) - (32 * kt + crow(r, hi));
                const float v = (rel >= 0 && rel < 128) ? C[r] - slope2 * (float)rel : NEGBIG; const float p = fast_exp2(v - mx); C[r] = p; lsum += p; }
#pragma unroll
            for (int ks = 0; ks < 2; ++ks) {
                v4u pw; pw.x = cvt_pk_bf16(C[8 * ks + 0], C[8 * ks + 1]); pw.y = cvt_pk_bf16(C[8 * ks + 2], C[8 * ks + 3]);
                pw.z = cvt_pk_bf16(C[8 * ks + 4], C[8 * ks + 5]); pw.w = cvt_pk_bf16(C[8 * ks + 6], C[8 * ks + 7]);
                const bf16x8 pa = __builtin_bit_cast(bf16x8, pw);
#pragma unroll
                for (int d0 = 0; d0 < 2; ++d0) {
                    LAS const unsigned char* vp = lds + SW_V + d0 * 16384 + (32 * kt + 16 * ks + 4 * hi + ((lane & 15) >> 2)) * 64 + ((lane >> 4) & 1) * 32 + (lane & 3) * 8;
                    const s16x4 vl = tr_read(vp), vh = tr_read(vp + 512);
                    const bf16x8 vf = (bf16x8){vl[0], vl[1], vl[2], vl[3], vh[0], vh[1], vh[2], vh[3]};
                    o[d0] = __builtin_amdgcn_mfma_f32_32x32x16_bf16(pa, vf, o[d0], 0, 0, 0);
                }
            }
        }
        lsum += __shfl_xor(lsum, 32); lsum += fast_exp2(sink2 - mx);
        if (hi == 0) wsf[r32] = fast_rcp(lsum);
        LDS_WAIT();
        bf16* orow = oa + (size_t)(b * SEQ + t0) * 1024 + hq * 64 + r32;
#pragma unroll
        for (int r = 0; r < 16; ++r) { const int q = crow(r, hi); const float rl = wsf[q];
            const unsigned w0 = cvt_pk_bf16(o[0][r] * rl, 0.f), w1 = cvt_pk_bf16(o[1][r] * rl, 0.f);
            orow[(size_t)q * 1024] = (bf16)(w0 & 0xffffu); orow[(size_t)q * 1024 + 32] = (bf16)(w1 & 0xffffu); }
        LDS_WAIT();
    }
    __syncthreads();
}

constexpr int DS_WAVE = 10240 + 512;
__device__ __forceinline__ void dsa_query(const bf16* proj, const unsigned short* idx, bf16* ob, LAS unsigned char* wl, int b, int t, int lane) {
    const int i16 = lane & 15, g = lane >> 4;
    const int nsel = (t + 1) < 256 ? (t + 1) : 256;
    LAS unsigned char* lst = wl + 10240;
    { const v2u li = *(const v2u*)(idx + ((size_t)(b * SEQ + t)) * 256 + lane * 4); *(LAS v2u*)(lst + lane * 8) = li; }
    const bf16* qrow = proj + (size_t)(b * SEQ + t) * NPROJP + C_QB + i16 * 64 + 8 * g;
    const bf16x8 qf0 = *(const bf16x8*)qrow, qf1 = *(const bf16x8*)(qrow + 32);
    const float slope2 = exp2f(-(float)(17 + i16) * 0.25f) * LOG2E;
    const bf16* pb = proj + (size_t)(b * SEQ) * NPROJP;
    LAS const unsigned short* lq = (LAS const unsigned short*)lst + i16;
    LAS const unsigned char* lg4 = lst + 8 * g;
    LAS const unsigned short* lv = (LAS const unsigned short*)lst + (lane >> 3);
    LAS unsigned char* vwr = wl + (lane >> 3) * 160 + (lane & 7) * 16;
    LAS const unsigned char* vrd = wl + (4 * g + (i16 >> 2)) * 160 + 8 * (i16 & 3);
    asm volatile("" : "+v"(lq), "+v"(lg4), "+v"(lv), "+v"(vwr), "+v"(vrd));
    LDS_WAIT();
    f32x4 s[16]; float mx = NEGBIG;
#pragma unroll
    for (int T = 0; T < 16; ++T) {
        const int pos = 16 * T + i16; int kidx = lq[16 * T]; kidx = (pos < nsel) ? kidx : 0;
        const bf16* krow = pb + (size_t)kidx * NPROJP + C_KB + 8 * g;
        const bf16x8 kf0 = *(const bf16x8*)krow, kf1 = *(const bf16x8*)(krow + 32);
        f32x4 c = {0.f, 0.f, 0.f, 0.f};
        c = __builtin_amdgcn_mfma_f32_16x16x32_bf16(kf0, qf0, c, 0, 0, 0);
        c = __builtin_amdgcn_mfma_f32_16x16x32_bf16(kf1, qf1, c, 0, 0, 0);
        const v2u i4 = *(const LAS v2u*)(lg4 + 32 * T);
        const int id0 = i4.x & 0xffff, id1 = i4.x >> 16, id2 = i4.y & 0xffff, id3 = i4.y >> 16;
        const int p0 = 16 * T + 4 * g;
        c[0] = (p0 + 0 < nsel) ? c[0] - slope2 * (float)(t - id0) : NEGBIG;
        c[1] = (p0 + 1 < nsel) ? c[1] - slope2 * (float)(t - id1) : NEGBIG;
        c[2] = (p0 + 2 < nsel) ? c[2] - slope2 * (float)(t - id2) : NEGBIG;
        c[3] = (p0 + 3 < nsel) ? c[3] - slope2 * (float)(t - id3) : NEGBIG;
        s[T] = c; mx = fmaxf(fmaxf(mx, fmaxf(c[0], c[1])), fmaxf(c[2], c[3]));
        if ((T & 3) == 3) __builtin_amdgcn_sched_barrier(0);
    }
    mx = fmaxf(mx, __shfl_xor(mx, 16)); mx = fmaxf(mx, __shfl_xor(mx, 32));
    float lsum = 0.f;
#pragma unroll
    for (int T = 0; T < 16; ++T)
#pragma unroll
        for (int r = 0; r < 4; ++r) { const float p = fast_exp2(s[T][r] - mx); s[T][r] = p; lsum += p; }
    lsum += __shfl_xor(lsum, 16); lsum += __shfl_xor(lsum, 32);
    f32x4 o[4];
#pragma unroll
    for (int dt = 0; dt < 4; ++dt) o[dt] = (f32x4){0.f, 0.f, 0.f, 0.f};
#pragma unroll
    for (int c = 0; c < 4; ++c) {
        v4u vv[8];
#pragma unroll
        for (int i = 0; i < 8; ++i) { const int pos = 64 * c + 8 * i + (lane >> 3); int vidx = lv[64 * c + 8 * i]; vidx = (pos < nsel) ? vidx : 0;
            vv[i] = *(const v4u*)(pb + (size_t)vidx * NPROJP + C_VB + (lane & 7) * 8); }
#pragma unroll
        for (int i = 0; i < 8; ++i) *(LAS v4u*)(vwr + 8 * i * 160) = vv[i];
        LDS_WAIT();
#pragma unroll
        for (int s2 = 0; s2 < 2; ++s2) {
            const int ks = 2 * c + s2;
            v4u pw; pw.x = cvt_pk_bf16(s[2 * ks][0], s[2 * ks][1]); pw.y = cvt_pk_bf16(s[2 * ks][2], s[2 * ks][3]);
            pw.z = cvt_pk_bf16(s[2 * ks + 1][0], s[2 * ks + 1][1]); pw.w = cvt_pk_bf16(s[2 * ks + 1][2], s[2 * ks + 1][3]);
            const bf16x8 pbv = __builtin_bit_cast(bf16x8, pw);
#pragma unroll
            for (int dt = 0; dt < 4; ++dt) {
                const s16x4 vl = tr_read(vrd + 32 * s2 * 160 + 32 * dt), vh = tr_read(vrd + (32 * s2 + 16) * 160 + 32 * dt);
                const bf16x8 vf = (bf16x8){vl[0], vl[1], vl[2], vl[3], vh[0], vh[1], vh[2], vh[3]};
                o[dt] = __builtin_amdgcn_mfma_f32_16x16x32_bf16(vf, pbv, o[dt], 0, 0, 0);
            }
        }
        LDS_WAIT();
        __builtin_amdgcn_sched_barrier(0);
    }
    const float rl = fast_rcp(lsum);
    bf16* orow = ob + (size_t)(b * SEQ + t) * 1024 + i16 * 64 + 4 * g;
#pragma unroll
    for (int dt = 0; dt < 4; ++dt) { v2u w; w.x = cvt_pk_bf16(o[dt][0] * rl, o[dt][1] * rl); w.y = cvt_pk_bf16(o[dt][2] * rl, o[dt][3] * rl); *(v2u*)(orow + 16 * dt) = w; }
}

constexpr int RT_PART = 0, RT_RS = 65536, RT_LG = RT_RS + 128;
__device__ __forceinline__ void router_unit(KArgs& a, LAS unsigned char* lds, int u, int tid, int lane, int wave) {
    const float* x2 = a.out; const float* modf = (const float*)(a.ws + WS_MODF); const float* g2 = a.in[I_LN2G];
    bf16* H2 = (bf16*)(a.ws + WS_H);
    const bf16* wrh = (const bf16*)(a.ws + WS_WRH); const bf16* wrl = (const bf16*)(a.ws + WS_WRL);
    const int row0 = u * 32, b = row0 >> 11;
    LAS float* rs = (LAS float*)(lds + RT_RS);
#pragma unroll 1
    for (int i = 0; i < 4; i += 2) {
        const int m = row0 + 4 * wave + i;
        const f32x4* xr0 = (const f32x4*)(x2 + (size_t)m * DM) + lane; const f32x4* xr1 = xr0 + DM / 4;
        f32x4 v0[8], v1[8]; float s0 = 0.f, s1 = 0.f;
#pragma unroll
        for (int j = 0; j < 8; ++j) { v0[j] = xr0[64 * j]; v1[j] = xr1[64 * j]; }
#pragma unroll
        for (int j = 0; j < 8; ++j) { s0 += (v0[j].x * v0[j].x + v0[j].y * v0[j].y) + (v0[j].z * v0[j].z + v0[j].w * v0[j].w); s1 += (v1[j].x * v1[j].x + v1[j].y * v1[j].y) + (v1[j].z * v1[j].z + v1[j].w * v1[j].w); }
        const float r0 = 1.f / sqrtf(wave_sum(s0) * (1.f / DM) + RMS_EPS), r1 = 1.f / sqrtf(wave_sum(s1) * (1.f / DM) + RMS_EPS);
        if (lane == 0) { rs[4 * wave + i] = r0; rs[4 * wave + i + 1] = r1; }
        unsigned long long* o0 = (unsigned long long*)(H2 + (size_t)m * DM) + lane; unsigned long long* o1 = o0 + DM / 4;
#pragma unroll
        for (int j = 0; j < 8; ++j) { const int k = 4 * lane + 256 * j;
            const f32x4 gk = *(const f32x4*)(g2 + k), sc = *(const f32x4*)(modf + b * 12288 + 8192 + k), sh = *(const f32x4*)(modf + b * 12288 + 6144 + k);
            const f32x4 fk = gk * (sc + 1.f);
            const f32x4 y0 = v0[j] * r0 * fk + sh, y1 = v1[j] * r1 * fk + sh;
            o0[64 * j] = (unsigned long long)cvt_pk_bf16(y0.x, y0.y) | ((unsigned long long)cvt_pk_bf16(y0.z, y0.w) << 32);
            o1[64 * j] = (unsigned long long)cvt_pk_bf16(y1.x, y1.y) | ((unsigned long long)cvt_pk_bf16(y1.z, y1.w) << 32); }
    }
    __syncthreads();
    {
        const int r32 = lane & 31, hh = lane >> 5;
        const float rst = rs[r32];
        const size_t rowoff = (size_t)(row0 + r32) * DM;
        f32x16 acc0 = {}, acc1 = {};
#pragma unroll 4
        for (int ks = 0; ks < 16; ++ks) {
            const int k = wave * 256 + 16 * ks + 8 * hh;
            const f32x4 xa = *(const f32x4*)(x2 + rowoff + k), xb = *(const f32x4*)(x2 + rowoff + k + 4);
            const f32x4 ga = *(const f32x4*)(g2 + k), gb = *(const f32x4*)(g2 + k + 4);
            const f32x4 sca = *(const f32x4*)(modf + b * 12288 + 8192 + k), scb = *(const f32x4*)(modf + b * 12288 + 8192 + k + 4);
            const f32x4 sha = *(const f32x4*)(modf + b * 12288 + 6144 + k), shb = *(const f32x4*)(modf + b * 12288 + 6144 + k + 4);
            const f32x4 ha = xa * rst * ga * (sca + 1.f) + sha, hb = xb * rst * gb * (scb + 1.f) + shb;
            v4u hi; hi.x = cvt_pk_bf16(ha.x, ha.y); hi.y = cvt_pk_bf16(ha.z, ha.w); hi.z = cvt_pk_bf16(hb.x, hb.y); hi.w = cvt_pk_bf16(hb.z, hb.w);
            v4u lo; lo.x = cvt_pk_bf16(ha.x - bflo(hi.x), ha.y - bfhi(hi.x)); lo.y = cvt_pk_bf16(ha.z - bflo(hi.y), ha.w - bfhi(hi.y));
            lo.z = cvt_pk_bf16(hb.x - bflo(hi.z), hb.y - bfhi(hi.z)); lo.w = cvt_pk_bf16(hb.z - bflo(hi.w), hb.w - bfhi(hi.w));
            const bf16x8 ah = __builtin_bit_cast(bf16x8, hi), al = __builtin_bit_cast(bf16x8, lo);
            const bf16x8 bh0 = *(const bf16x8*)(wrh + (size_t)r32 * DM + k), bl0 = *(const bf16x8*)(wrl + (size_t)r32 * DM + k);
            const bf16x8 bh1 = *(const bf16x8*)(wrh + (size_t)(32 + r32) * DM + k), bl1 = *(const bf16x8*)(wrl + (size_t)(32 + r32) * DM + k);
            acc0 = __builtin_amdgcn_mfma_f32_32x32x16_bf16(al, bh0, acc0, 0, 0, 0); acc0 = __builtin_amdgcn_mfma_f32_32x32x16_bf16(ah, bl0, acc0, 0, 0, 0); acc0 = __builtin_amdgcn_mfma_f32_32x32x16_bf16(ah, bh0, acc0, 0, 0, 0);
            acc1 = __builtin_amdgcn_mfma_f32_32x32x16_bf16(al, bh1, acc1, 0, 0, 0); acc1 = __builtin_amdgcn_mfma_f32_32x32x16_bf16(ah, bl1, acc1, 0, 0, 0); acc1 = __builtin_amdgcn_mfma_f32_32x32x16_bf16(ah, bh1, acc1, 0, 0, 0);
        }
        LAS float* part = (LAS float*)(lds + RT_PART) + wave * 2048;
#pragma unroll
        for (int r = 0; r < 16; ++r) { const int tkn = crow(r, hh); part[tkn * 64 + r32] = acc0[r]; part[tkn * 64 + 32 + r32] = acc1[r]; }
    }
    __syncthreads();
    LAS float* lg = (LAS float*)(lds + RT_LG);
    for (int o = tid; o < 32 * 36; o += 512) { const int t2 = o / 36, j = o % 36; float s = 0.f;
#pragma unroll
        for (int q = 0; q < 8; ++q) s += ((LAS float*)(lds + RT_PART))[q * 2048 + t2 * 64 + j];
        lg[t2 * 36 + j] = s + ((j < 32) ? a.in[I_BEXP][j] : a.in[I_BGRP][j - 32]); }
    __syncthreads();
    if (tid < 32) {
        const LAS float* l = lg + tid * 36;
        int gi = 0; float gm = l[32];
#pragma unroll
        for (int j = 1; j < 4; ++j) if (l[32 + j] > gm) { gm = l[32 + j]; gi = j; }
        float gs = 0.f;
#pragma unroll
        for (int j = 0; j < 4; ++j) gs += __expf(l[32 + j] - gm);
        const float pg = 1.f / gs;
        float e[8];
#pragma unroll
        for (int j = 0; j < 8; ++j) e[j] = (gi == 0) ? l[j] : (gi == 1) ? l[8 + j] : (gi == 2) ? l[16 + j] : l[24 + j];
        int i1 = 0; float m1 = e[0];
#pragma unroll
        for (int j = 1; j < 8; ++j) if (e[j] > m1) { m1 = e[j]; i1 = j; }
        int i2 = -1; float m2 = -3.0e38f;
#pragma unroll
        for (int j = 0; j < 8; ++j) if (j != i1 && e[j] > m2) { m2 = e[j]; i2 = j; }
        const float p2 = __expf(m2 - m1), inv = 1.f / (1.f + p2);
        const float c1 = pg * inv, c2 = pg * p2 * inv;
        const int e1 = gi * 8 + i1, e2 = gi * 8 + i2, m = row0 + tid;
        LAS unsigned* lcnt = (LAS unsigned*)(lds + RT_LG + 32 * 36 * 4);
        lcnt[tid] = 0u;
        LDS_WAIT(); __builtin_amdgcn_wave_barrier();
        const unsigned lr1 = __hip_atomic_fetch_add(lcnt + e1, 1u, __ATOMIC_RELAXED, __HIP_MEMORY_SCOPE_WORKGROUP);
        const unsigned lr2 = __hip_atomic_fetch_add(lcnt + e2, 1u, __ATOMIC_RELAXED, __HIP_MEMORY_SCOPE_WORKGROUP);
        LDS_WAIT(); __builtin_amdgcn_wave_barrier();
        unsigned* ecnt = (unsigned*)(a.ws + WS_CTL) + CW_ECNT;
        const unsigned mine = lcnt[tid];
        const unsigned gb = mine ? atomicAdd(ecnt + tid * 32, mine) : 0u;
        lcnt[32 + tid] = gb;
        LDS_WAIT(); __builtin_amdgcn_wave_barrier();
        const int pos1 = (int)(lcnt[32 + e1] + lr1), pos2 = (int)(lcnt[32 + e2] + lr2);
        int* rowtok = (int*)(a.ws + WS_ROWTOK); float* roww = (float*)(a.ws + WS_ROWW);
        rowtok[e1 * ECAP + pos1] = m; roww[e1 * ECAP + pos1] = c1;
        rowtok[e2 * ECAP + pos2] = m; roww[e2 * ECAP + pos2] = c2;
        int* tokinfo = (int*)(a.ws + WS_TOK) + m * 4;
        tokinfo[0] = e1; tokinfo[1] = pos1; tokinfo[2] = e2; tokinfo[3] = pos2;
    }
    __syncthreads();
}
__device__ __forceinline__ void moe_table(KArgs& a, LAS unsigned char* lds, int tid) {
    LAS int* tb = (LAS int*)(lds + MOE_TB_OFF); LAS int* cn = tb + 40;
    if (tid == 0) {
        const unsigned* ecnt = (const unsigned*)(a.ws + WS_CTL) + CW_ECNT; int acc = 0;
        for (int e = 0; e < NEXP; ++e) { const int c = (int)__hip_atomic_load(ecnt + e * 32, RLX_AGENT); tb[e] = acc; cn[e] = c; acc += (c + 255) >> 8; }
        tb[NEXP] = acc;
    }
    __syncthreads();
}


namespace wsg {
constexpr int BK = 64, A_STR = 144, B_STR = 288, A_BYTES = 256 * A_STR, B_BYTES = 64 * B_STR, BUF_BYTES = A_BYTES + B_BYTES;
struct Unit { int e, mt, pn, tile; };
struct Order {
    const LAS int* tb; int npn, G, c, total;
    __device__ __forceinline__ bool next(int i, Unit& u) const {
        const int L = i * G + c; if (L >= total) return false;
        int e = 0;
#pragma unroll
        for (int j = 1; j < NEXP; ++j) e += (L >= tb[j] * npn) ? 1 : 0;
        const int idx = L - tb[e] * npn, te = tb[e + 1] - tb[e];
        u.e = e; u.pn = idx / te; u.mt = idx - u.pn * te; u.tile = tb[e] + u.mt; return true;
    }
};
template <bool GU>
__device__ __forceinline__ void ws_gemm(LAS unsigned char* lds, KArgs& a, const Order& S, const LAS int* cnt) {
    const int tid = threadIdx.x, wid = __builtin_amdgcn_readfirstlane(tid >> 6), lane = tid & 63, wm = wid >> 1, wn = wid & 1, fr = lane & 15, g = lane >> 4;
    constexpr int K = GU ? DM : DEXP, NK = K / BK, LDW = GU ? DEXP : DM;
    const bf16* Abase = (const bf16*)(a.ws + (GU ? WS_H : WS_ACT));
    const int* rowtok = (const int*)(a.ws + WS_ROWTOK);
    const int k0 = 4 * (2 * wid + (lane >> 5)), c4 = 4 * (lane & 31);
    const int kp0 = (k0 & ~12) | ((k0 & 4) << 1) | ((k0 & 8) >> 1);
    const int arow = tid >> 3, apart = tid & 7;
    Unit cur, nxt;
    if (!S.next(0, cur)) return;
    f32x4 acc[4][4];
#pragma unroll
    for (int m = 0; m < 4; ++m)
#pragma unroll
        for (int n = 0; n < 4; ++n) acc[m][n] = (f32x4){0.f, 0.f, 0.f, 0.f};
    unsigned aoff[4]; const float* wsrc;
#define WSG_SETUP(U, AO, WS) do { \
        _Pragma("unroll") for (int i = 0; i < 4; ++i) { const int row = arow + 64 * i; \
            if (GU) { const int local = (U).mt * 256 + row; const unsigned tok = (local < cnt[(U).e]) ? (unsigned)rowtok[(U).e * ECAP + local] : 0u; AO[i] = tok * (unsigned)(K * 2) + (unsigned)apart * 16u; } \
            else AO[i] = (unsigned)((U).tile * 256 + row) * (unsigned)(K * 2) + (unsigned)apart * 16u; } \
        if (GU) { const int wn_ = c4 >> 6, n_ = (c4 >> 4) & 3, ii_ = c4 & 15; \
            WS = ((n_ < 2) ? a.in[I_WGU] : a.in[I_WUP]) + (size_t)(U).e * DM * DEXP + (64 * (U).pn + 32 * wn_ + 16 * (n_ & 1) + ii_) + (size_t)k0 * LDW; } \
        else WS = a.in[I_WDN] + (size_t)(U).e * DEXP * DM + (128 * (U).pn + c4) + (size_t)k0 * LDW; } while (0)
    WSG_SETUP(cur, aoff, wsrc);
    v4u av[4]; f32x4 wv0[4], wv1[4];
    LAS unsigned* noff = (LAS unsigned*)(lds + MOE_NOFF) + tid * 4;
#define WSG_LOADA(AO, kt) do { _Pragma("unroll") for (int i = 0; i < 4; ++i) av[i] = *(const v4u*)((const char*)Abase + AO[i] + (kt) * 128); } while (0)
#define WSG_LOADW(WV, WS, kt) do { _Pragma("unroll") for (int i = 0; i < 4; ++i) WV[i] = *(const f32x4*)(WS + (size_t)((kt) * 64 + i) * LDW); } while (0)
#define WSG_WRITE(buf, WV) do { LAS unsigned char* ba_ = lds + (buf) * BUF_BYTES; \
        _Pragma("unroll") for (int i = 0; i < 4; ++i) { *(LAS v4u*)(ba_ + (arow + 64 * i) * A_STR + apart * 16) = av[i]; \
            v2u w_; w_.x = cvt_pk_bf16(WV[i].x, WV[i].y); w_.y = cvt_pk_bf16(WV[i].z, WV[i].w); *(LAS v2u*)(ba_ + A_BYTES + (kp0 + i) * B_STR + (lane & 31) * 8) = w_; } } while (0)
#define WSG_COMPUTE(buf) do { LAS const unsigned char* ba = lds + (buf) * BUF_BYTES; LAS const unsigned char* bb = ba + A_BYTES; \
        _Pragma("unroll") for (int ks = 0; ks < 2; ++ks) { bf16x8 af[4], bfr[4]; \
            _Pragma("unroll") for (int m = 0; m < 4; ++m) af[m] = *(const LAS bf16x8*)(ba + (64 * wm + 16 * m + fr) * A_STR + (32 * ks + 8 * g) * 2); \
            _Pragma("unroll") for (int n = 0; n < 4; ++n) { LAS const unsigned char* p = bb + (32 * ks + 4 * (g & 1) + 16 * (g >> 1) + (fr >> 2)) * B_STR + (64 * wn + 16 * n + 4 * (fr & 3)) * 2; \
                const s16x4 vl = tr_read(p), vh = tr_read(p + 8 * B_STR); bfr[n] = (bf16x8){vl[0], vl[1], vl[2], vl[3], vh[0], vh[1], vh[2], vh[3]}; } \
            _Pragma("unroll") for (int m = 0; m < 4; ++m) _Pragma("unroll") for (int n = 0; n < 4; ++n) acc[m][n] = __builtin_amdgcn_mfma_f32_16x16x32_bf16(bfr[n], af[m], acc[m][n], 0, 0, 0); } } while (0)
    WSG_LOADA(aoff, 0); WSG_LOADW(wv0, wsrc, 0); WSG_LOADW(wv1, wsrc, 1); WSG_WRITE(0, wv0);
    __syncthreads();
    int ui = 0;
    for (;;) {
        const bool has_next = S.next(ui + 1, nxt);
        { unsigned t4[4]; const float* tw;
#pragma unroll
          for (int i = 0; i < 4; ++i) t4[i] = aoff[i];
          if (has_next) { WSG_SETUP(nxt, t4, tw); (void)tw; }
          *(LAS v4u*)noff = (v4u){t4[0], t4[1], t4[2], t4[3]}; }
#pragma unroll 1
        for (int kt = 0; kt < NK; kt += 2) {
            const bool lastp = (kt == NK - 2);
            WSG_LOADA(aoff, kt + 1);
            if (!lastp) WSG_LOADW(wv0, wsrc, kt + 2);
            else if (has_next) { unsigned t4[4]; const float* nws; WSG_SETUP(nxt, t4, nws); WSG_LOADW(wv0, nws, 0); }
            __builtin_amdgcn_sched_barrier(0);
            WSG_COMPUTE(0);
            __builtin_amdgcn_sched_barrier(0);
            WSG_WRITE(1, wv1);
            __syncthreads();
            if (!lastp) { WSG_LOADA(aoff, kt + 2); WSG_LOADW(wv1, wsrc, kt + 3); }
            else if (has_next) { const v4u o4 = *(const LAS v4u*)noff; unsigned n4[4] = {o4.x, o4.y, o4.z, o4.w}; unsigned t4[4]; const float* nws; WSG_SETUP(nxt, t4, nws); (void)t4;
                WSG_LOADA(n4, 0); WSG_LOADW(wv1, nws, 1); }
            __builtin_amdgcn_sched_barrier(0);
            WSG_COMPUTE(1);
            __builtin_amdgcn_sched_barrier(0);
            if (lastp) {
                const size_t prow0 = (size_t)cur.tile * 256 + 64 * wm + fr;
                if (GU) {
                    bf16* act = (bf16*)(a.ws + WS_ACT); const float* roww = (const float*)(a.ws + WS_ROWW);
#pragma unroll
                    for (int m = 0; m < 4; ++m) { const int local = cur.mt * 256 + 64 * wm + 16 * m + fr;
                        const float w = (local < cnt[cur.e]) ? roww[cur.e * ECAP + local] : 0.f;
#pragma unroll
                        for (int n = 0; n < 2; ++n) { float o[4];
#pragma unroll
                            for (int r = 0; r < 4; ++r) { const float gt = acc[m][n][r]; o[r] = gt * sigmoidf_(gt) * acc[m][n + 2][r] * w; }
                            v2u wv2; wv2.x = cvt_pk_bf16(o[0], o[1]); wv2.y = cvt_pk_bf16(o[2], o[3]);
                            *(v2u*)(act + (prow0 + 16 * m) * DEXP + 64 * cur.pn + 32 * wn + 16 * n + 4 * g) = wv2; } }
                } else {
                    bf16* Y = (bf16*)(a.ws + WS_Y);
#pragma unroll
                    for (int m = 0; m < 4; ++m)
#pragma unroll
                        for (int n = 0; n < 4; ++n) { v2u wv2; wv2.x = cvt_pk_bf16(acc[m][n][0], acc[m][n][1]); wv2.y = cvt_pk_bf16(acc[m][n][2], acc[m][n][3]);
                            *(v2u*)(Y + (prow0 + 16 * m) * DM + 128 * cur.pn + 64 * wn + 16 * n + 4 * g) = wv2; }
                }
#pragma unroll
                for (int m = 0; m < 4; ++m)
#pragma unroll
                    for (int n = 0; n < 4; ++n) acc[m][n] = (f32x4){0.f, 0.f, 0.f, 0.f};
            }
            if (!lastp || has_next) WSG_WRITE(0, wv0);
            __syncthreads();
        }
        if (!has_next) break;
        cur = nxt; ++ui;
        { const v4u o4 = *(const LAS v4u*)noff; aoff[0] = o4.x; aoff[1] = o4.y; aoff[2] = o4.z; aoff[3] = o4.w; unsigned t4[4]; WSG_SETUP(cur, t4, wsrc); (void)t4; }
    }
#undef WSG_COMPUTE
#undef WSG_SETUP
#undef WSG_LOADA
#undef WSG_LOADW
#undef WSG_WRITE
}

template <bool GU>
__device__ __forceinline__ void ws_gemm2(LAS unsigned char* lds, KArgs& a, const Order& S, const LAS int* cnt) {
    const int tid = threadIdx.x, wid = __builtin_amdgcn_readfirstlane(tid >> 6), lane = tid & 63;
    constexpr int K = GU ? DM : DEXP, NK = K / BK, LDW = GU ? DEXP : DM;
    const int nun = (S.total > S.c) ? (S.total - S.c + S.G - 1) / S.G : 0;
    if (nun == 0) return;
    const int total = nun * NK;
    if (wid >= 4) {
        const int ptid = tid - 256;
        const bf16* Abase = (const bf16*)(a.ws + (GU ? WS_H : WS_ACT));
        const int* rowtok = (const int*)(a.ws + WS_ROWTOK);
        const int k0 = 4 * (2 * (wid - 4) + (lane >> 5)), c4 = 4 * (lane & 31);
        const int kp0 = (k0 & ~12) | ((k0 & 4) << 1) | ((k0 & 8) >> 1);
        const int arow = ptid >> 3, apart = ptid & 7;
        Unit U; int lu = 0, lkt = 0; (void)S.next(0, U);
        unsigned aoff[8]; const float* wsrc;
#define WS2_SETUP() do { \
            _Pragma("unroll") for (int i = 0; i < 8; ++i) { const int row = arow + 32 * i; \
                if (GU) { const int local = U.mt * 256 + row; const unsigned tok = (local < cnt[U.e]) ? (unsigned)rowtok[U.e * ECAP + local] : 0u; aoff[i] = tok * (unsigned)(K * 2) + (unsigned)apart * 16u; } \
                else aoff[i] = (unsigned)(U.tile * 256 + row) * (unsigned)(K * 2) + (unsigned)apart * 16u; } \
            if (GU) wsrc = ((c4 < 64) ? a.in[I_WGU] : a.in[I_WUP]) + (size_t)U.e * DM * DEXP + (64 * U.pn + (c4 & 63)) + (size_t)k0 * LDW; \
            else wsrc = a.in[I_WDN] + (size_t)U.e * DEXP * DM + (128 * U.pn + c4) + (size_t)k0 * LDW; } while (0)
        WS2_SETUP();
        v4u avA[8], avB[8], avC[8]; f32x4 wvA[8], wvB[8], wvC[8];
#define WS2_ISSUE(AV, WV) do { \
            _Pragma("unroll") for (int i = 0; i < 8; ++i) AV[i] = *(const v4u*)((const char*)Abase + aoff[i] + lkt * 128); \
            _Pragma("unroll") for (int i = 0; i < 4; ++i) { WV[i] = *(const f32x4*)(wsrc + (size_t)(lkt * 64 + i) * LDW); WV[4 + i] = *(const f32x4*)(wsrc + (size_t)(lkt * 64 + 32 + i) * LDW); } \
            if (++lkt == NK) { if (lu + 1 < nun) { lkt = 0; ++lu; (void)S.next(lu, U); WS2_SETUP(); } else lkt = NK - 1; } } while (0)
#define WS2_WRITE(buf, AV, WV) do { LAS unsigned char* ba_ = lds + (buf) * BUF_BYTES; \
            _Pragma("unroll") for (int i = 0; i < 8; ++i) *(LAS v4u*)(ba_ + (arow + 32 * i) * A_STR + apart * 16) = AV[i]; \
            _Pragma("unroll") for (int i = 0; i < 4; ++i) { v2u w_; w_.x = cvt_pk_bf16(WV[i].x, WV[i].y); w_.y = cvt_pk_bf16(WV[i].z, WV[i].w); *(LAS v2u*)(ba_ + A_BYTES + (kp0 + i) * B_STR + (lane & 31) * 8) = w_; \
                v2u x_; x_.x = cvt_pk_bf16(WV[4 + i].x, WV[4 + i].y); x_.y = cvt_pk_bf16(WV[4 + i].z, WV[4 + i].w); *(LAS v2u*)(ba_ + A_BYTES + (32 + kp0 + i) * B_STR + (lane & 31) * 8) = x_; } } while (0)
#define WS2_SUB(j, AVI, WVI, AVW, WVW) do { WS2_ISSUE(AVI, WVI); WS2_WRITE(((j) + 1) & 1, AVW, WVW); __syncthreads(); } while (0)
        WS2_ISSUE(avA, wvA); WS2_ISSUE(avB, wvB); WS2_ISSUE(avC, wvC); WS2_WRITE(0, avA, wvA);
        __syncthreads();
        int j = 0;
#pragma unroll 1
        for (; j + 3 <= total; j += 3) {
            WS2_SUB(j, avA, wvA, avB, wvB);
            WS2_SUB(j + 1, avB, wvB, avC, wvC);
            WS2_SUB(j + 2, avC, wvC, avA, wvA);
        }
        if (j < total) { WS2_SUB(j, avA, wvA, avB, wvB); if (j + 1 < total) WS2_SUB(j + 1, avB, wvB, avC, wvC); }
#undef WS2_SETUP
#undef WS2_ISSUE
#undef WS2_WRITE
#undef WS2_SUB
    } else {
        const int fr = lane & 15, g = lane >> 4;
        f32x4 acc[4][8];
#pragma unroll
        for (int m = 0; m < 4; ++m)
#pragma unroll
            for (int n = 0; n < 8; ++n) acc[m][n] = (f32x4){0.f, 0.f, 0.f, 0.f};
        Unit U; int cu = 0, kt = 0; (void)S.next(0, U);
        __syncthreads();
#pragma unroll 1
        for (int s = 0; s < total; ++s) {
            LAS const unsigned char* ba = lds + (s & 1) * BUF_BYTES; LAS const unsigned char* bb = ba + A_BYTES;
#pragma unroll
            for (int ks = 0; ks < 2; ++ks) {
                bf16x8 af[4], bfr[8];
#pragma unroll
                for (int m = 0; m < 4; ++m) af[m] = *(const LAS bf16x8*)(ba + (64 * wid + 16 * m + fr) * A_STR + (32 * ks + 8 * g) * 2);
#pragma unroll
                for (int n = 0; n < 8; ++n) { LAS const unsigned char* p = bb + (32 * ks + 4 * (g & 1) + 16 * (g >> 1) + (fr >> 2)) * B_STR + (16 * n + 4 * (fr & 3)) * 2;
                    const s16x4 vl = tr_read(p), vh = tr_read(p + 8 * B_STR); bfr[n] = (bf16x8){vl[0], vl[1], vl[2], vl[3], vh[0], vh[1], vh[2], vh[3]}; }
#pragma unroll
                for (int m = 0; m < 4; ++m)
#pragma unroll
                    for (int n = 0; n < 8; ++n) acc[m][n] = __builtin_amdgcn_mfma_f32_16x16x32_bf16(bfr[n], af[m], acc[m][n], 0, 0, 0);
            }
            if (++kt == NK) {
                const size_t prow0 = (size_t)U.tile * 256 + 64 * wid + fr;
                if (GU) {
                    bf16* act = (bf16*)(a.ws + WS_ACT); const float* roww = (const float*)(a.ws + WS_ROWW);
#pragma unroll
                    for (int m = 0; m < 4; ++m) { const int local = U.mt * 256 + 64 * wid + 16 * m + fr;
                        const float w = (local < cnt[U.e]) ? roww[U.e * ECAP + local] : 0.f;
#pragma unroll
                        for (int n = 0; n < 4; ++n) { float o[4];
#pragma unroll
                            for (int r = 0; r < 4; ++r) { const float gt = acc[m][n][r]; o[r] = gt * sigmoidf_(gt) * acc[m][n + 4][r] * w; }
                            v2u wv2; wv2.x = cvt_pk_bf16(o[0], o[1]); wv2.y = cvt_pk_bf16(o[2], o[3]);
                            *(v2u*)(act + (prow0 + 16 * m) * DEXP + 64 * U.pn + 16 * n + 4 * g) = wv2; } }
                } else {
                    bf16* Y = (bf16*)(a.ws + WS_Y);
#pragma unroll
                    for (int m = 0; m < 4; ++m)
#pragma unroll
                        for (int n = 0; n < 8; ++n) { v2u wv2; wv2.x = cvt_pk_bf16(acc[m][n][0], acc[m][n][1]); wv2.y = cvt_pk_bf16(acc[m][n][2], acc[m][n][3]);
                            *(v2u*)(Y + (prow0 + 16 * m) * DM + 128 * U.pn + 16 * n + 4 * g) = wv2; }
                }
#pragma unroll
                for (int m = 0; m < 4; ++m)
#pragma unroll
                    for (int n = 0; n < 8; ++n) acc[m][n] = (f32x4){0.f, 0.f, 0.f, 0.f};
                kt = 0; ++cu; if (cu < nun) (void)S.next(cu, U);
            }
            __syncthreads();
        }
    }
}
}

__device__ __forceinline__ int fresh_tid() { int t = threadIdx.x; asm volatile("" : "+v"(t)); return t; }
#define PH_IDS const int tid = fresh_tid(), lane = tid & 63, wave = __builtin_amdgcn_readfirstlane(tid >> 6); (void)lane; (void)wave; KArgs& args = *kargs(); unsigned char* ws = args.ws; (void)ws
constexpr int NPHASE = 11;
__global__ void __launch_bounds__(NWAVES * 64, 2) mk_fwd(Args args_) {
    extern __shared__ __attribute__((aligned(16))) unsigned char lds_raw[];
    LAS unsigned char* lds = (LAS unsigned char*)lds_raw;
    volatile LAS unsigned* MISC = (volatile LAS unsigned*)(lds + MISC_OFF);
    const int tid0 = threadIdx.x;
    const int G = gridDim.x; const int bx = blockIdx.x; const int vcu = (G % 8 == 0) ? (bx % 8) * (G / 8) + bx / 8 : bx;
    gu32* ctl = (gu32*)(args_.ws + WS_CTL);
    for (int u = tid0; u < (LDS_BYTES - LDSCTL_OFF) / 4; u += NWAVES * 64) ((LAS unsigned*)(lds + LDSCTL_OFF))[u] = 0u;
    __syncthreads();
    XcdBarrier bar; bar.bar = (unsigned*)ctl + CW_BAR; bar.x = 0; bar.st = nullptr;
    if (!MK_LAUNCH_PER_PHASE) bar = xcd_barrier_post((unsigned*)ctl + CW_BAR, MISC + 8);
    const int lo = args_.ph_lo, hi = args_.ph_hi;
#ifndef PH_MASK
#define PH_MASK 0x7ff
#endif
#ifndef PH_REP
#define PH_REP 0
#endif
#define NREP(k) (1 + ((PH_REP >> (k)) & 1))
#define IN(k) (((PH_MASK >> (k)) & 1) && lo <= (k) && (k) < hi)
#define SEAM(k) do { if (IN(k) && IN((k) + 1)) { if (!MK_LAUNCH_PER_PHASE) xcd_barrier(bar); } } while (0)
    if (IN(0)) { PH_IDS; for (int rep = 0; rep < NREP(0); ++rep) { p0_prologue(args, lds, vcu, G, tid, lane, wave); if (rep) xcd_barrier(bar); } }
    SEAM(0);
    if (IN(1)) { PH_IDS; for (int rep = 0; rep < NREP(1); ++rep) { p1_norm1(args, lds, vcu, G, tid, lane, wave); if (rep) xcd_barrier(bar); } }
    SEAM(1);
    if (IN(2)) { PH_IDS;
        pg8::Gemm g{(const bf16*)(ws + WS_H), nullptr, (const bf16*)(ws + WS_WTIN), nullptr, DM};
        pg8::StaticOrder S; S.init(MTOK, NPROJP, G, bx);
        pg8::EpiStore E{(bf16*)(ws + WS_PROJ), NPROJP};
        for (int rep = 0; rep < NREP(2); ++rep) { pg8::gemm_phase<pg8::EpiStore, pg8::StaticOrder, true, false>(lds, g, S, E); if (rep) xcd_barrier(bar); }
    }
    SEAM(2);
    if (IN(3)) { const int tid = threadIdx.x, lane = tid & 63, wave = __builtin_amdgcn_readfirstlane(tid >> 6); KArgs& args = *kargs(); unsigned char* ws = args.ws;
        bf16* PROJ = (bf16*)(ws + WS_PROJ);
        prep_norms(args, vcu, G, lane, wave);
        if (!(DBG_SKIP & 2)) {
            unsigned short* idxo = (unsigned short*)(ws + WS_IDX);
            for (int rep = 0; rep < NREP(3); ++rep) { for (int i = vcu; i < 512; i += G) { const int u = (i < 256) ? i : 767 - i;
                indexer_unit(PROJ, idxo, lds, (u & 3) * 128 + (u >> 2), tid, lane, wave); } if (rep) xcd_barrier(bar); }
        }
    }
    SEAM(3);
    if (IN(4)) { PH_IDS;
        bf16* PROJ = (bf16*)(ws + WS_PROJ); bf16* OA = (bf16*)(ws + WS_OA); bf16* OB = (bf16*)(ws + WS_OB);
        if (!(DBG_SKIP & 1)) { for (int rep = 0; rep < NREP(11); ++rep) { for (int u = vcu; u < 256; u += G) swa_unit(PROJ, OA, args.in[I_SINKS], lds, u, tid, lane, wave); if (rep) xcd_barrier(bar); } }
        else { for (size_t i = (size_t)bx * 512 + tid; i < (size_t)MTOK * 1024 / 8; i += (size_t)G * 512) ((v4u*)OA)[i] = (v4u){0u, 0u, 0u, 0u}; }
        if (!(DBG_SKIP & 2)) {
            const unsigned short* idx = (const unsigned short*)(ws + WS_IDX);
            LAS unsigned char* wl = lds + wave * DS_WAVE;
            const int gw = vcu * NWAVES + wave, NGW = G * NWAVES;
            for (int rep = 0; rep < NREP(4); ++rep) { for (int q = gw; q < MTOK; q += NGW) { const int qq = (q & 1) ? (MTOK - 1 - (q >> 1)) : (q >> 1); dsa_query(PROJ, idx, OB, wl, qq >> 11, qq & 2047, lane); } if (rep) xcd_barrier(bar); }
        } else { for (size_t i = (size_t)bx * 512 + tid; i < (size_t)MTOK * 1024 / 8; i += (size_t)G * 512) ((v4u*)OB)[i] = (v4u){0u, 0u, 0u, 0u}; }
        __syncthreads();
    }
    SEAM(4);
    if (IN(5)) { PH_IDS;
        pg8::Gemm g{(const bf16*)(ws + WS_OA), (const bf16*)(ws + WS_OB), (const bf16*)(ws + WS_WTA), (const bf16*)(ws + WS_WTB), 1024};
        pg8::PairOrder S; S.init(MTOK, DM, G, bx);
        pg8::EpiGate E{(bf16*)(ws + WS_PROJ), (bf16*)(ws + WS_T), (bf16*)(ws + WS_MRG)};
        for (int rep = 0; rep < NREP(5); ++rep) { pg8::gemm_phase<pg8::EpiGate, pg8::PairOrder, true, false>(lds, g, S, E); if (rep) xcd_barrier(bar); }
    }
    SEAM(5);
    if (IN(6)) { PH_IDS;
        pg8::Gemm g{(const bf16*)(ws + WS_MRG), nullptr, (const bf16*)(ws + WS_WTO), nullptr, DM};
        pg8::StaticOrder S; S.init(MTOK, DM, G, bx);
        pg8::EpiOut E{args.in[I_X], (const float*)(ws + WS_MODF), args.out};
        for (int rep = 0; rep < NREP(6); ++rep) { pg8::gemm_phase<pg8::EpiOut, pg8::StaticOrder, true, false>(lds, g, S, E); if (rep) xcd_barrier(bar); }
    }
    SEAM(6);
    if (IN(7)) { PH_IDS; if (!(DBG_SKIP & 4)) for (int u = vcu; u < 256; u += G) router_unit(args, lds, u, tid, lane, wave); }
    SEAM(7);
    if (IN(8)) { PH_IDS; if (!(DBG_SKIP & 4)) {
        moe_table(args, lds, tid);
        const LAS int* tb = (const LAS int*)(lds + MOE_TB_OFF); const LAS int* cn = tb + 40;
        wsg::Order S{tb, 8, G, vcu, tb[NEXP] * 8};
        for (int rep = 0; rep < NREP(8); ++rep) { wsg::ws_gemm2<true>(lds, args, S, cn); if (rep) xcd_barrier(bar); }
    } }
    SEAM(8);
    if (IN(9)) { PH_IDS; if (!(DBG_SKIP & 4)) {
        moe_table(args, lds, tid);
        const LAS int* tb = (const LAS int*)(lds + MOE_TB_OFF); const LAS int* cn = tb + 40;
        wsg::Order S{tb, 16, G, vcu, tb[NEXP] * 16};
        for (int rep = 0; rep < NREP(9); ++rep) { wsg::ws_gemm2<false>(lds, args, S, cn); if (rep) xcd_barrier(bar); }
    } }
    SEAM(9);
    if (IN(10)) { PH_IDS; if (!(DBG_SKIP & 4)) {
        moe_table(args, lds, tid);
        const LAS int* tb = (const LAS int*)(lds + MOE_TB_OFF);
        const int gw = vcu * NWAVES + wave, NGW = G * NWAVES;
        const float* modf = (const float*)(ws + WS_MODF); const bf16* Y = (const bf16*)(ws + WS_Y);
        for (int m = gw; m < MTOK; m += NGW) {
            const int b = m >> 11; const int* ti = (const int*)(ws + WS_TOK) + m * 4;
            const size_t r1 = (size_t)tb[ti[0]] * 256 + ti[1], r2 = (size_t)tb[ti[2]] * 256 + ti[3];
            float* orow = args.out + (size_t)m * DM;
#pragma unroll
            for (int j = 0; j < 4; ++j) { const int k = 8 * lane + 512 * j;
                const v4u y1 = *(const v4u*)(Y + r1 * DM + k), y2 = *(const v4u*)(Y + r2 * DM + k);
                const f32x4 g0 = *(const f32x4*)(modf + b * 12288 + 10240 + k), g1 = *(const f32x4*)(modf + b * 12288 + 10240 + k + 4);
                f32x4 x0 = *(const f32x4*)(orow + k), x1 = *(const f32x4*)(orow + k + 4);
                x0.x += g0.x * (bflo(y1.x) + bflo(y2.x)); x0.y += g0.y * (bfhi(y1.x) + bfhi(y2.x)); x0.z += g0.z * (bflo(y1.y) + bflo(y2.y)); x0.w += g0.w * (bfhi(y1.y) + bfhi(y2.y));
                x1.x += g1.x * (bflo(y1.z) + bflo(y2.z)); x1.y += g1.y * (bfhi(y1.z) + bfhi(y2.z)); x1.z += g1.z * (bflo(y1.w) + bflo(y2.w)); x1.w += g1.w * (bfhi(y1.w) + bfhi(y2.w));
                *(f32x4*)(orow + k) = x0; *(f32x4*)(orow + k + 4) = x1; }
        }
    } }
#undef IN
#undef SEAM
}

extern "C" void kernel_launch(void* const* d_in, const int* in_sizes, int n_in, void* d_out, int out_size, void* d_ws, size_t ws_size, hipStream_t stream) {
    static int grid = 0;
    if (grid == 0) {
        if (n_in != 22 || out_size != MTOK * DM || ws_size < WS_END) { fprintf(stderr, "kernel_launch: unexpected shapes (n_in %d, out %d, ws %zu < %zu)\n", n_in, out_size, ws_size, (size_t)WS_END); grid = -1; return; }
        int dev = 0, cus = 0;
        if (hipGetDevice(&dev) != hipSuccess || hipDeviceGetAttribute(&cus, hipDeviceAttributeMultiprocessorCount, dev) != hipSuccess) { grid = -1; return; }
        if (hipFuncSetAttribute((const void*)mk_fwd, hipFuncAttributeMaxDynamicSharedMemorySize, LDS_BYTES) != hipSuccess) { fprintf(stderr, "kernel_launch: hipFuncSetAttribute failed\n"); grid = -1; return; }
        int per_cu = 0;
        if (hipOccupancyMaxActiveBlocksPerMultiprocessor(&per_cu, (const void*)mk_fwd, NWAVES * 64, LDS_BYTES) != hipSuccess || per_cu < 1) fprintf(stderr, "kernel_launch: occupancy query says %d\n", per_cu);
        (void)hipGetLastError();
        grid = cus;
    }
    if (grid < 0) return;
    if (hipMemsetAsync((char*)d_ws + WS_CTL, 0, CTL_ZERO_BYTES, stream) != hipSuccess) { fprintf(stderr, "kernel_launch: memset failed\n"); return; }
    Args a{};
    for (int i = 0; i < 22; ++i) a.in[i] = (const float*)d_in[i];
    a.out = (float*)d_out; a.ws = (unsigned char*)d_ws;
#if MK_LAUNCH_PER_PHASE
    for (int p = 0; p < NPHASE; ++p) { a.ph_lo = p; a.ph_hi = p + 1; hipLaunchKernelGGL(mk_fwd, dim3(grid), dim3(NWAVES * 64), LDS_BYTES, stream, a); }
#else
    a.ph_lo = 0; a.ph_hi = NPHASE;
    hipLaunchKernelGGL(mk_fwd, dim3(grid), dim3(NWAVES * 64), LDS_BYTES, stream, a);
#endif
    const hipError_t le = hipPeekAtLastError();
    if (le != hipSuccess) fprintf(stderr, "kernel_launch: launch failed: %s\n", hipGetErrorName(le));
}
```

```cpp
#include <hip/hip_runtime.h>
#include <cstdio>
#include <cstdint>

#ifndef MK_LAUNCH_PER_PHASE
#define MK_LAUNCH_PER_PHASE 0
#endif
#ifndef DBG_SKIP
#define DBG_SKIP 0
#endif

#define GAS __attribute__((address_space(1)))
#define LAS __attribute__((address_space(3)))
typedef unsigned short bf16;
typedef unsigned v4u __attribute__((ext_vector_type(4)));
typedef unsigned v2u __attribute__((ext_vector_type(2)));
typedef float f32x4 __attribute__((ext_vector_type(4)));
typedef float f32x16 __attribute__((ext_vector_type(16)));
typedef short bf16x8 __attribute__((ext_vector_type(8)));
typedef short s16x4 __attribute__((ext_vector_type(4)));
typedef GAS unsigned gu32;

constexpr int NB = 4, SEQ = 2048, DM = 2048, MTOK = NB * SEQ;
constexpr int NPROJ = 7888, NPROJP = 7936;
constexpr int C_QA = 0, C_KA = 1024, C_VA = 1280, C_QB = 1536, C_KB = 2560, C_VB = 2624, C_QI = 2688, C_KI = 3712, C_WI = 3776, C_GA = 3792, C_GB = 5840;
constexpr int NEXP = 32, DEXP = 512, ECAP = 8192, PADROWS = 24576;
constexpr float LOG2E = 1.4426950408889634f;
constexpr float RMS_EPS = 1e-6f;
constexpr float NEGBIG = -1e30f;

constexpr size_t MiB = 1u << 20;
constexpr size_t WS_CTL = 0, CTL_ZERO_BYTES = 1 * MiB;
constexpr size_t WS_MODP = 1 * MiB;
constexpr size_t WS_MODF = 2 * MiB;
constexpr size_t WS_CB   = 2 * MiB + 512 * 1024;
constexpr size_t WS_TOK  = 2 * MiB + 768 * 1024;
constexpr size_t WS_ROWTOK = 3 * MiB;
constexpr size_t WS_ROWW = 4 * MiB;
constexpr size_t WS_IDX  = 5 * MiB;
constexpr size_t WS_WTIN = 9 * MiB;
constexpr size_t WS_WTA  = 40 * MiB, WS_WTB = 44 * MiB, WS_WTO = 48 * MiB;
constexpr size_t WS_WRH = 56 * MiB, WS_WRL = 57 * MiB;
constexpr size_t WS_WTGU = 60 * MiB;
constexpr size_t WS_WTD  = 184 * MiB;
constexpr size_t WS_H    = 248 * MiB;
constexpr size_t WS_PROJ = 280 * MiB;
constexpr size_t WS_Y    = WS_PROJ;
constexpr size_t WS_OA   = 404 * MiB, WS_OB = 420 * MiB;
constexpr size_t WS_T    = 436 * MiB;
constexpr size_t WS_MRG  = 468 * MiB;
constexpr size_t WS_ACT  = 500 * MiB;
constexpr size_t WS_END  = 524 * MiB;
constexpr int CW_BAR = 4096;
constexpr int CW_ECNT = 16384;

constexpr int RING_BYTES = 135168;
constexpr int LDSCTL_OFF = RING_BYTES, MISC_OFF = LDSCTL_OFF + 320;
constexpr int MOE_TB_OFF = LDSCTL_OFF + 1024;
constexpr int MOE_NOFF = LDSCTL_OFF + 2048;
constexpr int LDS_BYTES = 147456;
constexpr int NWAVES = 8;

#define RLX_AGENT __ATOMIC_RELAXED, __HIP_MEMORY_SCOPE_AGENT
#define LDS_WAIT() asm volatile("s_waitcnt lgkmcnt(0)" ::: "memory")
#define VM_WAIT() asm volatile("s_waitcnt vmcnt(0)" ::: "memory")

__device__ __forceinline__ unsigned cvt_pk_bf16(float lo, float hi) { unsigned r; asm volatile("v_cvt_pk_bf16_f32 %0, %1, %2" : "=v"(r) : "v"(lo), "v"(hi)); return r; }
__device__ __forceinline__ float bflo(unsigned w) { return __uint_as_float(w << 16); }
__device__ __forceinline__ float bfhi(unsigned w) { return __uint_as_float(w & 0xffff0000u); }
__device__ __forceinline__ float fast_exp2(float x) { return __builtin_amdgcn_exp2f(x); }
__device__ __forceinline__ float fast_rcp(float x) { return __builtin_amdgcn_rcpf(x); }
__device__ __forceinline__ float sigmoidf_(float x) { return fast_rcp(1.f + fast_exp2(-x * LOG2E)); }
__device__ __forceinline__ float wave_sum(float v) {
#pragma unroll
    for (int o = 1; o < 64; o <<= 1) v += __shfl_xor(v, o);
    return v;
}
__device__ __forceinline__ s16x4 tr_read(LAS const unsigned char* p) {
    typedef short v4i16_t __attribute__((ext_vector_type(4)));
    return __builtin_bit_cast(s16x4, __builtin_amdgcn_ds_read_tr16_b64_v4i16((LAS v4i16_t*)p));
}
__device__ __forceinline__ int crow(int r, int hi) { return (r & 3) + 8 * (r >> 2) + 4 * hi; }

namespace pg8 {
typedef unsigned short bf16_t;
typedef unsigned u32x4 __attribute__((ext_vector_type(4)));
constexpr int BM = 256, BK = 64, HALF = 128, HTB = HALF * BK * 2, STAGE_BYTES = 8 * HTB, NXCD = 8, WGM = 8;
__host__ __device__ __forceinline__ int lds_byte(int r, int c) { const int st = (r >> 4) * 2 + (c >> 5), rr = r & 15, cc = c & 31, ob = rr * 64 + cc * 2; return st * 1024 + (ob ^ (((ob >> 9) & 1) << 5)); }
__host__ __device__ __forceinline__ void stage_rc(int b, int& R, int& C) { const int st = b / 1024, sb = b % 1024, swz = sb ^ (((sb >> 9) & 1) << 5); R = (st >> 1) * 16 + swz / 64; C = (st & 1) * 32 + (swz % 64) / 2; }
__host__ __device__ __forceinline__ int perm32(int rho) { const int n = rho >> 4, i = rho & 15; return 8 * (i >> 2) + 4 * n + (i & 3); }

struct Unit { int pm, pn, pb, ga; };
struct Gemm { const bf16_t* A0; const bf16_t* A1; const bf16_t* B0; const bf16_t* B1; int K; };

struct StaticOrder {
    static constexpr bool PAIR = false;
    int nM, nN, nwg, G, c;
    __device__ void init(int M, int N, int G_, int c_) { nM = M / BM; nN = N / BM; nwg = nM * nN; G = G_; c = c_; }
    __device__ bool next(int i, Unit& u) const {
        const long L = (long)i * G + c; if (L >= nwg) return false;
        int wgid = (int)L; { const int q = nwg / NXCD, r = nwg % NXCD, xcd = wgid % NXCD, off = wgid / NXCD; wgid = (xcd < r ? xcd * (q + 1) : r * (q + 1) + (xcd - r) * q) + off; }
        const int nig = WGM * nN, gid = wgid / nig, fm = gid * WGM, gsz = (nM - fm) < WGM ? (nM - fm) : WGM;
        u.pm = fm + ((wgid % nig) % gsz); u.pn = (wgid % nig) / gsz; u.pb = u.pn; u.ga = 0; return true;
    }
    __device__ __forceinline__ unsigned arow(const Unit&, int) const { return 0u; }
};
struct PairOrder {
    static constexpr bool PAIR = true;
    int nM, nN, nwg, G, c;
    __device__ void init(int M, int N, int G_, int c_) { nM = M / BM; nN = N / BM; nwg = nM * nN; G = G_; c = c_; }
    __device__ bool next(int i, Unit& u) const {
        const long L = (long)(i >> 1) * G + c; if (L >= nwg) return false;
        int wgid = (int)L; { const int q = nwg / NXCD, r = nwg % NXCD, xcd = wgid % NXCD, off = wgid / NXCD; wgid = (xcd < r ? xcd * (q + 1) : r * (q + 1) + (xcd - r) * q) + off; }
        const int nig = WGM * nN, gid = wgid / nig, fm = gid * WGM, gsz = (nM - fm) < WGM ? (nM - fm) : WGM;
        u.pm = fm + ((wgid % nig) % gsz); u.pn = (wgid % nig) / gsz; u.pb = u.pn; u.ga = i & 1; return true;
    }
    __device__ __forceinline__ unsigned arow(const Unit&, int) const { return 0u; }
};
struct MoeOrder {
    static constexpr bool PAIR = false;
    const LAS int* tb; const LAS int* cnt; const int* rowtok; int npn, G, c, total; bool gather;
    __device__ bool next(int i, Unit& u) const {
        const int L = i * G + c; if (L >= total) return false;
        const int tile = L / npn, pn = L - tile * npn; int e = 0;
#pragma unroll
        for (int j = 1; j < NEXP; ++j) e += (tile >= tb[j]) ? 1 : 0;
        u.pm = tile; u.pn = pn; u.pb = e * npn + pn; u.ga = e; return true;
    }
    __device__ __forceinline__ unsigned arow(const Unit& u, int r) const {
        const int e = u.ga, local = (u.pm - tb[e]) * 256 + r;
        return (local < cnt[e]) ? (unsigned)rowtok[e * ECAP + local] : 0u;
    }
};

template <class Epi, class Sched, bool ALIGN_EPI, bool GATHER>
__device__ __forceinline__ void gemm_phase(LAS unsigned char* lds, const Gemm g, const Sched& S, const Epi& E) {
    const int tid = threadIdx.x, wid = __builtin_amdgcn_readfirstlane(tid >> 6), lane = tid & 63, wr = wid >> 2, wc = wid & 3, fr = lane & 15, fq = lane >> 4;
    const int K = g.K, nt = K / BK;
    unsigned voffA[2], voffB[2]; int RA[2], CA[2];
#pragma unroll
    for (int i = 0; i < 2; ++i) { int R, C; stage_rc(tid * 16 + i * 8192, R, C); const int Rb = Epi::PERM ? ((R & ~31) + perm32(R & 31)) : R;
        RA[i] = R; CA[i] = C; voffA[i] = (unsigned)(R * K + C) * 2u; voffB[i] = (unsigned)(Rb * K + C) * 2u; }
    const size_t kstep = (size_t)(BK * 2);
    const size_t hstep = (size_t)HALF * K * 2;
    const size_t tstep = 2 * hstep;
    const unsigned ldsw = (unsigned)wid * 1024u;
    const int aoff = lds_byte(wr * 64 + fr, fq * 8), boff = lds_byte(wc * 32 + fr, fq * 8);
    LAS unsigned* noff = (LAS unsigned*)(lds + MOE_NOFF) + tid * 4;
#define PG8_SA(b, h) (((b) * 2 + (h)) * HTB)
#define PG8_SB(b, h) ((4 + (b) * 2 + (h)) * HTB)
#define PG8_STAGE(bufoff, gbase, voff) do { _Pragma("unroll") for (int _i = 0; _i < 2; ++_i) \
        __builtin_amdgcn_global_load_lds((const unsigned*)((const char*)(gbase) + (voff)[_i]), (LAS unsigned*)(lds + (bufoff) + ldsw + _i * 8192), 16, 0, 0); } while (0)
#define PG8_LDA(dst, b, h) do { _Pragma("unroll") for (int m = 0; m < 4; ++m) _Pragma("unroll") for (int k = 0; k < 2; ++k) dst[m][k] = *(const LAS bf16x8*)(lds + PG8_SA(b, h) + aoff + m * 2048 + k * 1024); } while (0)
#define PG8_LDB(dst, b, h) do { _Pragma("unroll") for (int n = 0; n < 2; ++n) _Pragma("unroll") for (int k = 0; k < 2; ++k) dst[n][k] = *(const LAS bf16x8*)(lds + PG8_SB(b, h) + boff + n * 2048 + k * 1024); } while (0)
#define PG8_MMA(ai, bj, At, Bt) do { __builtin_amdgcn_s_setprio(1); _Pragma("unroll") for (int m = 0; m < 4; ++m) _Pragma("unroll") for (int n = 0; n < 2; ++n) _Pragma("unroll") for (int k = 0; k < 2; ++k) \
        acc[ai][bj][m][n] = __builtin_amdgcn_mfma_f32_16x16x32_bf16(Bt[n][k], At[m][k], acc[ai][bj][m][n], 0, 0, 0); __builtin_amdgcn_s_setprio(0); } while (0)
#define PG8_WAIT_V(n) asm volatile("s_waitcnt vmcnt(" #n ")" ::: "memory")
#define PG8_WAIT_L(n) asm volatile("s_waitcnt lgkmcnt(" #n ")" ::: "memory")
#define PG8_BAR __builtin_amdgcn_s_barrier()
#define PG8_SCHED __builtin_amdgcn_sched_barrier(0)
    Unit cur, nxt; int ui = 0;
    if (!S.next(0, cur)) return;
    f32x4 acc[2][2][4][2];
#pragma unroll
    for (int a = 0; a < 2; ++a)
#pragma unroll
        for (int b = 0; b < 2; ++b)
#pragma unroll
            for (int m = 0; m < 4; ++m)
#pragma unroll
                for (int n = 0; n < 2; ++n) acc[a][b][m][n] = (f32x4){0.f, 0.f, 0.f, 0.f};
    bf16x8 At[4][2], B0[2][2], B1[2][2];
    unsigned cO0[2], cO1[2];
    const char* cA; const char* cB;
    if constexpr (GATHER) {
        cA = (const char*)g.A0;
#pragma unroll
        for (int i = 0; i < 2; ++i) { cO0[i] = S.arow(cur, RA[i]) * (unsigned)(K * 2) + (unsigned)CA[i] * 2u; cO1[i] = S.arow(cur, HALF + RA[i]) * (unsigned)(K * 2) + (unsigned)CA[i] * 2u; }
    } else {
        cA = (const char*)((Sched::PAIR && cur.ga) ? g.A1 : g.A0) + (size_t)cur.pm * tstep;
#pragma unroll
        for (int i = 0; i < 2; ++i) { cO0[i] = voffA[i]; cO1[i] = voffA[i] + (unsigned)hstep; }
    }
    cB = (const char*)((Sched::PAIR && cur.ga) ? g.B1 : g.B0) + (size_t)cur.pb * tstep;
    PG8_STAGE(PG8_SB(0, 0), cB, voffB); PG8_STAGE(PG8_SB(0, 1), cB + hstep, voffB); PG8_STAGE(PG8_SA(0, 0), cA, cO0); PG8_STAGE(PG8_SA(0, 1), cA, cO1);
    if (wr == 1) PG8_BAR;
    PG8_WAIT_V(2); PG8_BAR;
    PG8_STAGE(PG8_SB(1, 0), cB + kstep, voffB); PG8_STAGE(PG8_SA(1, 0), cA + kstep, cO0); PG8_STAGE(PG8_SB(1, 1), cB + hstep + kstep, voffB);
    PG8_WAIT_V(6); PG8_BAR;
    for (;;) {
        const bool has_next = S.next(ui + 1, nxt);
        const char* nA; const char* nB;
        if constexpr (GATHER) {
            nA = cA;
            if (has_next) {
                u32x4 o; o.x = S.arow(nxt, RA[0]) * (unsigned)(K * 2) + (unsigned)CA[0] * 2u; o.y = S.arow(nxt, RA[1]) * (unsigned)(K * 2) + (unsigned)CA[1] * 2u;
                o.z = S.arow(nxt, HALF + RA[0]) * (unsigned)(K * 2) + (unsigned)CA[0] * 2u; o.w = S.arow(nxt, HALF + RA[1]) * (unsigned)(K * 2) + (unsigned)CA[1] * 2u;
                *(LAS u32x4*)noff = o;
            } else { u32x4 o; o.x = cO0[0]; o.y = cO0[1]; o.z = cO1[0]; o.w = cO1[1]; *(LAS u32x4*)noff = o; }
        } else {
            nA = has_next ? (const char*)((Sched::PAIR && nxt.ga) ? g.A1 : g.A0) + (size_t)nxt.pm * tstep : cA;
        }
        nB = has_next ? (const char*)((Sched::PAIR && nxt.ga) ? g.B1 : g.B0) + (size_t)nxt.pb * tstep : cB;
        for (int t = 0; t < nt; t += 2) {
            const bool last = (t == nt - 2);
            const char* a1 = cA + (size_t)(t + 1) * kstep;
            const char* a2 = last ? nA : cA + (size_t)(t + 2) * kstep; const char* b2 = last ? nB : cB + (size_t)(t + 2) * kstep;
            const char* a3 = a2 + kstep; const char* b3 = b2 + kstep;
            unsigned sO0[2], sO1[2];
            if constexpr (GATHER) {
                if (last) { const u32x4 o = *(const LAS u32x4*)noff; sO0[0] = o.x; sO0[1] = o.y; sO1[0] = o.z; sO1[1] = o.w; }
                else { sO0[0] = cO0[0]; sO0[1] = cO0[1]; sO1[0] = cO1[0]; sO1[1] = cO1[1]; }
            } else { sO0[0] = cO0[0]; sO0[1] = cO0[1]; sO1[0] = cO1[0]; sO1[1] = cO1[1]; }
            PG8_LDB(B0, 0, 0); PG8_LDB(B1, 0, 1); PG8_SCHED; PG8_LDA(At, 0, 0); PG8_STAGE(PG8_SA(1, 1), a1, cO1);
            PG8_WAIT_V(8); PG8_WAIT_L(0); PG8_BAR; PG8_MMA(0, 0, At, B0); PG8_MMA(0, 1, At, B1); PG8_BAR; PG8_SCHED;
            PG8_LDA(At, 0, 1); PG8_STAGE(PG8_SB(0, 0), b2, voffB); PG8_STAGE(PG8_SB(0, 1), b2 + hstep, voffB); PG8_STAGE(PG8_SA(0, 0), a2, sO0);
            PG8_WAIT_V(8); PG8_WAIT_L(0); PG8_BAR; PG8_MMA(1, 0, At, B0); PG8_MMA(1, 1, At, B1); PG8_BAR; PG8_SCHED;
            PG8_LDB(B0, 1, 0); PG8_LDB(B1, 1, 1); PG8_SCHED; PG8_LDA(At, 1, 0); PG8_STAGE(PG8_SA(0, 1), a2, sO1);
            PG8_WAIT_V(8); PG8_WAIT_L(0); PG8_BAR; PG8_MMA(0, 0, At, B0); PG8_MMA(0, 1, At, B1); PG8_BAR; PG8_SCHED;
            PG8_LDA(At, 1, 1); PG8_STAGE(PG8_SB(1, 0), b3, voffB); PG8_STAGE(PG8_SB(1, 1), b3 + hstep, voffB); PG8_STAGE(PG8_SA(1, 0), a3, sO0);
            PG8_WAIT_V(8); PG8_WAIT_L(0); PG8_BAR; PG8_MMA(1, 0, At, B0); PG8_MMA(1, 1, At, B1); PG8_BAR; PG8_SCHED;
        }
        if constexpr (ALIGN_EPI) { if (wr == 0) PG8_BAR; }
        E(acc, cur, wr, wc, fr, fq);
        if (!has_next) break;
#pragma unroll
        for (int a = 0; a < 2; ++a)
#pragma unroll
            for (int b = 0; b < 2; ++b)
#pragma unroll
                for (int m = 0; m < 4; ++m)
#pragma unroll
                    for (int n = 0; n < 2; ++n) acc[a][b][m][n] = (f32x4){0.f, 0.f, 0.f, 0.f};
        cur = nxt; cA = nA; cB = nB; ++ui;
        if constexpr (GATHER) { const u32x4 o = *(const LAS u32x4*)noff; cO0[0] = o.x; cO0[1] = o.y; cO1[0] = o.z; cO1[1] = o.w; }
        if constexpr (ALIGN_EPI) { if (wr == 1) PG8_BAR; }
    }
    PG8_WAIT_V(0);
    if constexpr (!ALIGN_EPI) { if (wr == 0) PG8_BAR; }
    PG8_BAR;
#undef PG8_SA
#undef PG8_SB
#undef PG8_STAGE
#undef PG8_LDA
#undef PG8_LDB
#undef PG8_MMA
#undef PG8_WAIT_V
#undef PG8_WAIT_L
#undef PG8_BAR
#undef PG8_SCHED
}

struct EpiStore {
    static constexpr bool PERM = true;
    bf16_t* O; int ldc;
    __device__ __forceinline__ void operator()(const f32x4 (&acc)[2][2][4][2], const Unit& u, int wr, int wc, int fr, int fq) const {
        const int row0 = u.pm * BM + wr * 64 + fr, col0 = u.pn * BM + wc * 32 + 8 * fq;
#pragma unroll
        for (int ai = 0; ai < 2; ++ai)
#pragma unroll
            for (int m = 0; m < 4; ++m) { bf16_t* rowp = O + (size_t)(row0 + ai * HALF + m * 16) * ldc + col0;
#pragma unroll
                for (int bj = 0; bj < 2; ++bj) { const f32x4 v0 = acc[ai][bj][m][0], v1 = acc[ai][bj][m][1];
                    u32x4 w; w.x = cvt_pk_bf16(v0[0], v0[1]); w.y = cvt_pk_bf16(v0[2], v0[3]); w.z = cvt_pk_bf16(v1[0], v1[1]); w.w = cvt_pk_bf16(v1[2], v1[3]);
                    *(u32x4*)(rowp + bj * HALF) = w; } }
    }
};
struct EpiGate {
    static constexpr bool PERM = true;
    const bf16_t* proj; bf16_t* T; bf16_t* mrg;
    __device__ __forceinline__ void operator()(const f32x4 (&acc)[2][2][4][2], const Unit& u, int wr, int wc, int fr, int fq) const {
        const int row0 = u.pm * BM + wr * 64 + fr, col0 = u.pn * BM + wc * 32 + 8 * fq;
        const int gcol = (u.ga ? C_GB : C_GA) + col0;
#pragma unroll
        for (int ai = 0; ai < 2; ++ai)
#pragma unroll
            for (int m = 0; m < 4; ++m) { const size_t row = (size_t)(row0 + ai * HALF + m * 16);
#pragma unroll
                for (int bj = 0; bj < 2; ++bj) { const f32x4 v0 = acc[ai][bj][m][0], v1 = acc[ai][bj][m][1];
                    const u32x4 gt = *(const u32x4*)(proj + row * NPROJP + gcol + bj * HALF);
                    float r[8];
                    r[0] = v0[0] * sigmoidf_(bflo(gt.x)); r[1] = v0[1] * sigmoidf_(bfhi(gt.x)); r[2] = v0[2] * sigmoidf_(bflo(gt.y)); r[3] = v0[3] * sigmoidf_(bfhi(gt.y));
                    r[4] = v1[0] * sigmoidf_(bflo(gt.z)); r[5] = v1[1] * sigmoidf_(bfhi(gt.z)); r[6] = v1[2] * sigmoidf_(bflo(gt.w)); r[7] = v1[3] * sigmoidf_(bfhi(gt.w));
                    bf16_t* tp = T + row * DM + col0 + bj * HALF;
                    if (u.ga) { const u32x4 tv = *(const u32x4*)tp;
                        r[0] += bflo(tv.x); r[1] += bfhi(tv.x); r[2] += bflo(tv.y); r[3] += bfhi(tv.y); r[4] += bflo(tv.z); r[5] += bfhi(tv.z); r[6] += bflo(tv.w); r[7] += bfhi(tv.w); }
                    u32x4 w; w.x = cvt_pk_bf16(r[0], r[1]); w.y = cvt_pk_bf16(r[2], r[3]); w.z = cvt_pk_bf16(r[4], r[5]); w.w = cvt_pk_bf16(r[6], r[7]);
                    *(u32x4*)((u.ga ? mrg : T) + row * DM + col0 + bj * HALF) = w; } }
    }
};
struct EpiOut {
    static constexpr bool PERM = true;
    const float* x; const float* modf; float* out;
    __device__ __forceinline__ void operator()(const f32x4 (&acc)[2][2][4][2], const Unit& u, int wr, int wc, int fr, int fq) const {
        const int row0 = u.pm * BM + wr * 64 + fr, col0 = u.pn * BM + wc * 32 + 8 * fq;
        const int b = (u.pm * BM) >> 11;
        f32x4 gv[2][2];
#pragma unroll
        for (int bj = 0; bj < 2; ++bj)
#pragma unroll
            for (int n = 0; n < 2; ++n) gv[bj][n] = *(const f32x4*)(modf + b * 12288 + 4096 + col0 + bj * HALF + 4 * n);
#pragma unroll
        for (int ai = 0; ai < 2; ++ai)
#pragma unroll
            for (int m = 0; m < 4; ++m) { const size_t off = (size_t)(row0 + ai * HALF + m * 16) * DM + col0;
#pragma unroll
                for (int bj = 0; bj < 2; ++bj)
#pragma unroll
                    for (int n = 0; n < 2; ++n) { const f32x4 xv = *(const f32x4*)(x + off + bj * HALF + 4 * n);
                        *(f32x4*)(out + off + bj * HALF + 4 * n) = xv + gv[bj][n] * acc[ai][bj][m][n]; } }
    }
};
struct EpiMoeGU {
    static constexpr bool PERM = true;
    bf16_t* act; const float* roww; const LAS int* tb; const LAS int* cnt;
    __device__ __forceinline__ void operator()(const f32x4 (&acc)[2][2][4][2], const Unit& u, int wr, int wc, int fr, int fq) const {
        const int e = u.ga, lbase = (u.pm - tb[e]) * 256, n_e = cnt[e];
        const int r0 = wr * 64 + fr, col0 = u.pn * HALF + wc * 32 + 8 * fq;
#pragma unroll
        for (int ai = 0; ai < 2; ++ai)
#pragma unroll
            for (int m = 0; m < 4; ++m) { const int r = r0 + ai * HALF + m * 16; const int local = lbase + r;
                const float w = (local < n_e) ? roww[e * ECAP + local] : 0.f;
                float o[8];
#pragma unroll
                for (int n = 0; n < 2; ++n)
#pragma unroll
                    for (int j = 0; j < 4; ++j) { const float gte = acc[ai][0][m][n][j], up = acc[ai][1][m][n][j]; o[4 * n + j] = gte * sigmoidf_(gte) * up * w; }
                u32x4 wv; wv.x = cvt_pk_bf16(o[0], o[1]); wv.y = cvt_pk_bf16(o[2], o[3]); wv.z = cvt_pk_bf16(o[4], o[5]); wv.w = cvt_pk_bf16(o[6], o[7]);
                *(u32x4*)(act + (size_t)(u.pm * 256 + r) * DEXP + col0) = wv; }
    }
};
}

#define XB_TMO      128
#define XB_XCNT(j)  (256  + 64 * (j))
#define XB_XSUB(j)  (1280 + 64 * (j))
#define XB_XGEN(j)  (2304 + 64 * (j))
#define XB_TOP      3328
#define XB_TOPGEN   3392
#define XCD_BAR_WORDS 3456
#define XB_SPIN_CAP (1u << 18)
__device__ __forceinline__ unsigned xb_ld(unsigned* p)              { return __hip_atomic_load(p, __ATOMIC_RELAXED, __HIP_MEMORY_SCOPE_AGENT); }
__device__ __forceinline__ unsigned xb_add(unsigned* p, unsigned v) { return __hip_atomic_fetch_add(p, v, __ATOMIC_RELAXED, __HIP_MEMORY_SCOPE_AGENT); }
__device__ __forceinline__ unsigned xb_xcc_id() { return (unsigned)__builtin_amdgcn_s_getreg((3 << 11) | 20) & 0xFu; }
#define XB_SPIN(cond, bar) do { unsigned _sp = 0; while (cond) { __builtin_amdgcn_s_sleep(1); \
    if ((++_sp & 255u) == 0u) { if (xb_ld(&(bar)[XB_TMO])) break; if (_sp > XB_SPIN_CAP) { atomicAdd(&(bar)[XB_TMO], 1u); break; } } } } while (0)
struct XcdBarrier { unsigned* bar; unsigned x; volatile LAS unsigned* st; };
__device__ __forceinline__ XcdBarrier xcd_barrier_post(unsigned* bar, volatile LAS unsigned* st) {
    XcdBarrier b; b.bar = bar; b.x = xb_xcc_id(); b.st = st;
    if (threadIdx.x == 0) (void)xb_add(&bar[XB_XCNT(b.x)], 1u);
    return b;
}
__device__ __forceinline__ void xcd_barrier_complete(unsigned* bar, unsigned x, unsigned& nloc, unsigned& nx) {
    const unsigned G = gridDim.x * gridDim.y * gridDim.z;
    unsigned sum, cnt, mine, sp = 0u;
    for (;;) {
        sum = 0u; cnt = 0u; mine = 0u;
#pragma unroll
        for (unsigned j = 0; j < 16; ++j) { const unsigned c = xb_ld(&bar[XB_XCNT(j)]); sum += c; cnt += (c > 0u) ? 1u : 0u; mine = (j == x) ? c : mine; }
        if (sum == G) break;
        __builtin_amdgcn_s_sleep(1);
        if ((++sp & 255u) == 0u) { if (xb_ld(&bar[XB_TMO])) break; if (sp > XB_SPIN_CAP) { atomicAdd(&bar[XB_TMO], 1u); break; } }
    }
    nloc = mine > 0u ? mine : 1u; nx = cnt > 0u ? cnt : 1u;
}
__device__ __forceinline__ void xcd_barrier(const XcdBarrier& b) {
    asm volatile("s_waitcnt vmcnt(0)" ::: "memory");
    __syncthreads();
    if (threadIdx.x == 0) {
        unsigned* bar = b.bar;
        __builtin_amdgcn_s_waitcnt(0);
        unsigned nloc = b.st[0], nx = b.st[1];
        if (nloc == 0u) { xcd_barrier_complete(bar, b.x, nloc, nx); b.st[0] = nloc; b.st[1] = nx; }
        const unsigned old = xb_add(&bar[XB_XSUB(b.x)], 1u);
        const unsigned gen = old / nloc;
        if (old + 1u == (gen + 1u) * nloc) {
            __builtin_amdgcn_fence(__ATOMIC_RELEASE, "agent");
            asm volatile("s_waitcnt vmcnt(0)" ::: "memory");
            const unsigned og = xb_add(&bar[XB_TOP], 1u);
            const unsigned tg = og / nx;
            if (og + 1u == (tg + 1u) * nx) xb_add(&bar[XB_TOPGEN], 1u);
            else XB_SPIN(xb_ld(&bar[XB_TOPGEN]) == tg, bar);
            __builtin_amdgcn_fence(__ATOMIC_ACQUIRE, "agent");
            xb_add(&bar[XB_XGEN(b.x)], 1u);
            asm volatile("s_waitcnt vmcnt(0)" ::: "memory");
        } else {
            XB_SPIN(xb_ld(&bar[XB_XGEN(b.x)]) == gen, bar);
            __builtin_amdgcn_fence(__ATOMIC_ACQUIRE, "agent");
            asm volatile("s_waitcnt vmcnt(0)" ::: "memory");
        }
    }
    __syncthreads();
}

struct Args { const float* in[22]; float* out; unsigned char* ws; int ph_lo, ph_hi; };
typedef __attribute__((address_space(4))) const Args KArgs;
__device__ __forceinline__ KArgs* kargs() { KArgs* p = (KArgs*)__builtin_amdgcn_kernarg_segment_ptr(); asm volatile("" : "+s"(p)); return p; }
enum { I_X = 0, I_C, I_WADA, I_BADA, I_LN1G, I_WIN, I_SWAQN, I_SWAKN, I_SINKS, I_DSAQN, I_DSAKN, I_WBA, I_WBB, I_WOUT, I_LN2G, I_WGRP, I_BGRP, I_WEXP, I_BEXP, I_WGU, I_WUP, I_WDN };

__device__ __forceinline__ void p0_adaln_item(KArgs& a, LAS unsigned char* lds, int j, int tid) {
    LAS float* condl = (LAS float*)lds;
    LAS float* red = (LAS float*)(lds + 8192);
    const int cr = j & 63, kq = j >> 6;
    const float* cin = a.in[I_C];
    for (int i = tid; i < 2048; i += 512) { const int kk = i >> 2, b = i & 3; const float c = cin[b * 2048 + kq * 512 + kk]; condl[kk * 4 + b] = c * fast_rcp(1.f + __expf(-c)); }
    __syncthreads();
    if (tid < 480) {
        const int cg = tid % 48, ks = tid / 48;
        const float* wp = a.in[I_WADA] + (size_t)(kq * 512) * 12288 + cr * 192 + cg * 4;
        f32x4 acc[4];
#pragma unroll
        for (int b = 0; b < 4; ++b) acc[b] = (f32x4){0.f, 0.f, 0.f, 0.f};
#pragma unroll 13
        for (int kk = ks; kk < 512; kk += 10) {
            const f32x4 w = *(const f32x4*)(wp + (size_t)kk * 12288);
            const f32x4 c = *(const LAS f32x4*)(condl + kk * 4);
            acc[0] += c.x * w; acc[1] += c.y * w; acc[2] += c.z * w; acc[3] += c.w * w;
        }
#pragma unroll
        for (int b = 0; b < 4; ++b) *(LAS f32x4*)(red + (ks * 4 + b) * 192 + cg * 4) = acc[b];
    }
    __syncthreads();
    float* modp = (float*)(a.ws + WS_MODP);
    for (int o = tid; o < 768; o += 512) { const int b = o / 192, col = o % 192; float s = 0.f;
#pragma unroll
        for (int ks = 0; ks < 10; ++ks) s += red[(ks * 4 + b) * 192 + col];
        modp[(kq * 4 + b) * 12288 + cr * 192 + col] = s; }
    __syncthreads();
}
__device__ __forceinline__ void tr_item(const float* W, int N, int Nvalid, int K, bf16* WT, int drow0, int k0, int n0, LAS unsigned char* scr, int lane) {
    const int n4 = lane & 15, kr = lane >> 4;
    const bool ok = (n0 + 4 * n4) < Nvalid;
    f32x4 v[16];
#pragma unroll
    for (int i = 0; i < 16; ++i) v[i] = ok ? *(const f32x4*)(W + (size_t)(k0 + kr + 4 * i) * N + n0 + 4 * n4) : (f32x4){0.f, 0.f, 0.f, 0.f};
#pragma unroll
    for (int i = 0; i < 16; ++i) { const int k = kr + 4 * i, pos = (k & ~12) | ((k & 4) << 1) | ((k & 8) >> 1);
        v2u w; w.x = cvt_pk_bf16(v[i].x, v[i].y); w.y = cvt_pk_bf16(v[i].z, v[i].w); *(LAS v2u*)(scr + pos * 160 + n4 * 8) = w; }
    LDS_WAIT(); asm volatile("" ::: "memory");
    const int i16 = lane & 15, g = lane >> 4;
    LAS const unsigned char* rd = scr + (4 * (g & 1) + 16 * (g >> 1) + (i16 >> 2)) * 160 + 8 * (i16 & 3);
#pragma unroll
    for (int nt = 0; nt < 4; ++nt)
#pragma unroll
        for (int kh = 0; kh < 2; ++kh) {
            const s16x4 vl = tr_read(rd + (32 * kh) * 160 + 32 * nt), vh = tr_read(rd + (32 * kh + 8) * 160 + 32 * nt);
            v4u o = __builtin_bit_cast(v4u, (bf16x8){vl[0], vl[1], vl[2], vl[3], vh[0], vh[1], vh[2], vh[3]});
            *(v4u*)(WT + (size_t)(drow0 + 16 * nt + i16) * K + k0 + 32 * kh + 8 * g) = o; }
    LDS_WAIT(); asm volatile("" ::: "memory");
}
__device__ __forceinline__ void p0_prologue(KArgs& a, LAS unsigned char* lds, int vcu, int G, int tid, int lane, int wave) {
    for (int j = vcu; j < 256; j += G) p0_adaln_item(a, lds, j, tid);
    LAS unsigned char* scr = lds + wave * 10240;
    const int gw = vcu * NWAVES + wave, NGW = G * NWAVES;
    constexpr int I_IN = 32 * 124, I_BR = 16 * 32, I_OUT = 32 * 32;
    constexpr int NITEMS = I_IN + 2 * I_BR + I_OUT;
    unsigned char* ws = a.ws;
    for (int it = gw; it < NITEMS; it += NGW) {
        int r = it;
        if (r < I_IN) { const int kb = r / 124, nb = r % 124; tr_item(a.in[I_WIN], NPROJ, NPROJ, 2048, (bf16*)(ws + WS_WTIN), 64 * nb, 64 * kb, 64 * nb, scr, lane); continue; } r -= I_IN;
        if (r < I_BR) { const int kb = r / 32, nb = r % 32; tr_item(a.in[I_WBA], 2048, 2048, 1024, (bf16*)(ws + WS_WTA), 64 * nb, 64 * kb, 64 * nb, scr, lane); continue; } r -= I_BR;
        if (r < I_BR) { const int kb = r / 32, nb = r % 32; tr_item(a.in[I_WBB], 2048, 2048, 1024, (bf16*)(ws + WS_WTB), 64 * nb, 64 * kb, 64 * nb, scr, lane); continue; } r -= I_BR;
        { const int kb = r / 32, nb = r % 32; tr_item(a.in[I_WOUT], 2048, 2048, 2048, (bf16*)(ws + WS_WTO), 64 * nb, 64 * kb, 64 * nb, scr, lane); }
    }
    __syncthreads();
}

__device__ __forceinline__ float modval(const float* modp, const float* bada, int b, int n) {
    return ((modp[(0 * 4 + b) * 12288 + n] + modp[(1 * 4 + b) * 12288 + n]) + (modp[(2 * 4 + b) * 12288 + n] + modp[(3 * 4 + b) * 12288 + n])) + bada[n];
}
__device__ __forceinline__ void p1_norm1(KArgs& a, LAS unsigned char* lds, int vcu, int G, int tid, int lane, int wave) {
    const float* modp = (const float*)(a.ws + WS_MODP); const float* bada = a.in[I_BADA];
    float* modf = (float*)(a.ws + WS_MODF);
    LAS float* A4 = (LAS float*)lds; LAS float* B4 = A4 + 2048;
    const float* g1 = a.in[I_LN1G];
    for (int i = vcu * 512 + tid; i < 4 * 12288; i += G * 512) { const int b = i / 12288, n = i % 12288; modf[i] = modval(modp, bada, b, n); }
    { bf16* wrh = (bf16*)(a.ws + WS_WRH); bf16* wrl = (bf16*)(a.ws + WS_WRL);
      for (int i = vcu * 512 + tid; i < 64 * 2048; i += G * 512) { const int n = i >> 11, k = i & 2047;
          const float w = (n < 32) ? a.in[I_WEXP][k * 32 + n] : (n < 36) ? a.in[I_WGRP][k * 4 + (n - 32)] : 0.f;
          const unsigned hi = cvt_pk_bf16(w, 0.f) & 0xffffu; const float lo = w - bflo(hi);
          wrh[i] = (bf16)hi; wrl[i] = (bf16)(cvt_pk_bf16(lo, 0.f) & 0xffffu); } }
    const float* x = a.in[I_X]; bf16* H = (bf16*)(a.ws + WS_H);
    for (int blk = vcu; blk < 256; blk += G) {
        const int b = blk >> 6;
        __syncthreads();
        for (int k = tid; k < 2048; k += 512) { A4[k] = g1[k] * (1.f + modval(modp, bada, b, 2048 + k)); B4[k] = modval(modp, bada, b, k); }
        __syncthreads();
#pragma unroll 1
        for (int i = 0; i < 4; ++i) {
            const int m = blk * 32 + wave * 4 + i;
            const f32x4* xr = (const f32x4*)(x + (size_t)m * DM) + lane;
            f32x4 v[8]; float s = 0.f;
#pragma unroll
            for (int j = 0; j < 8; ++j) { v[j] = xr[64 * j]; s += (v[j].x * v[j].x + v[j].y * v[j].y) + (v[j].z * v[j].z + v[j].w * v[j].w); }
            const float rstd = 1.f / sqrtf(wave_sum(s) * (1.f / DM) + RMS_EPS);
            unsigned long long* o8 = (unsigned long long*)(H + (size_t)m * DM) + lane;
#pragma unroll
            for (int j = 0; j < 8; ++j) { const int k = 4 * lane + 256 * j; const f32x4 A = *(const LAS f32x4*)(A4 + k), Bv = *(const LAS f32x4*)(B4 + k);
                const f32x4 y = v[j] * rstd * A + Bv;
                o8[64 * j] = (unsigned long long)cvt_pk_bf16(y.x, y.y) | ((unsigned long long)cvt_pk_bf16(y.z, y.w) << 32); }
        }
    }
}

__device__ __forceinline__ void prep_norms(KArgs& a, int vcu, int G, int lane, int wave) {
    bf16* proj = (bf16*)(a.ws + WS_PROJ);
    const int gw = vcu * NWAVES + wave, NGW = G * NWAVES;
    const int sub = lane & 7, grp = lane >> 3;
    const float qs = 0.125f * LOG2E;
    for (int m = gw; m < MTOK; m += NGW) {
#pragma unroll
        for (int s = 0; s < 5; ++s) {
            const int hv = 8 * s + grp;
            if (hv < 37) {
                const int col = (hv < 20) ? 64 * hv : 256 + 64 * hv;
                const float* gain = (hv < 16) ? a.in[I_SWAQN] : (hv < 20) ? a.in[I_SWAKN] : (hv < 36) ? a.in[I_DSAQN] : a.in[I_DSAKN];
                const float sc = (hv < 16 || (hv >= 20 && hv < 36)) ? qs : 1.f;
                bf16* p = proj + (size_t)m * NPROJP + col + sub * 8;
                const v4u w = *(const v4u*)p;
                float f[8] = {bflo(w.x), bfhi(w.x), bflo(w.y), bfhi(w.y), bflo(w.z), bfhi(w.z), bflo(w.w), bfhi(w.w)};
                float ss = 0.f;
#pragma unroll
                for (int i = 0; i < 8; ++i) ss += f[i] * f[i];
                ss += __shfl_xor(ss, 1); ss += __shfl_xor(ss, 2); ss += __shfl_xor(ss, 4);
                const float r = sc / sqrtf(ss * (1.f / 64.f) + RMS_EPS);
                const f32x4 g0 = *(const f32x4*)(gain + sub * 8), g1 = *(const f32x4*)(gain + sub * 8 + 4);
                v4u o; o.x = cvt_pk_bf16(f[0] * r * g0.x, f[1] * r * g0.y); o.y = cvt_pk_bf16(f[2] * r * g0.z, f[3] * r * g0.w);
                o.z = cvt_pk_bf16(f[4] * r * g1.x, f[5] * r * g1.y); o.w = cvt_pk_bf16(f[6] * r * g1.z, f[7] * r * g1.w);
                *(v4u*)p = o;
            }
        }
    }
}
__device__ __forceinline__ unsigned f2key(float f) { const unsigned u = __float_as_uint(f); return (u & 0x80000000u) ? ~u : (u | 0x80000000u); }
__device__ __forceinline__ unsigned half_sum(unsigned v) {
    v += (unsigned)__builtin_amdgcn_update_dpp(0, (int)v, 0xB1, 0xF, 0xF, false);
    v += (unsigned)__builtin_amdgcn_update_dpp(0, (int)v, 0x4E, 0xF, 0xF, false);
    v += (unsigned)__builtin_amdgcn_update_dpp(0, (int)v, 0x141, 0xF, 0xF, false);
    v += (unsigned)__builtin_amdgcn_update_dpp(0, (int)v, 0x140, 0xF, 0xF, false);
    v += (unsigned)__builtin_amdgcn_ds_swizzle((int)v, 0x401F);
    return v;
}
constexpr int IX_KBUF = 36864;
constexpr int IX_LST = 2 * IX_KBUF;
__device__ __forceinline__ void indexer_unit(const bf16* proj, unsigned short* idxo, LAS unsigned char* lds, int u, int tid, int lane, int wave) {
    const int b = u >> 7, q0 = (u & 127) << 4;
    const int r32 = lane & 31, hi = lane >> 5;
    const int tq = q0 + 2 * wave + hi;
    const int NT = (q0 + 47) >> 5, NC = (NT + 7) >> 3;
    bf16x8 aq[4]; float wv[16];
    {
        const int sel = (r32 >> 2) & 1, head = (r32 & 3) + 4 * (r32 >> 3);
        const bf16* qrow = proj + (size_t)(b * SEQ + q0 + 2 * wave + sel) * NPROJP + C_QI + head * 64 + hi * 8;
#pragma unroll
        for (int ks = 0; ks < 4; ++ks) aq[ks] = *(const bf16x8*)(qrow + 16 * ks);
        const bf16* wrow = proj + (size_t)(b * SEQ + tq) * NPROJP + C_WI;
        const v4u w0 = *(const v4u*)wrow, w1 = *(const v4u*)(wrow + 8);
        const float c = 0.25f * 0.125f;
        wv[0] = bflo(w0.x) * c; wv[1] = bfhi(w0.x) * c; wv[2] = bflo(w0.y) * c; wv[3] = bfhi(w0.y) * c; wv[4] = bflo(w0.z) * c; wv[5] = bfhi(w0.z) * c; wv[6] = bflo(w0.w) * c; wv[7] = bfhi(w0.w) * c;
        wv[8] = bflo(w1.x) * c; wv[9] = bfhi(w1.x) * c; wv[10] = bflo(w1.y) * c; wv[11] = bfhi(w1.y) * c; wv[12] = bflo(w1.z) * c; wv[13] = bfhi(w1.z) * c; wv[14] = bflo(w1.w) * c; wv[15] = bfhi(w1.w) * c;
    }
    unsigned key[64];
    const bf16* kibase = proj + (size_t)(b * SEQ) * NPROJP + C_KI;
    v4u st[4];
#define IX_LOAD(c) do { _Pragma("unroll") for (int i = 0; i < 4; ++i) { const int p = tid + 512 * i; st[i] = *(const v4u*)(kibase + (size_t)(256 * (c) + (p >> 3)) * NPROJP + (p & 7) * 8); } } while (0)
#define IX_WRITE(buf) do { _Pragma("unroll") for (int i = 0; i < 4; ++i) { const int p = tid + 512 * i; *(LAS v4u*)(lds + (buf) * IX_KBUF + (p >> 3) * 144 + (p & 7) * 16) = st[i]; } } while (0)
    IX_LOAD(0); IX_WRITE(0);
    __syncthreads();
#pragma unroll
    for (int c = 0; c < 8; ++c) {
        if (c < NC) {
            if (c + 1 < NC) IX_LOAD(c + 1);
#pragma unroll
            for (int tt = 0; tt < 8; ++tt) {
                const int T = 8 * c + tt;
                if (T < NT) {
                    LAS const unsigned char* kb = lds + (c & 1) * IX_KBUF + (32 * tt + r32) * 144 + 16 * hi;
                    f32x16 C = {};
#pragma unroll
                    for (int ks = 0; ks < 4; ++ks) { const bf16x8 bk = *(const LAS bf16x8*)(kb + 32 * ks); C = __builtin_amdgcn_mfma_f32_32x32x16_bf16(aq[ks], bk, C, 0, 0, 0); }
                    float sc = 0.f;
#pragma unroll
                    for (int r = 0; r < 16; ++r) sc += fmaxf(C[r], 0.f) * wv[r];
                    unsigned kk = f2key(sc); kk = kk < 1u ? 1u : kk;
                    key[T] = ((32 * T + r32) <= tq) ? kk : 0u;
                } else key[T] = 0u;
            }
            if (c + 1 < NC) IX_WRITE((c + 1) & 1);
            __syncthreads();
        } else {
#pragma unroll
            for (int tt = 0; tt < 8; ++tt) key[8 * c + tt] = 0u;
        }
    }
#undef IX_LOAD
#undef IX_WRITE
    unsigned T = 0u, need = 0u, cgt = 0u;
    const bool small = (q0 + 2 * wave + 1) < 256;
    if (!small) {
        unsigned prefix = 0u; bool done = false;
        for (int bit = 31; bit >= 0; --bit) {
            const unsigned cand = prefix | (1u << bit);
            unsigned cnt = 0u;
#pragma unroll
            for (int c8 = 0; c8 < 8; ++c8) if (8 * c8 < NT) {
#pragma unroll
                for (int r = 8 * c8; r < 8 * c8 + 8; ++r) cnt += (key[r] >= cand) ? 1u : 0u; }
            cnt = half_sum(cnt);
            const bool take = !done && cnt >= 256u;
            prefix = take ? cand : prefix;
            done = done || (take && cnt == 256u);
            if (__all(done)) break;
        }
        if (done) { T = prefix - 1u; need = 0u; cgt = 256u; }
        else {
            T = prefix; unsigned cnt = 0u;
#pragma unroll
            for (int c8 = 0; c8 < 8; ++c8) if (8 * c8 < NT) {
#pragma unroll
                for (int r = 8 * c8; r < 8 * c8 + 8; ++r) cnt += (key[r] > T) ? 1u : 0u; }
            cgt = half_sum(cnt); need = 256u - cgt;
        }
    }
    LAS unsigned char* lst = lds + IX_LST + wave * 1024;
    *(LAS v4u*)(lst + lane * 16) = (v4u){0xFFFFFFFFu, 0xFFFFFFFFu, 0xFFFFFFFFu, 0xFFFFFFFFu};
    LDS_WAIT();
    LAS unsigned short* lq = (LAS unsigned short*)(lst + hi * 512);
    unsigned base_gt = 0u, base_eq = 0u;
#pragma unroll
    for (int r = 0; r < 64; ++r) if ((r & ~7) < NT) {
        const bool gt = key[r] > T, eq = key[r] == T;
        const unsigned long long mg = __ballot(gt), me = __ballot(eq);
        const unsigned mgh = hi ? (unsigned)(mg >> 32) : (unsigned)mg, meh = hi ? (unsigned)(me >> 32) : (unsigned)me;
        const unsigned below = (1u << r32) - 1u;
        const unsigned rg = __popc(mgh & below), re = __popc(meh & below);
        if (gt) lq[base_gt + rg] = (unsigned short)(32 * r + r32);
        if (eq && (base_eq + re) < need) lq[cgt + base_eq + re] = (unsigned short)(32 * r + r32);
        base_gt += __popc(mgh); base_eq += __popc(meh);
    }
    LDS_WAIT();
    const v4u lo = *(const LAS v4u*)(lst + lane * 16);
    *(v4u*)(idxo + ((size_t)(b * SEQ + q0 + 2 * wave + hi)) * 256 + r32 * 8) = lo;
    __syncthreads();
}

constexpr int SW_V = 36864, SW_WS = SW_V + 32768;
__device__ __forceinline__ void swa_unit(const bf16* proj, bf16* oa, const float* sinks, LAS unsigned char* lds, int u, int tid, int lane, int wave) {
    const int b = u >> 6, nblk = (u >> 2) & 15, kvh = u & 3;
    const int r32 = lane & 31, hi = lane >> 5;
#pragma unroll
    for (int i = 0; i < 4; ++i) {
        const int p = tid + 512 * i, kw = p >> 3, part = p & 7; const int spos = 128 * (nblk - 1) + kw;
        if (spos >= 0) {
            const bf16* src = proj + (size_t)(b * SEQ + spos) * NPROJP;
            const v4u kv = *(const v4u*)(src + C_KA + kvh * 64 + part * 8), vv = *(const v4u*)(src + C_VA + kvh * 64 + part * 8);
            *(LAS v4u*)(lds + kw * 144 + part * 16) = kv;
            *(LAS v4u*)(lds + SW_V + (part >> 2) * 16384 + kw * 64 + (part & 3) * 16) = vv;
        }
    }
    __syncthreads();
    const int hq = kvh * 4 + (wave >> 1);
    const float sink2 = sinks[hq] * LOG2E, slope2 = exp2f(-(float)(hq + 1) * 0.25f) * LOG2E;
    LAS float* wsf = (LAS float*)(lds + SW_WS) + wave * 32;
#pragma unroll 1
    for (int qq = 0; qq < 2; ++qq) {
        const int qt = 2 * (wave & 1) + qq, t0 = 128 * nblk + 32 * qt;
        const bf16* qrow = proj + (size_t)(b * SEQ + t0 + r32) * NPROJP + C_QA + hq * 64 + hi * 8;
        bf16x8 qr[4];
#pragma unroll
        for (int d0 = 0; d0 < 4; ++d0) qr[d0] = *(const bf16x8*)(qrow + 16 * d0);
        float mx = sink2;
        const int jlo = (nblk == 0) ? ((4 - qt) > 0 ? (4 - qt) : 0) : 0;
#pragma unroll 1
        for (int j = jlo; j < 5; ++j) {
            const int kt = qt + j;
            LAS const unsigned char* kb = lds + (32 * kt + r32) * 144 + 16 * hi;
            f32x16 C = {};
#pragma unroll
            for (int d0 = 0; d0 < 4; ++d0) { const bf16x8 kf = *(const LAS bf16x8*)(kb + 32 * d0); C = __builtin_amdgcn_mfma_f32_32x32x16_bf16(kf, qr[d0], C, 0, 0, 0); }
#pragma unroll
            for (int r = 0; r < 16; ++r) { const int rel = (128 + 32 * qt + r32) - (32 * kt + crow(r, hi));
                const float v = (rel >= 0 && rel < 128) ? C[r] - slope2 * (float)rel : NEGBIG; mx = fmaxf(mx, v); }
        }
        mx = fmaxf(mx, __shfl_xor(mx, 32));
        float lsum = 0.f;
        f32x16 o[2]; o[0] = (f32x16){}; o[1] = (f32x16){};
#pragma unroll 1
        for (int j = jlo; j < 5; ++j) {
            const int kt = qt + j;
            LAS const unsigned char* kb = lds + (32 * kt + r32) * 144 + 16 * hi;
            f32x16 C = {};
#pragma unroll
            for (int d0 = 0; d0 < 4; ++d0) { const bf16x8 kf = *(const LAS bf16x8*)(kb + 32 * d0); C = __builtin_amdgcn_mfma_f32_32x32x16_bf16(kf, qr[d0], C, 0, 0, 0); }
#pragma unroll
            for (int r = 0; r < 16; ++r) { const int rel = (128 + 32 * qt + r32) - (32 * kt + crow(r, hi));
                const float v = (rel >= 0 && rel < 128) ? C[r] - slope2 * (float)rel : NEGBIG; const float p = fast_exp2(v - mx); C[r] = p; lsum += p; }
#pragma unroll
            for (int ks = 0; ks < 2; ++ks) {
                v4u pw; pw.x = cvt_pk_bf16(C[8 * ks + 0], C[8 * ks + 1]); pw.y = cvt_pk_bf16(C[8 * ks + 2], C[8 * ks + 3]);
                pw.z = cvt_pk_bf16(C[8 * ks + 4], C[8 * ks + 5]); pw.w = cvt_pk_bf16(C[8 * ks + 6], C[8 * ks + 7]);
                const bf16x8 pa = __builtin_bit_cast(bf16x8, pw);
#pragma unroll
                for (int d0 = 0; d0 < 2; ++d0) {
                    LAS const unsigned char* vp = lds + SW_V + d0 * 16384 + (32 * kt + 16 * ks + 4 * hi + ((lane & 15) >> 2)) * 64 + ((lane >> 4) & 1) * 32 + (lane & 3) * 8;
                    const s16x4 vl = tr_read(vp), vh = tr_read(vp + 512);
                    const bf16x8 vf = (bf16x8){vl[0], vl[1], vl[2], vl[3], vh[0], vh[1], vh[2], vh[3]};
                    o[d0] = __builtin_amdgcn_mfma_f32_32x32x16_bf16(pa, vf, o[d0], 0, 0, 0);
                }
            }
        }
        lsum += __shfl_xor(lsum, 32); lsum += fast_exp2(sink2 - mx);
        if (hi == 0) wsf[r32] = fast_rcp(lsum);
        LDS_WAIT();
        bf16* orow = oa + (size_t)(b * SEQ + t0) * 1024 + hq * 64 + r32;
#pragma unroll
        for (int r = 0; r < 16; ++r) { const int q = crow(r, hi); const float rl = wsf[q];
            const unsigned w0 = cvt_pk_bf16(o[0][r] * rl, 0.f), w1 = cvt_pk_bf16(o[1][r] * rl, 0.f);
            orow[(size_t)q * 1024] = (bf16)(w0 & 0xffffu); orow[(size_t)q * 1024 + 32] = (bf16)(w1 & 0xffffu); }
        LDS_WAIT();
    }
    __syncthreads();
}

constexpr int DS_VBUF = 5120, DS_WAVE = 3 * DS_VBUF + 512;
struct DsaPre { v2u li; bf16x8 qf0, qf1; };
__device__ __forceinline__ DsaPre dsa_prefetch(const bf16* proj, const unsigned short* idx, int b, int t, int lane) {
    DsaPre p; const int i16 = lane & 15, g = lane >> 4;
    p.li = *(const v2u*)(idx + ((size_t)(b * SEQ + t)) * 256 + lane * 4);
    const bf16* qrow = proj + (size_t)(b * SEQ + t) * NPROJP + C_QB + i16 * 64 + 8 * g;
    p.qf0 = *(const bf16x8*)qrow; p.qf1 = *(const bf16x8*)(qrow + 32); return p;
}
__device__ __forceinline__ void dsa_query(const bf16* proj, const DsaPre& pre, bf16* ob, LAS unsigned char* wl, int b, int t, int lane) {
    int i16 = lane & 15, g = lane >> 4, l3 = lane >> 3;
    asm volatile("" : "+v"(i16), "+v"(g), "+v"(l3));
    const int nsel = (t + 1) < 256 ? (t + 1) : 256;
    LAS unsigned char* lst = wl + 3 * DS_VBUF;
    *(LAS v2u*)(lst + lane * 8) = pre.li;
    const bf16x8 qf0 = pre.qf0, qf1 = pre.qf1;
    const float slope2 = exp2f(-(float)(17 + i16) * 0.25f) * LOG2E;
    const bf16* pb = proj + (size_t)(b * SEQ) * NPROJP;
    LAS const unsigned short* lq = (LAS const unsigned short*)lst + i16;
    LAS const unsigned char* lg4 = lst + 8 * g;
    LAS const unsigned short* lv = (LAS const unsigned short*)lst + l3;
    LAS unsigned char* vwr = wl + l3 * 160 + (lane & 7) * 16;
    LAS const unsigned char* vrd = wl + (4 * g + (i16 >> 2)) * 160 + 8 * (i16 & 3);
    asm volatile("" : "+v"(lq), "+v"(lg4), "+v"(lv), "+v"(vwr), "+v"(vrd));
    LDS_WAIT();
    bf16x8 kA[4], kB[4], kC[4]; v4u vA[4], vB[4], vC[4];
#define DSA_ISSUE(c, KF, VV) do { \
        _Pragma("unroll") for (int tt = 0; tt < 2; ++tt) { const int pos = 32 * (c) + 16 * tt + i16; int kidx = lq[32 * (c) + 16 * tt]; kidx = (pos < nsel) ? kidx : 0; \
            const bf16* krow = pb + (size_t)kidx * NPROJP + C_KB + 8 * g; KF[2 * tt] = *(const bf16x8*)krow; KF[2 * tt + 1] = *(const bf16x8*)(krow + 32); } \
        _Pragma("unroll") for (int i = 0; i < 4; ++i) { const int pos = 32 * (c) + 8 * i + l3; int vidx = lv[32 * (c) + 8 * i]; vidx = (pos < nsel) ? vidx : 0; \
            VV[i] = *(const v4u*)(pb + (size_t)vidx * NPROJP + C_VB + (lane & 7) * 8); } } while (0)
    float m = NEGBIG, lsum = 0.f;
    f32x4 o[4];
#pragma unroll
    for (int dt = 0; dt < 4; ++dt) o[dt] = (f32x4){0.f, 0.f, 0.f, 0.f};
#define DSA_CHUNK(c, KF, VV, buf) do { \
        _Pragma("unroll") for (int i = 0; i < 4; ++i) *(LAS v4u*)(vwr + (buf) * DS_VBUF + 8 * i * 160) = VV[i]; \
        f32x4 s0 = {0.f, 0.f, 0.f, 0.f}, s1 = {0.f, 0.f, 0.f, 0.f}; \
        s0 = __builtin_amdgcn_mfma_f32_16x16x32_bf16(KF[0], qf0, s0, 0, 0, 0); s0 = __builtin_amdgcn_mfma_f32_16x16x32_bf16(KF[1], qf1, s0, 0, 0, 0); \
        s1 = __builtin_amdgcn_mfma_f32_16x16x32_bf16(KF[2], qf0, s1, 0, 0, 0); s1 = __builtin_amdgcn_mfma_f32_16x16x32_bf16(KF[3], qf1, s1, 0, 0, 0); \
        { const v2u i4 = *(const LAS v2u*)(lg4 + 64 * (c)), j4 = *(const LAS v2u*)(lg4 + 64 * (c) + 32); const int p0 = 32 * (c) + 4 * g; \
          s0[0] = (p0 + 0 < nsel) ? s0[0] - slope2 * (float)(t - (int)(i4.x & 0xffff)) : NEGBIG; s0[1] = (p0 + 1 < nsel) ? s0[1] - slope2 * (float)(t - (int)(i4.x >> 16)) : NEGBIG; \
          s0[2] = (p0 + 2 < nsel) ? s0[2] - slope2 * (float)(t - (int)(i4.y & 0xffff)) : NEGBIG; s0[3] = (p0 + 3 < nsel) ? s0[3] - slope2 * (float)(t - (int)(i4.y >> 16)) : NEGBIG; \
          s1[0] = (p0 + 16 < nsel) ? s1[0] - slope2 * (float)(t - (int)(j4.x & 0xffff)) : NEGBIG; s1[1] = (p0 + 17 < nsel) ? s1[1] - slope2 * (float)(t - (int)(j4.x >> 16)) : NEGBIG; \
          s1[2] = (p0 + 18 < nsel) ? s1[2] - slope2 * (float)(t - (int)(j4.y & 0xffff)) : NEGBIG; s1[3] = (p0 + 19 < nsel) ? s1[3] - slope2 * (float)(t - (int)(j4.y >> 16)) : NEGBIG; } \
        float cm = fmaxf(fmaxf(fmaxf(s0[0], s0[1]), fmaxf(s0[2], s0[3])), fmaxf(fmaxf(s1[0], s1[1]), fmaxf(s1[2], s1[3]))); \
        cm = fmaxf(cm, __shfl_xor(cm, 16)); cm = fmaxf(cm, __shfl_xor(cm, 32)); \
        const float mn = fmaxf(m, cm), al = fast_exp2(m - mn); m = mn; \
        _Pragma("unroll") for (int r = 0; r < 4; ++r) { s0[r] = fast_exp2(s0[r] - mn); s1[r] = fast_exp2(s1[r] - mn); } \
        lsum = lsum * al + ((s0[0] + s0[1]) + (s0[2] + s0[3])) + ((s1[0] + s1[1]) + (s1[2] + s1[3])); \
        _Pragma("unroll") for (int dt = 0; dt < 4; ++dt) o[dt] = o[dt] * al; \
        v4u pw; pw.x = cvt_pk_bf16(s0[0], s0[1]); pw.y = cvt_pk_bf16(s0[2], s0[3]); pw.z = cvt_pk_bf16(s1[0], s1[1]); pw.w = cvt_pk_bf16(s1[2], s1[3]); \
        const bf16x8 pbv = __builtin_bit_cast(bf16x8, pw); \
        LDS_WAIT(); \
        _Pragma("unroll") for (int dt = 0; dt < 4; ++dt) { \
            const s16x4 vl = tr_read(vrd + (buf) * DS_VBUF + 32 * dt), vh = tr_read(vrd + (buf) * DS_VBUF + 16 * 160 + 32 * dt); \
            const bf16x8 vf = (bf16x8){vl[0], vl[1], vl[2], vl[3], vh[0], vh[1], vh[2], vh[3]}; \
            o[dt] = __builtin_amdgcn_mfma_f32_16x16x32_bf16(vf, pbv, o[dt], 0, 0, 0); } \
        __builtin_amdgcn_sched_barrier(0); } while (0)
    DSA_ISSUE(0, kA, vA); DSA_ISSUE(1, kB, vB);
    DSA_ISSUE(2, kC, vC); DSA_CHUNK(0, kA, vA, 0);
    DSA_ISSUE(3, kA, vA); DSA_CHUNK(1, kB, vB, 1);
    DSA_ISSUE(4, kB, vB); DSA_CHUNK(2, kC, vC, 2);
    DSA_ISSUE(5, kC, vC); DSA_CHUNK(3, kA, vA, 0);
    DSA_ISSUE(6, kA, vA); DSA_CHUNK(4, kB, vB, 1);
    DSA_ISSUE(7, kB, vB); DSA_CHUNK(5, kC, vC, 2);
    DSA_CHUNK(6, kA, vA, 0);
    DSA_CHUNK(7, kB, vB, 1);
#undef DSA_ISSUE
#undef DSA_CHUNK
    lsum += __shfl_xor(lsum, 16); lsum += __shfl_xor(lsum, 32);
    const float rl = fast_rcp(lsum);
    bf16* orow = ob + (size_t)(b * SEQ + t) * 1024 + i16 * 64 + 4 * g;
#pragma unroll
    for (int dt = 0; dt < 4; ++dt) { v2u w; w.x = cvt_pk_bf16(o[dt][0] * rl, o[dt][1] * rl); w.y = cvt_pk_bf16(o[dt][2] * rl, o[dt][3] * rl); *(v2u*)(orow + 16 * dt) = w; }
}

constexpr int RT_PART = 0, RT_RS = 65536, RT_LG = RT_RS + 128;
__device__ __forceinline__ void router_unit(KArgs& a, LAS unsigned char* lds, int u, int tid, int lane, int wave) {
    const float* x2 = a.out; const float* modf = (const float*)(a.ws + WS_MODF); const float* g2 = a.in[I_LN2G];
    bf16* H2 = (bf16*)(a.ws + WS_H);
    const bf16* wrh = (const bf16*)(a.ws + WS_WRH); const bf16* wrl = (const bf16*)(a.ws + WS_WRL);
    const int row0 = u * 32, b = row0 >> 11;
    LAS float* rs = (LAS float*)(lds + RT_RS);
#pragma unroll 1
    for (int i = 0; i < 4; i += 2) {
        const int m = row0 + 4 * wave + i;
        const f32x4* xr0 = (const f32x4*)(x2 + (size_t)m * DM) + lane; const f32x4* xr1 = xr0 + DM / 4;
        f32x4 v0[8], v1[8]; float s0 = 0.f, s1 = 0.f;
#pragma unroll
        for (int j = 0; j < 8; ++j) { v0[j] = xr0[64 * j]; v1[j] = xr1[64 * j]; }
#pragma unroll
        for (int j = 0; j < 8; ++j) { s0 += (v0[j].x * v0[j].x + v0[j].y * v0[j].y) + (v0[j].z * v0[j].z + v0[j].w * v0[j].w); s1 += (v1[j].x * v1[j].x + v1[j].y * v1[j].y) + (v1[j].z * v1[j].z + v1[j].w * v1[j].w); }
        const float r0 = 1.f / sqrtf(wave_sum(s0) * (1.f / DM) + RMS_EPS), r1 = 1.f / sqrtf(wave_sum(s1) * (1.f / DM) + RMS_EPS);
        if (lane == 0) { rs[4 * wave + i] = r0; rs[4 * wave + i + 1] = r1; }
        unsigned long long* o0 = (unsigned long long*)(H2 + (size_t)m * DM) + lane; unsigned long long* o1 = o0 + DM / 4;
#pragma unroll
        for (int j = 0; j < 8; ++j) { const int k = 4 * lane + 256 * j;
            const f32x4 gk = *(const f32x4*)(g2 + k), sc = *(const f32x4*)(modf + b * 12288 + 8192 + k), sh = *(const f32x4*)(modf + b * 12288 + 6144 + k);
            const f32x4 fk = gk * (sc + 1.f);
            const f32x4 y0 = v0[j] * r0 * fk + sh, y1 = v1[j] * r1 * fk + sh;
            o0[64 * j] = (unsigned long long)cvt_pk_bf16(y0.x, y0.y) | ((unsigned long long)cvt_pk_bf16(y0.z, y0.w) << 32);
            o1[64 * j] = (unsigned long long)cvt_pk_bf16(y1.x, y1.y) | ((unsigned long long)cvt_pk_bf16(y1.z, y1.w) << 32); }
    }
    __syncthreads();
    {
        const int r32 = lane & 31, hh = lane >> 5;
        const float rst = rs[r32];
        const size_t rowoff = (size_t)(row0 + r32) * DM;
        f32x16 acc0 = {}, acc1 = {};
#pragma unroll 4
        for (int ks = 0; ks < 16; ++ks) {
            const int k = wave * 256 + 16 * ks + 8 * hh;
            const f32x4 xa = *(const f32x4*)(x2 + rowoff + k), xb = *(const f32x4*)(x2 + rowoff + k + 4);
            const f32x4 ga = *(const f32x4*)(g2 + k), gb = *(const f32x4*)(g2 + k + 4);
            const f32x4 sca = *(const f32x4*)(modf + b * 12288 + 8192 + k), scb = *(const f32x4*)(modf + b * 12288 + 8192 + k + 4);
            const f32x4 sha = *(const f32x4*)(modf + b * 12288 + 6144 + k), shb = *(const f32x4*)(modf + b * 12288 + 6144 + k + 4);
            const f32x4 ha = xa * rst * ga * (sca + 1.f) + sha, hb = xb * rst * gb * (scb + 1.f) + shb;
            v4u hi; hi.x = cvt_pk_bf16(ha.x, ha.y); hi.y = cvt_pk_bf16(ha.z, ha.w); hi.z = cvt_pk_bf16(hb.x, hb.y); hi.w = cvt_pk_bf16(hb.z, hb.w);
            v4u lo; lo.x = cvt_pk_bf16(ha.x - bflo(hi.x), ha.y - bfhi(hi.x)); lo.y = cvt_pk_bf16(ha.z - bflo(hi.y), ha.w - bfhi(hi.y));
            lo.z = cvt_pk_bf16(hb.x - bflo(hi.z), hb.y - bfhi(hi.z)); lo.w = cvt_pk_bf16(hb.z - bflo(hi.w), hb.w - bfhi(hi.w));
            const bf16x8 ah = __builtin_bit_cast(bf16x8, hi), al = __builtin_bit_cast(bf16x8, lo);
            const bf16x8 bh0 = *(const bf16x8*)(wrh + (size_t)r32 * DM + k), bl0 = *(const bf16x8*)(wrl + (size_t)r32 * DM + k);
            const bf16x8 bh1 = *(const bf16x8*)(wrh + (size_t)(32 + r32) * DM + k), bl1 = *(const bf16x8*)(wrl + (size_t)(32 + r32) * DM + k);
            acc0 = __builtin_amdgcn_mfma_f32_32x32x16_bf16(al, bh0, acc0, 0, 0, 0); acc0 = __builtin_amdgcn_mfma_f32_32x32x16_bf16(ah, bl0, acc0, 0, 0, 0); acc0 = __builtin_amdgcn_mfma_f32_32x32x16_bf16(ah, bh0, acc0, 0, 0, 0);
            acc1 = __builtin_amdgcn_mfma_f32_32x32x16_bf16(al, bh1, acc1, 0, 0, 0); acc1 = __builtin_amdgcn_mfma_f32_32x32x16_bf16(ah, bl1, acc1, 0, 0, 0); acc1 = __builtin_amdgcn_mfma_f32_32x32x16_bf16(ah, bh1, acc1, 0, 0, 0);
        }
        LAS float* part = (LAS float*)(lds + RT_PART) + wave * 2048;
#pragma unroll
        for (int r = 0; r < 16; ++r) { const int tkn = crow(r, hh); part[tkn * 64 + r32] = acc0[r]; part[tkn * 64 + 32 + r32] = acc1[r]; }
    }
    __syncthreads();
    LAS float* lg = (LAS float*)(lds + RT_LG);
    for (int o = tid; o < 32 * 36; o += 512) { const int t2 = o / 36, j = o % 36; float s = 0.f;
#pragma unroll
        for (int q = 0; q < 8; ++q) s += ((LAS float*)(lds + RT_PART))[q * 2048 + t2 * 64 + j];
        lg[t2 * 36 + j] = s + ((j < 32) ? a.in[I_BEXP][j] : a.in[I_BGRP][j - 32]); }
    __syncthreads();
    if (tid < 32) {
        const LAS float* l = lg + tid * 36;
        int gi = 0; float gm = l[32];
#pragma unroll
        for (int j = 1; j < 4; ++j) if (l[32 + j] > gm) { gm = l[32 + j]; gi = j; }
        float gs = 0.f;
#pragma unroll
        for (int j = 0; j < 4; ++j) gs += __expf(l[32 + j] - gm);
        const float pg = 1.f / gs;
        float e[8];
#pragma unroll
        for (int j = 0; j < 8; ++j) e[j] = (gi == 0) ? l[j] : (gi == 1) ? l[8 + j] : (gi == 2) ? l[16 + j] : l[24 + j];
        int i1 = 0; float m1 = e[0];
#pragma unroll
        for (int j = 1; j < 8; ++j) if (e[j] > m1) { m1 = e[j]; i1 = j; }
        int i2 = -1; float m2 = -3.0e38f;
#pragma unroll
        for (int j = 0; j < 8; ++j) if (j != i1 && e[j] > m2) { m2 = e[j]; i2 = j; }
        const float p2 = __expf(m2 - m1), inv = 1.f / (1.f + p2);
        const float c1 = pg * inv, c2 = pg * p2 * inv;
        const int e1 = gi * 8 + i1, e2 = gi * 8 + i2, m = row0 + tid;
        LAS unsigned* lcnt = (LAS unsigned*)(lds + RT_LG + 32 * 36 * 4);
        lcnt[tid] = 0u;
        LDS_WAIT(); __builtin_amdgcn_wave_barrier();
        const unsigned lr1 = __hip_atomic_fetch_add(lcnt + e1, 1u, __ATOMIC_RELAXED, __HIP_MEMORY_SCOPE_WORKGROUP);
        const unsigned lr2 = __hip_atomic_fetch_add(lcnt + e2, 1u, __ATOMIC_RELAXED, __HIP_MEMORY_SCOPE_WORKGROUP);
        LDS_WAIT(); __builtin_amdgcn_wave_barrier();
        unsigned* ecnt = (unsigned*)(a.ws + WS_CTL) + CW_ECNT;
        const unsigned mine = lcnt[tid];
        const unsigned gb = mine ? atomicAdd(ecnt + tid * 32, mine) : 0u;
        lcnt[32 + tid] = gb;
        LDS_WAIT(); __builtin_amdgcn_wave_barrier();
        const int pos1 = (int)(lcnt[32 + e1] + lr1), pos2 = (int)(lcnt[32 + e2] + lr2);
        int* rowtok = (int*)(a.ws + WS_ROWTOK); float* roww = (float*)(a.ws + WS_ROWW);
        rowtok[e1 * ECAP + pos1] = m; roww[e1 * ECAP + pos1] = c1;
        rowtok[e2 * ECAP + pos2] = m; roww[e2 * ECAP + pos2] = c2;
        int* tokinfo = (int*)(a.ws + WS_TOK) + m * 4;
        tokinfo[0] = e1; tokinfo[1] = pos1; tokinfo[2] = e2; tokinfo[3] = pos2;
    }
    __syncthreads();
}
__device__ __forceinline__ void moe_table(KArgs& a, LAS unsigned char* lds, int tid) {
    LAS int* tb = (LAS int*)(lds + MOE_TB_OFF); LAS int* cn = tb + 40;
    if (tid == 0) {
        const unsigned* ecnt = (const unsigned*)(a.ws + WS_CTL) + CW_ECNT; int acc = 0;
        for (int e = 0; e < NEXP; ++e) { const int c = (int)__hip_atomic_load(ecnt + e * 32, RLX_AGENT); tb[e] = acc; cn[e] = c; acc += (c + 255) >> 8; }
        tb[NEXP] = acc;
    }
    __syncthreads();
}


namespace wsg {
constexpr int BK = 64, A_STR = 144, B_STR = 288, A_BYTES = 256 * A_STR, B_BYTES = 64 * B_STR, BUF_BYTES = A_BYTES + B_BYTES;
struct Unit { int e, mt, pn, tile; };
struct Order {
    const LAS int* tb; int npn, G, c, total;
    __device__ __forceinline__ bool next(int i, Unit& u) const {
        const int L = i * G + c; if (L >= total) return false;
        int e = 0;
#pragma unroll
        for (int j = 1; j < NEXP; ++j) e += (L >= tb[j] * npn) ? 1 : 0;
        const int idx = L - tb[e] * npn, te = tb[e + 1] - tb[e];
        u.e = e; u.pn = idx / te; u.mt = idx - u.pn * te; u.tile = tb[e] + u.mt; return true;
    }
};
template <bool GU>
__device__ __forceinline__ void ws_gemm(LAS unsigned char* lds, KArgs& a, const Order& S, const LAS int* cnt) {
    const int tid = threadIdx.x, wid = __builtin_amdgcn_readfirstlane(tid >> 6), lane = tid & 63, wm = wid >> 1, wn = wid & 1, fr = lane & 15, g = lane >> 4;
    constexpr int K = GU ? DM : DEXP, NK = K / BK, LDW = GU ? DEXP : DM;
    const bf16* Abase = (const bf16*)(a.ws + (GU ? WS_H : WS_ACT));
    const int* rowtok = (const int*)(a.ws + WS_ROWTOK);
    const int k0 = 4 * (2 * wid + (lane >> 5)), c4 = 4 * (lane & 31);
    const int kp0 = (k0 & ~12) | ((k0 & 4) << 1) | ((k0 & 8) >> 1);
    const int arow = tid >> 3, apart = tid & 7;
    Unit cur, nxt;
    if (!S.next(0, cur)) return;
    f32x4 acc[4][4];
#pragma unroll
    for (int m = 0; m < 4; ++m)
#pragma unroll
        for (int n = 0; n < 4; ++n) acc[m][n] = (f32x4){0.f, 0.f, 0.f, 0.f};
    unsigned aoff[4]; const float* wsrc;
#define WSG_SETUP(U, AO, WS) do { \
        _Pragma("unroll") for (int i = 0; i < 4; ++i) { const int row = arow + 64 * i; \
            if (GU) { const int local = (U).mt * 256 + row; const unsigned tok = (local < cnt[(U).e]) ? (unsigned)rowtok[(U).e * ECAP + local] : 0u; AO[i] = tok * (unsigned)(K * 2) + (unsigned)apart * 16u; } \
            else AO[i] = (unsigned)((U).tile * 256 + row) * (unsigned)(K * 2) + (unsigned)apart * 16u; } \
        if (GU) { const int wn_ = c4 >> 6, n_ = (c4 >> 4) & 3, ii_ = c4 & 15; \
            WS = ((n_ < 2) ? a.in[I_WGU] : a.in[I_WUP]) + (size_t)(U).e * DM * DEXP + (64 * (U).pn + 32 * wn_ + 16 * (n_ & 1) + ii_) + (size_t)k0 * LDW; } \
        else WS = a.in[I_WDN] + (size_t)(U).e * DEXP * DM + (128 * (U).pn + c4) + (size_t)k0 * LDW; } while (0)
    WSG_SETUP(cur, aoff, wsrc);
    v4u av[4]; f32x4 wv0[4], wv1[4];
    LAS unsigned* noff = (LAS unsigned*)(lds + MOE_NOFF) + tid * 4;
#define WSG_LOADA(AO, kt) do { _Pragma("unroll") for (int i = 0; i < 4; ++i) av[i] = *(const v4u*)((const char*)Abase + AO[i] + (kt) * 128); } while (0)
#define WSG_LOADW(WV, WS, kt) do { _Pragma("unroll") for (int i = 0; i < 4; ++i) WV[i] = *(const f32x4*)(WS + (size_t)((kt) * 64 + i) * LDW); } while (0)
#define WSG_WRITE(buf, WV) do { LAS unsigned char* ba_ = lds + (buf) * BUF_BYTES; \
        _Pragma("unroll") for (int i = 0; i < 4; ++i) { *(LAS v4u*)(ba_ + (arow + 64 * i) * A_STR + apart * 16) = av[i]; \
            v2u w_; w_.x = cvt_pk_bf16(WV[i].x, WV[i].y); w_.y = cvt_pk_bf16(WV[i].z, WV[i].w); *(LAS v2u*)(ba_ + A_BYTES + (kp0 + i) * B_STR + (lane & 31) * 8) = w_; } } while (0)
#define WSG_COMPUTE(buf) do { LAS const unsigned char* ba = lds + (buf) * BUF_BYTES; LAS const unsigned char* bb = ba + A_BYTES; \
        _Pragma("unroll") for (int ks = 0; ks < 2; ++ks) { bf16x8 af[4], bfr[4]; \
            _Pragma("unroll") for (int m = 0; m < 4; ++m) af[m] = *(const LAS bf16x8*)(ba + (64 * wm + 16 * m + fr) * A_STR + (32 * ks + 8 * g) * 2); \
            _Pragma("unroll") for (int n = 0; n < 4; ++n) { LAS const unsigned char* p = bb + (32 * ks + 4 * (g & 1) + 16 * (g >> 1) + (fr >> 2)) * B_STR + (64 * wn + 16 * n + 4 * (fr & 3)) * 2; \
                const s16x4 vl = tr_read(p), vh = tr_read(p + 8 * B_STR); bfr[n] = (bf16x8){vl[0], vl[1], vl[2], vl[3], vh[0], vh[1], vh[2], vh[3]}; } \
            _Pragma("unroll") for (int m = 0; m < 4; ++m) _Pragma("unroll") for (int n = 0; n < 4; ++n) acc[m][n] = __builtin_amdgcn_mfma_f32_16x16x32_bf16(bfr[n], af[m], acc[m][n], 0, 0, 0); } } while (0)
    WSG_LOADA(aoff, 0); WSG_LOADW(wv0, wsrc, 0); WSG_LOADW(wv1, wsrc, 1); WSG_WRITE(0, wv0);
    __syncthreads();
    int ui = 0;
    for (;;) {
        const bool has_next = S.next(ui + 1, nxt);
        { unsigned t4[4]; const float* tw;
#pragma unroll
          for (int i = 0; i < 4; ++i) t4[i] = aoff[i];
          if (has_next) { WSG_SETUP(nxt, t4, tw); (void)tw; }
          *(LAS v4u*)noff = (v4u){t4[0], t4[1], t4[2], t4[3]}; }
#pragma unroll 1
        for (int kt = 0; kt < NK; kt += 2) {
            const bool lastp = (kt == NK - 2);
            WSG_LOADA(aoff, kt + 1);
            if (!lastp) WSG_LOADW(wv0, wsrc, kt + 2);
            else if (has_next) { unsigned t4[4]; const float* nws; WSG_SETUP(nxt, t4, nws); WSG_LOADW(wv0, nws, 0); }
            __builtin_amdgcn_sched_barrier(0);
            WSG_COMPUTE(0);
            __builtin_amdgcn_sched_barrier(0);
            WSG_WRITE(1, wv1);
            __syncthreads();
            if (!lastp) { WSG_LOADA(aoff, kt + 2); WSG_LOADW(wv1, wsrc, kt + 3); }
            else if (has_next) { const v4u o4 = *(const LAS v4u*)noff; unsigned n4[4] = {o4.x, o4.y, o4.z, o4.w}; unsigned t4[4]; const float* nws; WSG_SETUP(nxt, t4, nws); (void)t4;
                WSG_LOADA(n4, 0); WSG_LOADW(wv1, nws, 1); }
            __builtin_amdgcn_sched_barrier(0);
            WSG_COMPUTE(1);
            __builtin_amdgcn_sched_barrier(0);
            if (lastp) {
                const size_t prow0 = (size_t)cur.tile * 256 + 64 * wm + fr;
                if (GU) {
                    bf16* act = (bf16*)(a.ws + WS_ACT); const float* roww = (const float*)(a.ws + WS_ROWW);
#pragma unroll
                    for (int m = 0; m < 4; ++m) { const int local = cur.mt * 256 + 64 * wm + 16 * m + fr;
                        const float w = (local < cnt[cur.e]) ? roww[cur.e * ECAP + local] : 0.f;
#pragma unroll
                        for (int n = 0; n < 2; ++n) { float o[4];
#pragma unroll
                            for (int r = 0; r < 4; ++r) { const float gt = acc[m][n][r]; o[r] = gt * sigmoidf_(gt) * acc[m][n + 2][r] * w; }
                            v2u wv2; wv2.x = cvt_pk_bf16(o[0], o[1]); wv2.y = cvt_pk_bf16(o[2], o[3]);
                            *(v2u*)(act + (prow0 + 16 * m) * DEXP + 64 * cur.pn + 32 * wn + 16 * n + 4 * g) = wv2; } }
                } else {
                    bf16* Y = (bf16*)(a.ws + WS_Y);
#pragma unroll
                    for (int m = 0; m < 4; ++m)
#pragma unroll
                        for (int n = 0; n < 4; ++n) { v2u wv2; wv2.x = cvt_pk_bf16(acc[m][n][0], acc[m][n][1]); wv2.y = cvt_pk_bf16(acc[m][n][2], acc[m][n][3]);
                            *(v2u*)(Y + (prow0 + 16 * m) * DM + 128 * cur.pn + 64 * wn + 16 * n + 4 * g) = wv2; }
                }
#pragma unroll
                for (int m = 0; m < 4; ++m)
#pragma unroll
                    for (int n = 0; n < 4; ++n) acc[m][n] = (f32x4){0.f, 0.f, 0.f, 0.f};
            }
            if (!lastp || has_next) WSG_WRITE(0, wv0);
            __syncthreads();
        }
        if (!has_next) break;
        cur = nxt; ++ui;
        { const v4u o4 = *(const LAS v4u*)noff; aoff[0] = o4.x; aoff[1] = o4.y; aoff[2] = o4.z; aoff[3] = o4.w; unsigned t4[4]; WSG_SETUP(cur, t4, wsrc); (void)t4; }
    }
#undef WSG_COMPUTE
#undef WSG_SETUP
#undef WSG_LOADA
#undef WSG_LOADW
#undef WSG_WRITE
}

template <bool GU>
__device__ __forceinline__ void ws_gemm2(LAS unsigned char* lds, KArgs& a, const Order& S, const LAS int* cnt) {
    const int tid = threadIdx.x, wid = __builtin_amdgcn_readfirstlane(tid >> 6), lane = tid & 63;
    constexpr int K = GU ? DM : DEXP, NK = K / BK, LDW = GU ? DEXP : DM;
    const int nun = (S.total > S.c) ? (S.total - S.c + S.G - 1) / S.G : 0;
    if (nun == 0) return;
    const int total = nun * NK;
    if (wid >= 4) {
        const int ptid = tid - 256;
        const bf16* Abase = (const bf16*)(a.ws + (GU ? WS_H : WS_ACT));
        const int* rowtok = (const int*)(a.ws + WS_ROWTOK);
        const int k0 = 4 * (2 * (wid - 4) + (lane >> 5)), c4 = 4 * (lane & 31);
        const int kp0 = (k0 & ~12) | ((k0 & 4) << 1) | ((k0 & 8) >> 1);
        const int arow = ptid >> 3, apart = ptid & 7;
        Unit U; int lu = 0, lkt = 0; (void)S.next(0, U);
        unsigned aoff[8]; const float* wsrc;
#define WS2_SETUP() do { \
            _Pragma("unroll") for (int i = 0; i < 8; ++i) { const int row = arow + 32 * i; \
                if (GU) { const int local = U.mt * 256 + row; const unsigned tok = (local < cnt[U.e]) ? (unsigned)rowtok[U.e * ECAP + local] : 0u; aoff[i] = tok * (unsigned)(K * 2) + (unsigned)apart * 16u; } \
                else aoff[i] = (unsigned)(U.tile * 256 + row) * (unsigned)(K * 2) + (unsigned)apart * 16u; } \
            if (GU) wsrc = ((c4 < 64) ? a.in[I_WGU] : a.in[I_WUP]) + (size_t)U.e * DM * DEXP + (64 * U.pn + (c4 & 63)) + (size_t)k0 * LDW; \
            else wsrc = a.in[I_WDN] + (size_t)U.e * DEXP * DM + (128 * U.pn + c4) + (size_t)k0 * LDW; } while (0)
        WS2_SETUP();
        v4u avA[8], avB[8], avC[8]; f32x4 wvA[8], wvB[8], wvC[8];
#define WS2_ISSUE(AV, WV) do { \
            _Pragma("unroll") for (int i = 0; i < 8; ++i) AV[i] = *(const v4u*)((const char*)Abase + aoff[i] + lkt * 128); \
            _Pragma("unroll") for (int i = 0; i < 4; ++i) { WV[i] = *(const f32x4*)(wsrc + (size_t)(lkt * 64 + i) * LDW); WV[4 + i] = *(const f32x4*)(wsrc + (size_t)(lkt * 64 + 32 + i) * LDW); } \
            if (++lkt == NK) { if (lu + 1 < nun) { lkt = 0; ++lu; (void)S.next(lu, U); WS2_SETUP(); } else lkt = NK - 1; } } while (0)
#define WS2_WRITE(buf, AV, WV) do { LAS unsigned char* ba_ = lds + (buf) * BUF_BYTES; \
            _Pragma("unroll") for (int i = 0; i < 8; ++i) *(LAS v4u*)(ba_ + (arow + 32 * i) * A_STR + apart * 16) = AV[i]; \
            _Pragma("unroll") for (int i = 0; i < 4; ++i) { v2u w_; w_.x = cvt_pk_bf16(WV[i].x, WV[i].y); w_.y = cvt_pk_bf16(WV[i].z, WV[i].w); *(LAS v2u*)(ba_ + A_BYTES + (kp0 + i) * B_STR + (lane & 31) * 8) = w_; \
                v2u x_; x_.x = cvt_pk_bf16(WV[4 + i].x, WV[4 + i].y); x_.y = cvt_pk_bf16(WV[4 + i].z, WV[4 + i].w); *(LAS v2u*)(ba_ + A_BYTES + (32 + kp0 + i) * B_STR + (lane & 31) * 8) = x_; } } while (0)
#define WS2_SUB(j, AVI, WVI, AVW, WVW) do { WS2_ISSUE(AVI, WVI); WS2_WRITE(((j) + 1) & 1, AVW, WVW); __syncthreads(); } while (0)
        WS2_ISSUE(avA, wvA); WS2_ISSUE(avB, wvB); WS2_ISSUE(avC, wvC); WS2_WRITE(0, avA, wvA);
        __syncthreads();
        int j = 0;
#pragma unroll 1
        for (; j + 3 <= total; j += 3) {
            WS2_SUB(j, avA, wvA, avB, wvB);
            WS2_SUB(j + 1, avB, wvB, avC, wvC);
            WS2_SUB(j + 2, avC, wvC, avA, wvA);
        }
        if (j < total) { WS2_SUB(j, avA, wvA, avB, wvB); if (j + 1 < total) WS2_SUB(j + 1, avB, wvB, avC, wvC); }
#undef WS2_SETUP
#undef WS2_ISSUE
#undef WS2_WRITE
#undef WS2_SUB
    } else {
        const int fr = lane & 15, g = lane >> 4;
        f32x4 acc[4][8];
#pragma unroll
        for (int m = 0; m < 4; ++m)
#pragma unroll
            for (int n = 0; n < 8; ++n) acc[m][n] = (f32x4){0.f, 0.f, 0.f, 0.f};
        Unit U; int cu = 0, kt = 0; (void)S.next(0, U);
        __syncthreads();
#pragma unroll 1
        for (int s = 0; s < total; ++s) {
            LAS const unsigned char* ba = lds + (s & 1) * BUF_BYTES; LAS const unsigned char* bb = ba + A_BYTES;
#pragma unroll
            for (int ks = 0; ks < 2; ++ks) {
                bf16x8 af[4], bfr[8];
#pragma unroll
                for (int m = 0; m < 4; ++m) af[m] = *(const LAS bf16x8*)(ba + (64 * wid + 16 * m + fr) * A_STR + (32 * ks + 8 * g) * 2);
#pragma unroll
                for (int n = 0; n < 8; ++n) { LAS const unsigned char* p = bb + (32 * ks + 4 * (g & 1) + 16 * (g >> 1) + (fr >> 2)) * B_STR + (16 * n + 4 * (fr & 3)) * 2;
                    const s16x4 vl = tr_read(p), vh = tr_read(p + 8 * B_STR); bfr[n] = (bf16x8){vl[0], vl[1], vl[2], vl[3], vh[0], vh[1], vh[2], vh[3]}; }
#pragma unroll
                for (int m = 0; m < 4; ++m)
#pragma unroll
                    for (int n = 0; n < 8; ++n) acc[m][n] = __builtin_amdgcn_mfma_f32_16x16x32_bf16(bfr[n], af[m], acc[m][n], 0, 0, 0);
            }
            if (++kt == NK) {
                const size_t prow0 = (size_t)U.tile * 256 + 64 * wid + fr;
                if (GU) {
                    bf16* act = (bf16*)(a.ws + WS_ACT); const float* roww = (const float*)(a.ws + WS_ROWW);
#pragma unroll
                    for (int m = 0; m < 4; ++m) { const int local = U.mt * 256 + 64 * wid + 16 * m + fr;
                        const float w = (local < cnt[U.e]) ? roww[U.e * ECAP + local] : 0.f;
#pragma unroll
                        for (int n = 0; n < 4; ++n) { float o[4];
#pragma unroll
                            for (int r = 0; r < 4; ++r) { const float gt = acc[m][n][r]; o[r] = gt * sigmoidf_(gt) * acc[m][n + 4][r] * w; }
                            v2u wv2; wv2.x = cvt_pk_bf16(o[0], o[1]); wv2.y = cvt_pk_bf16(o[2], o[3]);
                            *(v2u*)(act + (prow0 + 16 * m) * DEXP + 64 * U.pn + 16 * n + 4 * g) = wv2; } }
                } else {
                    bf16* Y = (bf16*)(a.ws + WS_Y);
#pragma unroll
                    for (int m = 0; m < 4; ++m)
#pragma unroll
                        for (int n = 0; n < 8; ++n) { v2u wv2; wv2.x = cvt_pk_bf16(acc[m][n][0], acc[m][n][1]); wv2.y = cvt_pk_bf16(acc[m][n][2], acc[m][n][3]);
                            *(v2u*)(Y + (prow0 + 16 * m) * DM + 128 * U.pn + 16 * n + 4 * g) = wv2; }
                }
#pragma unroll
                for (int m = 0; m < 4; ++m)
#pragma unroll
                    for (int n = 0; n < 8; ++n) acc[m][n] = (f32x4){0.f, 0.f, 0.f, 0.f};
                kt = 0; ++cu; if (cu < nun) (void)S.next(cu, U);
            }
            __syncthreads();
        }
    }
}

constexpr int A3_BYTES = 32768, A3_RING = 3 * A3_BYTES, B3_OFF = A3_RING;
__device__ __forceinline__ void glds16(const void* gsrc, unsigned lds_dst) { unsigned keep;
    asm volatile("s_mov_b32 %0, m0\n\ts_mov_b32 m0, %2\n\ts_nop 0\n\tglobal_load_lds_dwordx4 %1, off\n\ts_mov_b32 m0, %0" : "=&s"(keep) : "v"(gsrc), "s"(lds_dst) : "memory"); }
template <bool GU>
__device__ __forceinline__ void ws_gemm3(LAS unsigned char* lds, KArgs& a, const Order& S, const LAS int* cnt) {
    const int tid = threadIdx.x, wid = __builtin_amdgcn_readfirstlane(tid >> 6), lane = tid & 63;
    constexpr int K = GU ? DM : DEXP, NK = K / BK, LDW = GU ? DEXP : DM;
    const int nun = (S.total > S.c) ? (S.total - S.c + S.G - 1) / S.G : 0;
    if (nun == 0) return;
    const int total = nun * NK;
    if (wid >= 4) {
        const int p = wid - 4;
        const bf16* Abase = (const bf16*)(a.ws + (GU ? WS_H : WS_ACT));
        const int* rowtok = (const int*)(a.ws + WS_ROWTOK);
        const int k0 = 4 * (2 * p + (lane >> 5)), c4 = 4 * (lane & 31);
        const int kp0 = (k0 & ~12) | ((k0 & 4) << 1) | ((k0 & 8) >> 1);
        Unit UA, UW; int luA = 0, ktA = 0, luW = 0, ktW = 0; (void)S.next(0, UA); UW = UA;
        unsigned aoff[8]; const float* wsrc;
#define WS3_SETUP_A() do { _Pragma("unroll") for (int i = 0; i < 8; ++i) { const int row = 8 * (4 * i + p) + (lane >> 3); const unsigned cc = (unsigned)((lane & 7) ^ ((row >> 1) & 7)); \
            if (GU) { const int local = UA.mt * 256 + row; const unsigned tok = (local < cnt[UA.e]) ? (unsigned)rowtok[UA.e * ECAP + local] : 0u; aoff[i] = tok * (unsigned)(K * 2) + cc * 16u; } \
            else aoff[i] = (unsigned)(UA.tile * 256 + row) * (unsigned)(K * 2) + cc * 16u; } } while (0)
#define WS3_SETUP_W() do { if (GU) wsrc = ((c4 < 64) ? a.in[I_WGU] : a.in[I_WUP]) + (size_t)UW.e * DM * DEXP + (64 * UW.pn + (c4 & 63)) + (size_t)k0 * LDW; \
            else wsrc = a.in[I_WDN] + (size_t)UW.e * DEXP * DM + (128 * UW.pn + c4) + (size_t)k0 * LDW; } while (0)
        WS3_SETUP_A(); WS3_SETUP_W();
        f32x4 wvA[8], wvB[8], wvC[8];
#define WS3_ISSUE_A(slot) do { _Pragma("unroll") for (int i = 0; i < 8; ++i) \
                glds16((const char*)Abase + aoff[i] + ktA * 128, (unsigned)__builtin_amdgcn_readfirstlane((slot) * A3_BYTES + (4 * i + p) * 1024)); \
            if (++ktA == NK) { if (luA + 1 < nun) { ktA = 0; ++luA; (void)S.next(luA, UA); WS3_SETUP_A(); } else ktA = NK - 1; } } while (0)
#define WS3_ISSUE_W(WV) do { _Pragma("unroll") for (int i = 0; i < 4; ++i) { \
                WV[i] = *(const f32x4*)(wsrc + (size_t)(ktW * 64 + i) * LDW); \
                WV[4 + i] = *(const f32x4*)(wsrc + (size_t)(ktW * 64 + 32 + i) * LDW); } \
            if (++ktW == NK) { if (luW + 1 < nun) { ktW = 0; ++luW; (void)S.next(luW, UW); WS3_SETUP_W(); } else ktW = NK - 1; } } while (0)
#define WS3_WRITE_W(buf, WV) do { \
            LAS unsigned char* bb_ = lds + B3_OFF + (buf) * B_BYTES; \
            _Pragma("unroll") for (int i = 0; i < 4; ++i) { v2u w_; w_.x = cvt_pk_bf16(WV[i].x, WV[i].y); w_.y = cvt_pk_bf16(WV[i].z, WV[i].w); *(LAS v2u*)(bb_ + (kp0 + i) * B_STR + (lane & 31) * 8) = w_; \
                v2u x_; x_.x = cvt_pk_bf16(WV[4 + i].x, WV[4 + i].y); x_.y = cvt_pk_bf16(WV[4 + i].z, WV[4 + i].w); *(LAS v2u*)(bb_ + (32 + kp0 + i) * B_STR + (lane & 31) * 8) = x_; } } while (0)
#define WS3_BAR() asm volatile("s_waitcnt vmcnt(24) lgkmcnt(0)\n\ts_barrier" ::: "memory")
        WS3_ISSUE_W(wvA); WS3_ISSUE_A(0); WS3_ISSUE_W(wvB); WS3_ISSUE_A(1); WS3_ISSUE_W(wvC);
        WS3_WRITE_W(0, wvA); WS3_BAR();
#define WS3_SUB(j, slotA, WVI, WVW) do { WS3_ISSUE_A(slotA); WS3_ISSUE_W(WVI); WS3_WRITE_W(((j) + 1) & 1, WVW); WS3_BAR(); } while (0)
        int j = 0;
#pragma unroll 1
        for (; j + 3 <= total; j += 3) {
            WS3_SUB(j, 2, wvA, wvB);
            WS3_SUB(j + 1, 0, wvB, wvC);
            WS3_SUB(j + 2, 1, wvC, wvA);
        }
        if (j < total) { WS3_SUB(j, 2, wvA, wvB); if (j + 1 < total) WS3_SUB(j + 1, 0, wvB, wvC); }
        asm volatile("s_waitcnt vmcnt(0)" ::: "memory");
#undef WS3_SETUP_A
#undef WS3_SETUP_W
#undef WS3_ISSUE_A
#undef WS3_ISSUE_W
#undef WS3_WRITE_W
#undef WS3_BAR
#undef WS3_SUB
    } else {
        const int fr = lane & 15, g = lane >> 4;
        f32x4 acc[4][8];
#pragma unroll
        for (int m = 0; m < 4; ++m)
#pragma unroll
            for (int n = 0; n < 8; ++n) acc[m][n] = (f32x4){0.f, 0.f, 0.f, 0.f};
        Unit U; int cu = 0, kt = 0; (void)S.next(0, U);
        __syncthreads();
        int slot = 0;
#pragma unroll 1
        for (int s = 0; s < total; ++s) {
            LAS const unsigned char* ba = lds + slot * A3_BYTES; LAS const unsigned char* bb = lds + B3_OFF + (s & 1) * B_BYTES;
#pragma unroll
            for (int ks = 0; ks < 2; ++ks) {
                bf16x8 af[4], bfr[8];
#pragma unroll
                for (int m = 0; m < 4; ++m) { const int row = 64 * wid + 16 * m + fr; af[m] = *(const LAS bf16x8*)(ba + row * 128 + (((4 * ks + g) ^ ((row >> 1) & 7)) << 4)); }
#pragma unroll
                for (int n = 0; n < 8; ++n) { LAS const unsigned char* pp = bb + (32 * ks + 4 * (g & 1) + 16 * (g >> 1) + (fr >> 2)) * B_STR + (16 * n + 4 * (fr & 3)) * 2;
                    const s16x4 vl = tr_read(pp), vh = tr_read(pp + 8 * B_STR); bfr[n] = (bf16x8){vl[0], vl[1], vl[2], vl[3], vh[0], vh[1], vh[2], vh[3]}; }
#pragma unroll
                for (int m = 0; m < 4; ++m)
#pragma unroll
                    for (int n = 0; n < 8; ++n) acc[m][n] = __builtin_amdgcn_mfma_f32_16x16x32_bf16(bfr[n], af[m], acc[m][n], 0, 0, 0);
            }
            slot = (slot == 2) ? 0 : slot + 1;
            if (++kt == NK) {
                const size_t prow0 = (size_t)U.tile * 256 + 64 * wid + fr;
                if (GU) {
                    bf16* act = (bf16*)(a.ws + WS_ACT); const float* roww = (const float*)(a.ws + WS_ROWW);
#pragma unroll
                    for (int m = 0; m < 4; ++m) { const int local = U.mt * 256 + 64 * wid + 16 * m + fr;
                        const float w = (local < cnt[U.e]) ? roww[U.e * ECAP + local] : 0.f;
#pragma unroll
                        for (int n = 0; n < 4; ++n) { float o[4];
#pragma unroll
                            for (int r = 0; r < 4; ++r) { const float gt = acc[m][n][r]; o[r] = gt * sigmoidf_(gt) * acc[m][n + 4][r] * w; }
                            v2u wv2; wv2.x = cvt_pk_bf16(o[0], o[1]); wv2.y = cvt_pk_bf16(o[2], o[3]);
                            *(v2u*)(act + (prow0 + 16 * m) * DEXP + 64 * U.pn + 16 * n + 4 * g) = wv2; } }
                } else {
                    bf16* Y = (bf16*)(a.ws + WS_Y);
#pragma unroll
                    for (int m = 0; m < 4; ++m)
#pragma unroll
                        for (int q = 0; q < 4; ++q) { v4u w4; w4.x = cvt_pk_bf16(acc[m][2 * q][0], acc[m][2 * q][1]); w4.y = cvt_pk_bf16(acc[m][2 * q][2], acc[m][2 * q][3]);
                            w4.z = cvt_pk_bf16(acc[m][2 * q + 1][0], acc[m][2 * q + 1][1]); w4.w = cvt_pk_bf16(acc[m][2 * q + 1][2], acc[m][2 * q + 1][3]);
                            *(v4u*)(Y + (prow0 + 16 * m) * DM + 128 * U.pn + 32 * g + 8 * q) = w4; }
                }
#pragma unroll
                for (int m = 0; m < 4; ++m)
#pragma unroll
                    for (int n = 0; n < 8; ++n) acc[m][n] = (f32x4){0.f, 0.f, 0.f, 0.f};
                kt = 0; ++cu; if (cu < nun) (void)S.next(cu, U);
            }
            __syncthreads();
        }
    }
    __syncthreads();
}
}

__device__ __forceinline__ int fresh_tid() { int t = threadIdx.x; asm volatile("" : "+v"(t)); return t; }
#define PH_IDS const int tid = fresh_tid(), lane = tid & 63, wave = __builtin_amdgcn_readfirstlane(tid >> 6); (void)lane; (void)wave; KArgs& args = *kargs(); unsigned char* ws = args.ws; (void)ws
constexpr int NPHASE = 11;
__global__ void __launch_bounds__(NWAVES * 64, 2) mk_fwd(Args args_) {
    extern __shared__ __attribute__((aligned(16))) unsigned char lds_raw[];
    LAS unsigned char* lds = (LAS unsigned char*)lds_raw;
    volatile LAS unsigned* MISC = (volatile LAS unsigned*)(lds + MISC_OFF);
    const int tid0 = threadIdx.x;
    const int G = gridDim.x; const int bx = blockIdx.x; const int vcu = (G % 8 == 0) ? (bx % 8) * (G / 8) + bx / 8 : bx;
    gu32* ctl = (gu32*)(args_.ws + WS_CTL);
    for (int u = tid0; u < (LDS_BYTES - LDSCTL_OFF) / 4; u += NWAVES * 64) ((LAS unsigned*)(lds + LDSCTL_OFF))[u] = 0u;
    __syncthreads();
    XcdBarrier bar; bar.bar = (unsigned*)ctl + CW_BAR; bar.x = 0; bar.st = nullptr;
    if (!MK_LAUNCH_PER_PHASE) bar = xcd_barrier_post((unsigned*)ctl + CW_BAR, MISC + 8);
    const int lo = args_.ph_lo, hi = args_.ph_hi;
#ifndef PH_MASK
#define PH_MASK 0x7ff
#endif
#ifndef PH_REP
#define PH_REP 0
#endif
#define NREP(k) (1 + ((PH_REP >> (k)) & 1))
#define IN(k) (((PH_MASK >> (k)) & 1) && lo <= (k) && (k) < hi)
#define SEAM(k) do { if (IN(k) && IN((k) + 1)) { if (!MK_LAUNCH_PER_PHASE) xcd_barrier(bar); } } while (0)
    if (IN(0)) { PH_IDS; for (int rep = 0; rep < NREP(0); ++rep) { p0_prologue(args, lds, vcu, G, tid, lane, wave); if (rep) xcd_barrier(bar); } }
    SEAM(0);
    if (IN(1)) { PH_IDS; for (int rep = 0; rep < NREP(1); ++rep) { p1_norm1(args, lds, vcu, G, tid, lane, wave); if (rep) xcd_barrier(bar); } }
    SEAM(1);
    if (IN(2)) { PH_IDS;
        pg8::Gemm g{(const bf16*)(ws + WS_H), nullptr, (const bf16*)(ws + WS_WTIN), nullptr, DM};
        pg8::StaticOrder S; S.init(MTOK, NPROJP, G, bx);
        pg8::EpiStore E{(bf16*)(ws + WS_PROJ), NPROJP};
        for (int rep = 0; rep < NREP(2); ++rep) { pg8::gemm_phase<pg8::EpiStore, pg8::StaticOrder, true, false>(lds, g, S, E); if (rep) xcd_barrier(bar); }
    }
    SEAM(2);
    if (IN(3)) { const int tid = threadIdx.x, lane = tid & 63, wave = __builtin_amdgcn_readfirstlane(tid >> 6); KArgs& args = *kargs(); unsigned char* ws = args.ws;
        bf16* PROJ = (bf16*)(ws + WS_PROJ);
        prep_norms(args, vcu, G, lane, wave);
        if (!(DBG_SKIP & 2)) {
            unsigned short* idxo = (unsigned short*)(ws + WS_IDX);
            for (int rep = 0; rep < NREP(3); ++rep) { for (int i = vcu; i < 512; i += G) { const int u = (i < 256) ? i : 767 - i;
                indexer_unit(PROJ, idxo, lds, (u & 3) * 128 + (u >> 2), tid, lane, wave); } if (rep) xcd_barrier(bar); }
        }
    }
    SEAM(3);
    if (IN(4)) { PH_IDS;
        bf16* PROJ = (bf16*)(ws + WS_PROJ); bf16* OA = (bf16*)(ws + WS_OA); bf16* OB = (bf16*)(ws + WS_OB);
        if (!(DBG_SKIP & 1)) { for (int rep = 0; rep < NREP(11); ++rep) { for (int u = vcu; u < 256; u += G) swa_unit(PROJ, OA, args.in[I_SINKS], lds, u, tid, lane, wave); if (rep) xcd_barrier(bar); } }
        else { for (size_t i = (size_t)bx * 512 + tid; i < (size_t)MTOK * 1024 / 8; i += (size_t)G * 512) ((v4u*)OA)[i] = (v4u){0u, 0u, 0u, 0u}; }
        if (!(DBG_SKIP & 2)) {
            const unsigned short* idx = (const unsigned short*)(ws + WS_IDX);
            LAS unsigned char* wl = lds + wave * DS_WAVE;
            const int gw = vcu * NWAVES + wave, NGW = G * NWAVES;
            for (int rep = 0; rep < NREP(4); ++rep) {
                int q = gw; int qq = (q & 1) ? (MTOK - 1 - (q >> 1)) : (q >> 1);
                DsaPre pre = dsa_prefetch(PROJ, idx, qq >> 11, qq & 2047, lane);
                for (; q < MTOK; q += NGW) {
                    const DsaPre cur = pre; const int cb = qq >> 11, ct = qq & 2047;
                    const int qn = q + NGW; if (qn < MTOK) { qq = (qn & 1) ? (MTOK - 1 - (qn >> 1)) : (qn >> 1); pre = dsa_prefetch(PROJ, idx, qq >> 11, qq & 2047, lane); }
                    dsa_query(PROJ, cur, OB, wl, cb, ct, lane);
                }
                if (rep) xcd_barrier(bar); }
        } else { for (size_t i = (size_t)bx * 512 + tid; i < (size_t)MTOK * 1024 / 8; i += (size_t)G * 512) ((v4u*)OB)[i] = (v4u){0u, 0u, 0u, 0u}; }
        __syncthreads();
    }
    SEAM(4);
    if (IN(5)) { PH_IDS;
        pg8::Gemm g{(const bf16*)(ws + WS_OA), (const bf16*)(ws + WS_OB), (const bf16*)(ws + WS_WTA), (const bf16*)(ws + WS_WTB), 1024};
        pg8::PairOrder S; S.init(MTOK, DM, G, bx);
        pg8::EpiGate E{(bf16*)(ws + WS_PROJ), (bf16*)(ws + WS_T), (bf16*)(ws + WS_MRG)};
        for (int rep = 0; rep < NREP(5); ++rep) { pg8::gemm_phase<pg8::EpiGate, pg8::PairOrder, true, false>(lds, g, S, E); if (rep) xcd_barrier(bar); }
    }
    SEAM(5);
    if (IN(6)) { PH_IDS;
        pg8::Gemm g{(const bf16*)(ws + WS_MRG), nullptr, (const bf16*)(ws + WS_WTO), nullptr, DM};
        pg8::StaticOrder S; S.init(MTOK, DM, G, bx);
        pg8::EpiOut E{args.in[I_X], (const float*)(ws + WS_MODF), args.out};
        for (int rep = 0; rep < NREP(6); ++rep) { pg8::gemm_phase<pg8::EpiOut, pg8::StaticOrder, true, false>(lds, g, S, E); if (rep) xcd_barrier(bar); }
    }
    SEAM(6);
    if (IN(7)) { PH_IDS; if (!(DBG_SKIP & 4)) for (int u = vcu; u < 256; u += G) router_unit(args, lds, u, tid, lane, wave); }
    SEAM(7);
    if (IN(8)) { PH_IDS; if (!(DBG_SKIP & 4)) {
        moe_table(args, lds, tid);
        const LAS int* tb = (const LAS int*)(lds + MOE_TB_OFF); const LAS int* cn = tb + 40;
        wsg::Order S{tb, 8, G, vcu, tb[NEXP] * 8};
        for (int rep = 0; rep < NREP(8); ++rep) { wsg::ws_gemm3<true>(lds, args, S, cn); if (rep) xcd_barrier(bar); }
    } }
    SEAM(8);
    if (IN(9)) { PH_IDS; if (!(DBG_SKIP & 4)) {
        moe_table(args, lds, tid);
        const LAS int* tb = (const LAS int*)(lds + MOE_TB_OFF); const LAS int* cn = tb + 40;
        wsg::Order S{tb, 16, G, vcu, tb[NEXP] * 16};
        for (int rep = 0; rep < NREP(9); ++rep) { wsg::ws_gemm3<false>(lds, args, S, cn); if (rep) xcd_barrier(bar); }
    } }
    SEAM(9);
    if (IN(10)) { PH_IDS; if (!(DBG_SKIP & 4)) {
        moe_table(args, lds, tid);
        const LAS int* tb = (const LAS int*)(lds + MOE_TB_OFF);
        const int gw = vcu * NWAVES + wave, NGW = G * NWAVES;
        const float* modf = (const float*)(ws + WS_MODF); const bf16* Y = (const bf16*)(ws + WS_Y);
        for (int m = gw; m < MTOK; m += NGW) {
            const int b = m >> 11; const int* ti = (const int*)(ws + WS_TOK) + m * 4;
            const size_t r1 = (size_t)tb[ti[0]] * 256 + ti[1], r2 = (size_t)tb[ti[2]] * 256 + ti[3];
            float* orow = args.out + (size_t)m * DM;
#pragma unroll
            for (int j = 0; j < 4; ++j) { const int kp = 8 * lane + 512 * j;
                const int k = (kp & ~127) + 32 * ((kp >> 3) & 3) + 4 * ((kp >> 5) & 3), k2 = k + 16;
                const v4u y1 = *(const v4u*)(Y + r1 * DM + kp), y2 = *(const v4u*)(Y + r2 * DM + kp);
                const f32x4 g0 = *(const f32x4*)(modf + b * 12288 + 10240 + k), g1 = *(const f32x4*)(modf + b * 12288 + 10240 + k2);
                f32x4 x0 = *(const f32x4*)(orow + k), x1 = *(const f32x4*)(orow + k2);
                x0.x += g0.x * (bflo(y1.x) + bflo(y2.x)); x0.y += g0.y * (bfhi(y1.x) + bfhi(y2.x)); x0.z += g0.z * (bflo(y1.y) + bflo(y2.y)); x0.w += g0.w * (bfhi(y1.y) + bfhi(y2.y));
                x1.x += g1.x * (bflo(y1.z) + bflo(y2.z)); x1.y += g1.y * (bfhi(y1.z) + bfhi(y2.z)); x1.z += g1.z * (bflo(y1.w) + bflo(y2.w)); x1.w += g1.w * (bfhi(y1.w) + bfhi(y2.w));
                *(f32x4*)(orow + k) = x0; *(f32x4*)(orow + k2) = x1; }
        }
    } }
#undef IN
#undef SEAM
}

extern "C" void kernel_launch(void* const* d_in, const int* in_sizes, int n_in, void* d_out, int out_size, void* d_ws, size_t ws_size, hipStream_t stream) {
    static int grid = 0;
    if (grid == 0) {
        if (n_in != 22 || out_size != MTOK * DM || ws_size < WS_END) { fprintf(stderr, "kernel_launch: unexpected shapes (n_in %d, out %d, ws %zu < %zu)\n", n_in, out_size, ws_size, (size_t)WS_END); grid = -1; return; }
        int dev = 0, cus = 0;
        if (hipGetDevice(&dev) != hipSuccess || hipDeviceGetAttribute(&cus, hipDeviceAttributeMultiprocessorCount, dev) != hipSuccess) { grid = -1; return; }
        if (hipFuncSetAttribute((const void*)mk_fwd, hipFuncAttributeMaxDynamicSharedMemorySize, LDS_BYTES) != hipSuccess) { fprintf(stderr, "kernel_launch: hipFuncSetAttribute failed\n"); grid = -1; return; }
        int per_cu = 0;
        if (hipOccupancyMaxActiveBlocksPerMultiprocessor(&per_cu, (const void*)mk_fwd, NWAVES * 64, LDS_BYTES) != hipSuccess || per_cu < 1) fprintf(stderr, "kernel_launch: occupancy query says %d\n", per_cu);
        (void)hipGetLastError();
        grid = cus;
    }
    if (grid < 0) return;
    if (hipMemsetAsync((char*)d_ws + WS_CTL, 0, CTL_ZERO_BYTES, stream) != hipSuccess) { fprintf(stderr, "kernel_launch: memset failed\n"); return; }
    Args a{};
    for (int i = 0; i < 22; ++i) a.in[i] = (const float*)d_in[i];
    a.out = (float*)d_out; a.ws = (unsigned char*)d_ws;
#if MK_LAUNCH_PER_PHASE
    for (int p = 0; p < NPHASE; ++p) { a.ph_lo = p; a.ph_hi = p + 1; hipLaunchKernelGGL(mk_fwd, dim3(grid), dim3(NWAVES * 64), LDS_BYTES, stream, a); }
#else
    a.ph_lo = 0; a.ph_hi = NPHASE;
    hipLaunchKernelGGL(mk_fwd, dim3(grid), dim3(NWAVES * 64), LDS_BYTES, stream, a);
#endif
    const hipError_t le = hipPeekAtLastError();
    if (le != hipSuccess) fprintf(stderr, "kernel_launch: launch failed: %s\n", hipGetErrorName(le));
}
```

```cpp
#include <hip/hip_runtime.h>
#include <cstdio>
#include <cstdint>

#ifndef MK_LAUNCH_PER_PHASE
#define MK_LAUNCH_PER_PHASE 0
#endif
#ifndef DBG_SKIP
#define DBG_SKIP 0
#endif

#define GAS __attribute__((address_space(1)))
#define LAS __attribute__((address_space(3)))
typedef unsigned short bf16;
typedef unsigned v4u __attribute__((ext_vector_type(4)));
typedef unsigned v2u __attribute__((ext_vector_type(2)));
typedef float f32x4 __attribute__((ext_vector_type(4)));
typedef float f32x16 __attribute__((ext_vector_type(16)));
typedef short bf16x8 __attribute__((ext_vector_type(8)));
typedef short s16x4 __attribute__((ext_vector_type(4)));
typedef GAS unsigned gu32;

constexpr int NB = 4, SEQ = 2048, DM = 2048, MTOK = NB * SEQ;
constexpr int NPROJ = 7888, NPROJP = 7936;
constexpr int C_QA = 0, C_KA = 1024, C_VA = 1280, C_QB = 1536, C_KB = 2560, C_VB = 2624, C_QI = 2688, C_KI = 3712, C_WI = 3776, C_GA = 3792, C_GB = 5840;
constexpr int NEXP = 32, DEXP = 512, ECAP = 8192, PADROWS = 24576;
constexpr float LOG2E = 1.4426950408889634f;
constexpr float RMS_EPS = 1e-6f;
constexpr float NEGBIG = -1e30f;

constexpr size_t MiB = 1u << 20;
constexpr size_t WS_CTL = 0, CTL_ZERO_BYTES = 1 * MiB;
constexpr size_t WS_MODP = 1 * MiB;
constexpr size_t WS_MODF = 2 * MiB;
constexpr size_t WS_CB   = 2 * MiB + 512 * 1024;
constexpr size_t WS_TOK  = 2 * MiB + 768 * 1024;
constexpr size_t WS_ROWTOK = 3 * MiB;
constexpr size_t WS_ROWW = 4 * MiB;
constexpr size_t WS_IDX  = 5 * MiB;
constexpr size_t WS_WTIN = 9 * MiB;
constexpr size_t WS_WTA  = 40 * MiB, WS_WTB = 44 * MiB, WS_WTO = 48 * MiB;
constexpr size_t WS_WRH = 56 * MiB, WS_WRL = 57 * MiB;
constexpr size_t WS_WTGU = 60 * MiB;
constexpr size_t WS_WTD  = 184 * MiB;
constexpr size_t WS_H    = 248 * MiB;
constexpr size_t WS_PROJ = 280 * MiB;
constexpr size_t WS_Y    = WS_PROJ;
constexpr size_t WS_OA   = 404 * MiB, WS_OB = 420 * MiB;
constexpr size_t WS_T    = 436 * MiB;
constexpr size_t WS_MRG  = 468 * MiB;
constexpr size_t WS_ACT  = 500 * MiB;
constexpr size_t WS_END  = 524 * MiB;
constexpr int CW_BAR = 4096;
constexpr int CW_ECNT = 16384;

constexpr int RING_BYTES = 135168;
constexpr int LDSCTL_OFF = RING_BYTES, MISC_OFF = LDSCTL_OFF + 320;
constexpr int MOE_TB_OFF = LDSCTL_OFF + 1024;
constexpr int MOE_NOFF = LDSCTL_OFF + 2048;
constexpr int LDS_BYTES = 147456;
constexpr int NWAVES = 8;

#define RLX_AGENT __ATOMIC_RELAXED, __HIP_MEMORY_SCOPE_AGENT
#define LDS_WAIT() asm volatile("s_waitcnt lgkmcnt(0)" ::: "memory")
#define VM_WAIT() asm volatile("s_waitcnt vmcnt(0)" ::: "memory")

__device__ __forceinline__ unsigned cvt_pk_bf16(float lo, float hi) { unsigned r; asm volatile("v_cvt_pk_bf16_f32 %0, %1, %2" : "=v"(r) : "v"(lo), "v"(hi)); return r; }
__device__ __forceinline__ float bflo(unsigned w) { return __uint_as_float(w << 16); }
__device__ __forceinline__ float bfhi(unsigned w) { return __uint_as_float(w & 0xffff0000u); }
__device__ __forceinline__ float fast_exp2(float x) { return __builtin_amdgcn_exp2f(x); }
__device__ __forceinline__ float fast_rcp(float x) { return __builtin_amdgcn_rcpf(x); }
__device__ __forceinline__ float sigmoidf_(float x) { return fast_rcp(1.f + fast_exp2(-x * LOG2E)); }
__device__ __forceinline__ float wave_sum(float v) {
#pragma unroll
    for (int o = 1; o < 64; o <<= 1) v += __shfl_xor(v, o);
    return v;
}
__device__ __forceinline__ s16x4 tr_read(LAS const unsigned char* p) {
    typedef short v4i16_t __attribute__((ext_vector_type(4)));
    return __builtin_bit_cast(s16x4, __builtin_amdgcn_ds_read_tr16_b64_v4i16((LAS v4i16_t*)p));
}
__device__ __forceinline__ int crow(int r, int hi) { return (r & 3) + 8 * (r >> 2) + 4 * hi; }

namespace pg8 {
typedef unsigned short bf16_t;
typedef unsigned u32x4 __attribute__((ext_vector_type(4)));
constexpr int BM = 256, BK = 64, HALF = 128, HTB = HALF * BK * 2, STAGE_BYTES = 8 * HTB, NXCD = 8, WGM = 8;
__host__ __device__ __forceinline__ int lds_byte(int r, int c) { const int st = (r >> 4) * 2 + (c >> 5), rr = r & 15, cc = c & 31, ob = rr * 64 + cc * 2; return st * 1024 + (ob ^ (((ob >> 9) & 1) << 5)); }
__host__ __device__ __forceinline__ void stage_rc(int b, int& R, int& C) { const int st = b / 1024, sb = b % 1024, swz = sb ^ (((sb >> 9) & 1) << 5); R = (st >> 1) * 16 + swz / 64; C = (st & 1) * 32 + (swz % 64) / 2; }
__host__ __device__ __forceinline__ int perm32(int rho) { const int n = rho >> 4, i = rho & 15; return 8 * (i >> 2) + 4 * n + (i & 3); }

struct Unit { int pm, pn, pb, ga; };
struct Gemm { const bf16_t* A0; const bf16_t* A1; const bf16_t* B0; const bf16_t* B1; int K; };

struct StaticOrder {
    static constexpr bool PAIR = false;
    int nM, nN, nwg, G, c;
    __device__ void init(int M, int N, int G_, int c_) { nM = M / BM; nN = N / BM; nwg = nM * nN; G = G_; c = c_; }
    __device__ bool next(int i, Unit& u) const {
        const long L = (long)i * G + c; if (L >= nwg) return false;
        int wgid = (int)L; { const int q = nwg / NXCD, r = nwg % NXCD, xcd = wgid % NXCD, off = wgid / NXCD; wgid = (xcd < r ? xcd * (q + 1) : r * (q + 1) + (xcd - r) * q) + off; }
        const int nig = WGM * nN, gid = wgid / nig, fm = gid * WGM, gsz = (nM - fm) < WGM ? (nM - fm) : WGM;
        u.pm = fm + ((wgid % nig) % gsz); u.pn = (wgid % nig) / gsz; u.pb = u.pn; u.ga = 0; return true;
    }
    __device__ __forceinline__ unsigned arow(const Unit&, int) const { return 0u; }
};
struct PairOrder {
    static constexpr bool PAIR = true;
    int nM, nN, nwg, G, c;
    __device__ void init(int M, int N, int G_, int c_) { nM = M / BM; nN = N / BM; nwg = nM * nN; G = G_; c = c_; }
    __device__ bool next(int i, Unit& u) const {
        const long L = (long)(i >> 1) * G + c; if (L >= nwg) return false;
        int wgid = (int)L; { const int q = nwg / NXCD, r = nwg % NXCD, xcd = wgid % NXCD, off = wgid / NXCD; wgid = (xcd < r ? xcd * (q + 1) : r * (q + 1) + (xcd - r) * q) + off; }
        const int nig = WGM * nN, gid = wgid / nig, fm = gid * WGM, gsz = (nM - fm) < WGM ? (nM - fm) : WGM;
        u.pm = fm + ((wgid % nig) % gsz); u.pn = (wgid % nig) / gsz; u.pb = u.pn; u.ga = i & 1; return true;
    }
    __device__ __forceinline__ unsigned arow(const Unit&, int) const { return 0u; }
};
struct MoeOrder {
    static constexpr bool PAIR = false;
    const LAS int* tb; const LAS int* cnt; const int* rowtok; int npn, G, c, total; bool gather;
    __device__ bool next(int i, Unit& u) const {
        const int L = i * G + c; if (L >= total) return false;
        const int tile = L / npn, pn = L - tile * npn; int e = 0;
#pragma unroll
        for (int j = 1; j < NEXP; ++j) e += (tile >= tb[j]) ? 1 : 0;
        u.pm = tile; u.pn = pn; u.pb = e * npn + pn; u.ga = e; return true;
    }
    __device__ __forceinline__ unsigned arow(const Unit& u, int r) const {
        const int e = u.ga, local = (u.pm - tb[e]) * 256 + r;
        return (local < cnt[e]) ? (unsigned)rowtok[e * ECAP + local] : 0u;
    }
};

template <class Epi, class Sched, bool ALIGN_EPI, bool GATHER>
__device__ __forceinline__ void gemm_phase(LAS unsigned char* lds, const Gemm g, const Sched& S, const Epi& E) {
    const int tid = threadIdx.x, wid = __builtin_amdgcn_readfirstlane(tid >> 6), lane = tid & 63, wr = wid >> 2, wc = wid & 3, fr = lane & 15, fq = lane >> 4;
    const int K = g.K, nt = K / BK;
    unsigned voffA[2], voffB[2]; int RA[2], CA[2];
#pragma unroll
    for (int i = 0; i < 2; ++i) { int R, C; stage_rc(tid * 16 + i * 8192, R, C); const int Rb = Epi::PERM ? ((R & ~31) + perm32(R & 31)) : R;
        RA[i] = R; CA[i] = C; voffA[i] = (unsigned)(R * K + C) * 2u; voffB[i] = (unsigned)(Rb * K + C) * 2u; }
    const size_t kstep = (size_t)(BK * 2);
    const size_t hstep = (size_t)HALF * K * 2;
    const size_t tstep = 2 * hstep;
    const unsigned ldsw = (unsigned)wid * 1024u;
    const int aoff = lds_byte(wr * 64 + fr, fq * 8), boff = lds_byte(wc * 32 + fr, fq * 8);
    LAS unsigned* noff = (LAS unsigned*)(lds + MOE_NOFF) + tid * 4;
#define PG8_SA(b, h) (((b) * 2 + (h)) * HTB)
#define PG8_SB(b, h) ((4 + (b) * 2 + (h)) * HTB)
#define PG8_STAGE(bufoff, gbase, voff) do { _Pragma("unroll") for (int _i = 0; _i < 2; ++_i) \
        __builtin_amdgcn_global_load_lds((const unsigned*)((const char*)(gbase) + (voff)[_i]), (LAS unsigned*)(lds + (bufoff) + ldsw + _i * 8192), 16, 0, 0); } while (0)
#define PG8_LDA(dst, b, h) do { _Pragma("unroll") for (int m = 0; m < 4; ++m) _Pragma("unroll") for (int k = 0; k < 2; ++k) dst[m][k] = *(const LAS bf16x8*)(lds + PG8_SA(b, h) + aoff + m * 2048 + k * 1024); } while (0)
#define PG8_LDB(dst, b, h) do { _Pragma("unroll") for (int n = 0; n < 2; ++n) _Pragma("unroll") for (int k = 0; k < 2; ++k) dst[n][k] = *(const LAS bf16x8*)(lds + PG8_SB(b, h) + boff + n * 2048 + k * 1024); } while (0)
#define PG8_MMA(ai, bj, At, Bt) do { __builtin_amdgcn_s_setprio(1); _Pragma("unroll") for (int m = 0; m < 4; ++m) _Pragma("unroll") for (int n = 0; n < 2; ++n) _Pragma("unroll") for (int k = 0; k < 2; ++k) \
        acc[ai][bj][m][n] = __builtin_amdgcn_mfma_f32_16x16x32_bf16(Bt[n][k], At[m][k], acc[ai][bj][m][n], 0, 0, 0); __builtin_amdgcn_s_setprio(0); } while (0)
#define PG8_WAIT_V(n) asm volatile("s_waitcnt vmcnt(" #n ")" ::: "memory")
#define PG8_WAIT_L(n) asm volatile("s_waitcnt lgkmcnt(" #n ")" ::: "memory")
#define PG8_BAR __builtin_amdgcn_s_barrier()
#define PG8_SCHED __builtin_amdgcn_sched_barrier(0)
    Unit cur, nxt; int ui = 0;
    if (!S.next(0, cur)) return;
    f32x4 acc[2][2][4][2];
#pragma unroll
    for (int a = 0; a < 2; ++a)
#pragma unroll
        for (int b = 0; b < 2; ++b)
#pragma unroll
            for (int m = 0; m < 4; ++m)
#pragma unroll
                for (int n = 0; n < 2; ++n) acc[a][b][m][n] = (f32x4){0.f, 0.f, 0.f, 0.f};
    bf16x8 At[4][2], B0[2][2], B1[2][2];
    unsigned cO0[2], cO1[2];
    const char* cA; const char* cB;
    if constexpr (GATHER) {
        cA = (const char*)g.A0;
#pragma unroll
        for (int i = 0; i < 2; ++i) { cO0[i] = S.arow(cur, RA[i]) * (unsigned)(K * 2) + (unsigned)CA[i] * 2u; cO1[i] = S.arow(cur, HALF + RA[i]) * (unsigned)(K * 2) + (unsigned)CA[i] * 2u; }
    } else {
        cA = (const char*)((Sched::PAIR && cur.ga) ? g.A1 : g.A0) + (size_t)cur.pm * tstep;
#pragma unroll
        for (int i = 0; i < 2; ++i) { cO0[i] = voffA[i]; cO1[i] = voffA[i] + (unsigned)hstep; }
    }
    cB = (const char*)((Sched::PAIR && cur.ga) ? g.B1 : g.B0) + (size_t)cur.pb * tstep;
    PG8_STAGE(PG8_SB(0, 0), cB, voffB); PG8_STAGE(PG8_SB(0, 1), cB + hstep, voffB); PG8_STAGE(PG8_SA(0, 0), cA, cO0); PG8_STAGE(PG8_SA(0, 1), cA, cO1);
    if (wr == 1) PG8_BAR;
    PG8_WAIT_V(2); PG8_BAR;
    PG8_STAGE(PG8_SB(1, 0), cB + kstep, voffB); PG8_STAGE(PG8_SA(1, 0), cA + kstep, cO0); PG8_STAGE(PG8_SB(1, 1), cB + hstep + kstep, voffB);
    PG8_WAIT_V(6); PG8_BAR;
    for (;;) {
        const bool has_next = S.next(ui + 1, nxt);
        const char* nA; const char* nB;
        if constexpr (GATHER) {
            nA = cA;
            if (has_next) {
                u32x4 o; o.x = S.arow(nxt, RA[0]) * (unsigned)(K * 2) + (unsigned)CA[0] * 2u; o.y = S.arow(nxt, RA[1]) * (unsigned)(K * 2) + (unsigned)CA[1] * 2u;
                o.z = S.arow(nxt, HALF + RA[0]) * (unsigned)(K * 2) + (unsigned)CA[0] * 2u; o.w = S.arow(nxt, HALF + RA[1]) * (unsigned)(K * 2) + (unsigned)CA[1] * 2u;
                *(LAS u32x4*)noff = o;
            } else { u32x4 o; o.x = cO0[0]; o.y = cO0[1]; o.z = cO1[0]; o.w = cO1[1]; *(LAS u32x4*)noff = o; }
        } else {
            nA = has_next ? (const char*)((Sched::PAIR && nxt.ga) ? g.A1 : g.A0) + (size_t)nxt.pm * tstep : cA;
        }
        nB = has_next ? (const char*)((Sched::PAIR && nxt.ga) ? g.B1 : g.B0) + (size_t)nxt.pb * tstep : cB;
        for (int t = 0; t < nt; t += 2) {
            const bool last = (t == nt - 2);
            const char* a1 = cA + (size_t)(t + 1) * kstep;
            const char* a2 = last ? nA : cA + (size_t)(t + 2) * kstep; const char* b2 = last ? nB : cB + (size_t)(t + 2) * kstep;
            const char* a3 = a2 + kstep; const char* b3 = b2 + kstep;
            unsigned sO0[2], sO1[2];
            if constexpr (GATHER) {
                if (last) { const u32x4 o = *(const LAS u32x4*)noff; sO0[0] = o.x; sO0[1] = o.y; sO1[0] = o.z; sO1[1] = o.w; }
                else { sO0[0] = cO0[0]; sO0[1] = cO0[1]; sO1[0] = cO1[0]; sO1[1] = cO1[1]; }
            } else { sO0[0] = cO0[0]; sO0[1] = cO0[1]; sO1[0] = cO1[0]; sO1[1] = cO1[1]; }
            PG8_LDB(B0, 0, 0); PG8_LDB(B1, 0, 1); PG8_SCHED; PG8_LDA(At, 0, 0); PG8_STAGE(PG8_SA(1, 1), a1, cO1);
            PG8_WAIT_V(8); PG8_WAIT_L(0); PG8_BAR; PG8_MMA(0, 0, At, B0); PG8_MMA(0, 1, At, B1); PG8_BAR; PG8_SCHED;
            PG8_LDA(At, 0, 1); PG8_STAGE(PG8_SB(0, 0), b2, voffB); PG8_STAGE(PG8_SB(0, 1), b2 + hstep, voffB); PG8_STAGE(PG8_SA(0, 0), a2, sO0);
            PG8_WAIT_V(8); PG8_WAIT_L(0); PG8_BAR; PG8_MMA(1, 0, At, B0); PG8_MMA(1, 1, At, B1); PG8_BAR; PG8_SCHED;
            PG8_LDB(B0, 1, 0); PG8_LDB(B1, 1, 1); PG8_SCHED; PG8_LDA(At, 1, 0); PG8_STAGE(PG8_SA(0, 1), a2, sO1);
            PG8_WAIT_V(8); PG8_WAIT_L(0); PG8_BAR; PG8_MMA(0, 0, At, B0); PG8_MMA(0, 1, At, B1); PG8_BAR; PG8_SCHED;
            PG8_LDA(At, 1, 1); PG8_STAGE(PG8_SB(1, 0), b3, voffB); PG8_STAGE(PG8_SB(1, 1), b3 + hstep, voffB); PG8_STAGE(PG8_SA(1, 0), a3, sO0);
            PG8_WAIT_V(8); PG8_WAIT_L(0); PG8_BAR; PG8_MMA(1, 0, At, B0); PG8_MMA(1, 1, At, B1); PG8_BAR; PG8_SCHED;
        }
        if constexpr (ALIGN_EPI) { if (wr == 0) PG8_BAR; }
        E(acc, cur, wr, wc, fr, fq);
        if (!has_next) break;
#pragma unroll
        for (int a = 0; a < 2; ++a)
#pragma unroll
            for (int b = 0; b < 2; ++b)
#pragma unroll
                for (int m = 0; m < 4; ++m)
#pragma unroll
                    for (int n = 0; n < 2; ++n) acc[a][b][m][n] = (f32x4){0.f, 0.f, 0.f, 0.f};
        cur = nxt; cA = nA; cB = nB; ++ui;
        if constexpr (GATHER) { const u32x4 o = *(const LAS u32x4*)noff; cO0[0] = o.x; cO0[1] = o.y; cO1[0] = o.z; cO1[1] = o.w; }
        if constexpr (ALIGN_EPI) { if (wr == 1) PG8_BAR; }
    }
    PG8_WAIT_V(0);
    if constexpr (!ALIGN_EPI) { if (wr == 0) PG8_BAR; }
    PG8_BAR;
#undef PG8_SA
#undef PG8_SB
#undef PG8_STAGE
#undef PG8_LDA
#undef PG8_LDB
#undef PG8_MMA
#undef PG8_WAIT_V
#undef PG8_WAIT_L
#undef PG8_BAR
#undef PG8_SCHED
}

struct EpiStore {
    static constexpr bool PERM = true;
    bf16_t* O; int ldc;
    __device__ __forceinline__ void operator()(const f32x4 (&acc)[2][2][4][2], const Unit& u, int wr, int wc, int fr, int fq) const {
        const int row0 = u.pm * BM + wr * 64 + fr, col0 = u.pn * BM + wc * 32 + 8 * fq;
#pragma unroll
        for (int ai = 0; ai < 2; ++ai)
#pragma unroll
            for (int m = 0; m < 4; ++m) { bf16_t* rowp = O + (size_t)(row0 + ai * HALF + m * 16) * ldc + col0;
#pragma unroll
                for (int bj = 0; bj < 2; ++bj) { const f32x4 v0 = acc[ai][bj][m][0], v1 = acc[ai][bj][m][1];
                    u32x4 w; w.x = cvt_pk_bf16(v0[0], v0[1]); w.y = cvt_pk_bf16(v0[2], v0[3]); w.z = cvt_pk_bf16(v1[0], v1[1]); w.w = cvt_pk_bf16(v1[2], v1[3]);
                    *(u32x4*)(rowp + bj * HALF) = w; } }
    }
};
struct EpiGate {
    static constexpr bool PERM = true;
    const bf16_t* proj; bf16_t* T; bf16_t* mrg;
    __device__ __forceinline__ void operator()(const f32x4 (&acc)[2][2][4][2], const Unit& u, int wr, int wc, int fr, int fq) const {
        const int row0 = u.pm * BM + wr * 64 + fr, col0 = u.pn * BM + wc * 32 + 8 * fq;
        const int gcol = (u.ga ? C_GB : C_GA) + col0;
#pragma unroll
        for (int ai = 0; ai < 2; ++ai)
#pragma unroll
            for (int m = 0; m < 4; ++m) { const size_t row = (size_t)(row0 + ai * HALF + m * 16);
#pragma unroll
                for (int bj = 0; bj < 2; ++bj) { const f32x4 v0 = acc[ai][bj][m][0], v1 = acc[ai][bj][m][1];
                    const u32x4 gt = *(const u32x4*)(proj + row * NPROJP + gcol + bj * HALF);
                    float r[8];
                    r[0] = v0[0] * sigmoidf_(bflo(gt.x)); r[1] = v0[1] * sigmoidf_(bfhi(gt.x)); r[2] = v0[2] * sigmoidf_(bflo(gt.y)); r[3] = v0[3] * sigmoidf_(bfhi(gt.y));
                    r[4] = v1[0] * sigmoidf_(bflo(gt.z)); r[5] = v1[1] * sigmoidf_(bfhi(gt.z)); r[6] = v1[2] * sigmoidf_(bflo(gt.w)); r[7] = v1[3] * sigmoidf_(bfhi(gt.w));
                    bf16_t* tp = T + row * DM + col0 + bj * HALF;
                    if (u.ga) { const u32x4 tv = *(const u32x4*)tp;
                        r[0] += bflo(tv.x); r[1] += bfhi(tv.x); r[2] += bflo(tv.y); r[3] += bfhi(tv.y); r[4] += bflo(tv.z); r[5] += bfhi(tv.z); r[6] += bflo(tv.w); r[7] += bfhi(tv.w); }
                    u32x4 w; w.x = cvt_pk_bf16(r[0], r[1]); w.y = cvt_pk_bf16(r[2], r[3]); w.z = cvt_pk_bf16(r[4], r[5]); w.w = cvt_pk_bf16(r[6], r[7]);
                    *(u32x4*)((u.ga ? mrg : T) + row * DM + col0 + bj * HALF) = w; } }
    }
};
struct EpiOut {
    static constexpr bool PERM = true;
    const float* x; const float* modf; float* out;
    __device__ __forceinline__ void operator()(const f32x4 (&acc)[2][2][4][2], const Unit& u, int wr, int wc, int fr, int fq) const {
        const int row0 = u.pm * BM + wr * 64 + fr, col0 = u.pn * BM + wc * 32 + 8 * fq;
        const int b = (u.pm * BM) >> 11;
        f32x4 gv[2][2];
#pragma unroll
        for (int bj = 0; bj < 2; ++bj)
#pragma unroll
            for (int n = 0; n < 2; ++n) gv[bj][n] = *(const f32x4*)(modf + b * 12288 + 4096 + col0 + bj * HALF + 4 * n);
#pragma unroll
        for (int ai = 0; ai < 2; ++ai)
#pragma unroll
            for (int m = 0; m < 4; ++m) { const size_t off = (size_t)(row0 + ai * HALF + m * 16) * DM + col0;
#pragma unroll
                for (int bj = 0; bj < 2; ++bj)
#pragma unroll
                    for (int n = 0; n < 2; ++n) { const f32x4 xv = *(const f32x4*)(x + off + bj * HALF + 4 * n);
                        *(f32x4*)(out + off + bj * HALF + 4 * n) = xv + gv[bj][n] * acc[ai][bj][m][n]; } }
    }
};
struct EpiMoeGU {
    static constexpr bool PERM = true;
    bf16_t* act; const float* roww; const LAS int* tb; const LAS int* cnt;
    __device__ __forceinline__ void operator()(const f32x4 (&acc)[2][2][4][2], const Unit& u, int wr, int wc, int fr, int fq) const {
        const int e = u.ga, lbase = (u.pm - tb[e]) * 256, n_e = cnt[e];
        const int r0 = wr * 64 + fr, col0 = u.pn * HALF + wc * 32 + 8 * fq;
#pragma unroll
        for (int ai = 0; ai < 2; ++ai)
#pragma unroll
            for (int m = 0; m < 4; ++m) { const int r = r0 + ai * HALF + m * 16; const int local = lbase + r;
                const float w = (local < n_e) ? roww[e * ECAP + local] : 0.f;
                float o[8];
#pragma unroll
                for (int n = 0; n < 2; ++n)
#pragma unroll
                    for (int j = 0; j < 4; ++j) { const float gte = acc[ai][0][m][n][j], up = acc[ai][1][m][n][j]; o[4 * n + j] = gte * sigmoidf_(gte) * up * w; }
                u32x4 wv; wv.x = cvt_pk_bf16(o[0], o[1]); wv.y = cvt_pk_bf16(o[2], o[3]); wv.z = cvt_pk_bf16(o[4], o[5]); wv.w = cvt_pk_bf16(o[6], o[7]);
                *(u32x4*)(act + (size_t)(u.pm * 256 + r) * DEXP + col0) = wv; }
    }
};
}

#define XB_TMO      128
#define XB_XCNT(j)  (256  + 64 * (j))
#define XB_XSUB(j)  (1280 + 64 * (j))
#define XB_XGEN(j)  (2304 + 64 * (j))
#define XB_TOP      3328
#define XB_TOPGEN   3392
#define XCD_BAR_WORDS 3456
#define XB_SPIN_CAP (1u << 18)
__device__ __forceinline__ unsigned xb_ld(unsigned* p)              { return __hip_atomic_load(p, __ATOMIC_RELAXED, __HIP_MEMORY_SCOPE_AGENT); }
__device__ __forceinline__ unsigned xb_add(unsigned* p, unsigned v) { return __hip_atomic_fetch_add(p, v, __ATOMIC_RELAXED, __HIP_MEMORY_SCOPE_AGENT); }
__device__ __forceinline__ unsigned xb_xcc_id() { return (unsigned)__builtin_amdgcn_s_getreg((3 << 11) | 20) & 0xFu; }
#define XB_SPIN(cond, bar) do { unsigned _sp = 0; while (cond) { __builtin_amdgcn_s_sleep(1); \
    if ((++_sp & 255u) == 0u) { if (xb_ld(&(bar)[XB_TMO])) break; if (_sp > XB_SPIN_CAP) { atomicAdd(&(bar)[XB_TMO], 1u); break; } } } } while (0)
struct XcdBarrier { unsigned* bar; unsigned x; volatile LAS unsigned* st; };
__device__ __forceinline__ XcdBarrier xcd_barrier_post(unsigned* bar, volatile LAS unsigned* st) {
    XcdBarrier b; b.bar = bar; b.x = xb_xcc_id(); b.st = st;
    if (threadIdx.x == 0) (void)xb_add(&bar[XB_XCNT(b.x)], 1u);
    return b;
}
__device__ __forceinline__ void xcd_barrier_complete(unsigned* bar, unsigned x, unsigned& nloc, unsigned& nx) {
    const unsigned G = gridDim.x * gridDim.y * gridDim.z;
    unsigned sum, cnt, mine, sp = 0u;
    for (;;) {
        sum = 0u; cnt = 0u; mine = 0u;
#pragma unroll
        for (unsigned j = 0; j < 16; ++j) { const unsigned c = xb_ld(&bar[XB_XCNT(j)]); sum += c; cnt += (c > 0u) ? 1u : 0u; mine = (j == x) ? c : mine; }
        if (sum == G) break;
        __builtin_amdgcn_s_sleep(1);
        if ((++sp & 255u) == 0u) { if (xb_ld(&bar[XB_TMO])) break; if (sp > XB_SPIN_CAP) { atomicAdd(&bar[XB_TMO], 1u); break; } }
    }
    nloc = mine > 0u ? mine : 1u; nx = cnt > 0u ? cnt : 1u;
}
__device__ __forceinline__ void xcd_barrier(const XcdBarrier& b) {
    asm volatile("s_waitcnt vmcnt(0)" ::: "memory");
    __syncthreads();
    if (threadIdx.x == 0) {
        unsigned* bar = b.bar;
        __builtin_amdgcn_s_waitcnt(0);
        unsigned nloc = b.st[0], nx = b.st[1];
        if (nloc == 0u) { xcd_barrier_complete(bar, b.x, nloc, nx); b.st[0] = nloc; b.st[1] = nx; }
        const unsigned old = xb_add(&bar[XB_XSUB(b.x)], 1u);
        const unsigned gen = old / nloc;
        if (old + 1u == (gen + 1u) * nloc) {
            __builtin_amdgcn_fence(__ATOMIC_RELEASE, "agent");
            asm volatile("s_waitcnt vmcnt(0)" ::: "memory");
            const unsigned og = xb_add(&bar[XB_TOP], 1u);
            const unsigned tg = og / nx;
            if (og + 1u == (tg + 1u) * nx) xb_add(&bar[XB_TOPGEN], 1u);
            else XB_SPIN(xb_ld(&bar[XB_TOPGEN]) == tg, bar);
            __builtin_amdgcn_fence(__ATOMIC_ACQUIRE, "agent");
            xb_add(&bar[XB_XGEN(b.x)], 1u);
            asm volatile("s_waitcnt vmcnt(0)" ::: "memory");
        } else {
            XB_SPIN(xb_ld(&bar[XB_XGEN(b.x)]) == gen, bar);
            __builtin_amdgcn_fence(__ATOMIC_ACQUIRE, "agent");
            asm volatile("s_waitcnt vmcnt(0)" ::: "memory");
        }
    }
    __syncthreads();
}

struct Args { const float* in[22]; float* out; unsigned char* ws; int ph_lo, ph_hi; };
typedef __attribute__((address_space(4))) const Args KArgs;
__device__ __forceinline__ KArgs* kargs() { KArgs* p = (KArgs*)__builtin_amdgcn_kernarg_segment_ptr(); asm volatile("" : "+s"(p)); return p; }
enum { I_X = 0, I_C, I_WADA, I_BADA, I_LN1G, I_WIN, I_SWAQN, I_SWAKN, I_SINKS, I_DSAQN, I_DSAKN, I_WBA, I_WBB, I_WOUT, I_LN2G, I_WGRP, I_BGRP, I_WEXP, I_BEXP, I_WGU, I_WUP, I_WDN };

__device__ __forceinline__ void p0_adaln_item(KArgs& a, LAS unsigned char* lds, int j, int tid) {
    LAS float* condl = (LAS float*)lds;
    LAS float* red = (LAS float*)(lds + 8192);
    const int cr = j & 63, kq = j >> 6;
    const float* cin = a.in[I_C];
    for (int i = tid; i < 2048; i += 512) { const int kk = i >> 2, b = i & 3; const float c = cin[b * 2048 + kq * 512 + kk]; condl[kk * 4 + b] = c * fast_rcp(1.f + __expf(-c)); }
    __syncthreads();
    if (tid < 480) {
        const int cg = tid % 48, ks = tid / 48;
        const float* wp = a.in[I_WADA] + (size_t)(kq * 512) * 12288 + cr * 192 + cg * 4;
        f32x4 acc[4];
#pragma unroll
        for (int b = 0; b < 4; ++b) acc[b] = (f32x4){0.f, 0.f, 0.f, 0.f};
#pragma unroll 13
        for (int kk = ks; kk < 512; kk += 10) {
            const f32x4 w = *(const f32x4*)(wp + (size_t)kk * 12288);
            const f32x4 c = *(const LAS f32x4*)(condl + kk * 4);
            acc[0] += c.x * w; acc[1] += c.y * w; acc[2] += c.z * w; acc[3] += c.w * w;
        }
#pragma unroll
        for (int b = 0; b < 4; ++b) *(LAS f32x4*)(red + (ks * 4 + b) * 192 + cg * 4) = acc[b];
    }
    __syncthreads();
    float* modp = (float*)(a.ws + WS_MODP);
    for (int o = tid; o < 768; o += 512) { const int b = o / 192, col = o % 192; float s = 0.f;
#pragma unroll
        for (int ks = 0; ks < 10; ++ks) s += red[(ks * 4 + b) * 192 + col];
        modp[(kq * 4 + b) * 12288 + cr * 192 + col] = s; }
    __syncthreads();
}
__device__ __forceinline__ void tr_item(const float* W, int N, int Nvalid, int K, bf16* WT, int drow0, int k0, int n0, LAS unsigned char* scr, int lane) {
    const int n4 = lane & 15, kr = lane >> 4;
    const bool ok = (n0 + 4 * n4) < Nvalid;
    f32x4 v[16];
#pragma unroll
    for (int i = 0; i < 16; ++i) v[i] = ok ? *(const f32x4*)(W + (size_t)(k0 + kr + 4 * i) * N + n0 + 4 * n4) : (f32x4){0.f, 0.f, 0.f, 0.f};
#pragma unroll
    for (int i = 0; i < 16; ++i) { const int k = kr + 4 * i, pos = (k & ~12) | ((k & 4) << 1) | ((k & 8) >> 1);
        v2u w; w.x = cvt_pk_bf16(v[i].x, v[i].y); w.y = cvt_pk_bf16(v[i].z, v[i].w); *(LAS v2u*)(scr + pos * 160 + n4 * 8) = w; }
    LDS_WAIT(); asm volatile("" ::: "memory");
    const int i16 = lane & 15, g = lane >> 4;
    LAS const unsigned char* rd = scr + (4 * (g & 1) + 16 * (g >> 1) + (i16 >> 2)) * 160 + 8 * (i16 & 3);
#pragma unroll
    for (int nt = 0; nt < 4; ++nt)
#pragma unroll
        for (int kh = 0; kh < 2; ++kh) {
            const s16x4 vl = tr_read(rd + (32 * kh) * 160 + 32 * nt), vh = tr_read(rd + (32 * kh + 8) * 160 + 32 * nt);
            v4u o = __builtin_bit_cast(v4u, (bf16x8){vl[0], vl[1], vl[2], vl[3], vh[0], vh[1], vh[2], vh[3]});
            *(v4u*)(WT + (size_t)(drow0 + 16 * nt + i16) * K + k0 + 32 * kh + 8 * g) = o; }
    LDS_WAIT(); asm volatile("" ::: "memory");
}
__device__ __forceinline__ void p0_prologue(KArgs& a, LAS unsigned char* lds, int vcu, int G, int tid, int lane, int wave) {
    for (int j = vcu; j < 256; j += G) p0_adaln_item(a, lds, j, tid);
    LAS unsigned char* scr = lds + wave * 10240;
    const int gw = vcu * NWAVES + wave, NGW = G * NWAVES;
    constexpr int I_IN = 32 * 124, I_BR = 16 * 32, I_OUT = 32 * 32;
    constexpr int NITEMS = I_IN + 2 * I_BR + I_OUT;
    unsigned char* ws = a.ws;
    for (int it = gw; it < NITEMS; it += NGW) {
        int r = it;
        if (r < I_IN) { const int kb = r / 124, nb = r % 124; tr_item(a.in[I_WIN], NPROJ, NPROJ, 2048, (bf16*)(ws + WS_WTIN), 64 * nb, 64 * kb, 64 * nb, scr, lane); continue; } r -= I_IN;
        if (r < I_BR) { const int kb = r / 32, nb = r % 32; tr_item(a.in[I_WBA], 2048, 2048, 1024, (bf16*)(ws + WS_WTA), 64 * nb, 64 * kb, 64 * nb, scr, lane); continue; } r -= I_BR;
        if (r < I_BR) { const int kb = r / 32, nb = r % 32; tr_item(a.in[I_WBB], 2048, 2048, 1024, (bf16*)(ws + WS_WTB), 64 * nb, 64 * kb, 64 * nb, scr, lane); continue; } r -= I_BR;
        { const int kb = r / 32, nb = r % 32; tr_item(a.in[I_WOUT], 2048, 2048, 2048, (bf16*)(ws + WS_WTO), 64 * nb, 64 * kb, 64 * nb, scr, lane); }
    }
    __syncthreads();
}

__device__ __forceinline__ float modval(const float* modp, const float* bada, int b, int n) {
    return ((modp[(0 * 4 + b) * 12288 + n] + modp[(1 * 4 + b) * 12288 + n]) + (modp[(2 * 4 + b) * 12288 + n] + modp[(3 * 4 + b) * 12288 + n])) + bada[n];
}
__device__ __forceinline__ void p1_norm1(KArgs& a, LAS unsigned char* lds, int vcu, int G, int tid, int lane, int wave) {
    const float* modp = (const float*)(a.ws + WS_MODP); const float* bada = a.in[I_BADA];
    float* modf = (float*)(a.ws + WS_MODF);
    LAS float* A4 = (LAS float*)lds; LAS float* B4 = A4 + 2048;
    const float* g1 = a.in[I_LN1G];
    for (int i = vcu * 512 + tid; i < 4 * 12288; i += G * 512) { const int b = i / 12288, n = i % 12288; modf[i] = modval(modp, bada, b, n); }
    { bf16* wrh = (bf16*)(a.ws + WS_WRH); bf16* wrl = (bf16*)(a.ws + WS_WRL);
      for (int i = vcu * 512 + tid; i < 64 * 2048; i += G * 512) { const int n = i >> 11, k = i & 2047;
          const float w = (n < 32) ? a.in[I_WEXP][k * 32 + n] : (n < 36) ? a.in[I_WGRP][k * 4 + (n - 32)] : 0.f;
          const unsigned hi = cvt_pk_bf16(w, 0.f) & 0xffffu; const float lo = w - bflo(hi);
          wrh[i] = (bf16)hi; wrl[i] = (bf16)(cvt_pk_bf16(lo, 0.f) & 0xffffu); } }
    const float* x = a.in[I_X]; bf16* H = (bf16*)(a.ws + WS_H);
    for (int blk = vcu; blk < 256; blk += G) {
        const int b = blk >> 6;
        __syncthreads();
        for (int k = tid; k < 2048; k += 512) { A4[k] = g1[k] * (1.f + modval(modp, bada, b, 2048 + k)); B4[k] = modval(modp, bada, b, k); }
        __syncthreads();
#pragma unroll 1
        for (int i = 0; i < 4; ++i) {
            const int m = blk * 32 + wave * 4 + i;
            const f32x4* xr = (const f32x4*)(x + (size_t)m * DM) + lane;
            f32x4 v[8]; float s = 0.f;
#pragma unroll
            for (int j = 0; j < 8; ++j) { v[j] = xr[64 * j]; s += (v[j].x * v[j].x + v[j].y * v[j].y) + (v[j].z * v[j].z + v[j].w * v[j].w); }
            const float rstd = 1.f / sqrtf(wave_sum(s) * (1.f / DM) + RMS_EPS);
            unsigned long long* o8 = (unsigned long long*)(H + (size_t)m * DM) + lane;
#pragma unroll
            for (int j = 0; j < 8; ++j) { const int k = 4 * lane + 256 * j; const f32x4 A = *(const LAS f32x4*)(A4 + k), Bv = *(const LAS f32x4*)(B4 + k);
                const f32x4 y = v[j] * rstd * A + Bv;
                o8[64 * j] = (unsigned long long)cvt_pk_bf16(y.x, y.y) | ((unsigned long long)cvt_pk_bf16(y.z, y.w) << 32); }
        }
    }
}

__device__ __forceinline__ void prep_norms(KArgs& a, int vcu, int G, int lane, int wave) {
    bf16* proj = (bf16*)(a.ws + WS_PROJ);
    const int gw = vcu * NWAVES + wave, NGW = G * NWAVES;
    const int sub = lane & 7, grp = lane >> 3;
    const float qs = 0.125f * LOG2E;
    for (int m = gw; m < MTOK; m += NGW) {
#pragma unroll
        for (int s = 0; s < 5; ++s) {
            const int hv = 8 * s + grp;
            if (hv < 37) {
                const int col = (hv < 20) ? 64 * hv : 256 + 64 * hv;
                const float* gain = (hv < 16) ? a.in[I_SWAQN] : (hv < 20) ? a.in[I_SWAKN] : (hv < 36) ? a.in[I_DSAQN] : a.in[I_DSAKN];
                const float sc = (hv < 16 || (hv >= 20 && hv < 36)) ? qs : 1.f;
                bf16* p = proj + (size_t)m * NPROJP + col + sub * 8;
                const v4u w = *(const v4u*)p;
                float f[8] = {bflo(w.x), bfhi(w.x), bflo(w.y), bfhi(w.y), bflo(w.z), bfhi(w.z), bflo(w.w), bfhi(w.w)};
                float ss = 0.f;
#pragma unroll
                for (int i = 0; i < 8; ++i) ss += f[i] * f[i];
                ss += __shfl_xor(ss, 1); ss += __shfl_xor(ss, 2); ss += __shfl_xor(ss, 4);
                const float r = sc / sqrtf(ss * (1.f / 64.f) + RMS_EPS);
                const f32x4 g0 = *(const f32x4*)(gain + sub * 8), g1 = *(const f32x4*)(gain + sub * 8 + 4);
                v4u o; o.x = cvt_pk_bf16(f[0] * r * g0.x, f[1] * r * g0.y); o.y = cvt_pk_bf16(f[2] * r * g0.z, f[3] * r * g0.w);
                o.z = cvt_pk_bf16(f[4] * r * g1.x, f[5] * r * g1.y); o.w = cvt_pk_bf16(f[6] * r * g1.z, f[7] * r * g1.w);
                *(v4u*)p = o;
            }
        }
    }
}
__device__ __forceinline__ unsigned f2key(float f) { const unsigned u = __float_as_uint(f); return (u & 0x80000000u) ? ~u : (u | 0x80000000u); }
__device__ __forceinline__ unsigned half_sum(unsigned v) {
    v += (unsigned)__builtin_amdgcn_update_dpp(0, (int)v, 0xB1, 0xF, 0xF, false);
    v += (unsigned)__builtin_amdgcn_update_dpp(0, (int)v, 0x4E, 0xF, 0xF, false);
    v += (unsigned)__builtin_amdgcn_update_dpp(0, (int)v, 0x141, 0xF, 0xF, false);
    v += (unsigned)__builtin_amdgcn_update_dpp(0, (int)v, 0x140, 0xF, 0xF, false);
    v += (unsigned)__builtin_amdgcn_ds_swizzle((int)v, 0x401F);
    return v;
}
constexpr int IX_KBUF = 36864;
constexpr int IX_LST = 2 * IX_KBUF;
__device__ __forceinline__ void indexer_unit(const bf16* proj, unsigned short* idxo, LAS unsigned char* lds, int u, int tid, int lane, int wave) {
    const int b = u >> 7, q0 = (u & 127) << 4;
    const int r32 = lane & 31, hi = lane >> 5;
    const int tq = q0 + 2 * wave + hi;
    const int NT = (q0 + 47) >> 5, NC = (NT + 7) >> 3;
    bf16x8 aq[4]; float wv[16];
    {
        const int sel = (r32 >> 2) & 1, head = (r32 & 3) + 4 * (r32 >> 3);
        const bf16* qrow = proj + (size_t)(b * SEQ + q0 + 2 * wave + sel) * NPROJP + C_QI + head * 64 + hi * 8;
#pragma unroll
        for (int ks = 0; ks < 4; ++ks) aq[ks] = *(const bf16x8*)(qrow + 16 * ks);
        const bf16* wrow = proj + (size_t)(b * SEQ + tq) * NPROJP + C_WI;
        const v4u w0 = *(const v4u*)wrow, w1 = *(const v4u*)(wrow + 8);
        const float c = 0.25f * 0.125f;
        wv[0] = bflo(w0.x) * c; wv[1] = bfhi(w0.x) * c; wv[2] = bflo(w0.y) * c; wv[3] = bfhi(w0.y) * c; wv[4] = bflo(w0.z) * c; wv[5] = bfhi(w0.z) * c; wv[6] = bflo(w0.w) * c; wv[7] = bfhi(w0.w) * c;
        wv[8] = bflo(w1.x) * c; wv[9] = bfhi(w1.x) * c; wv[10] = bflo(w1.y) * c; wv[11] = bfhi(w1.y) * c; wv[12] = bflo(w1.z) * c; wv[13] = bfhi(w1.z) * c; wv[14] = bflo(w1.w) * c; wv[15] = bfhi(w1.w) * c;
    }
    unsigned key[64];
    const bf16* kibase = proj + (size_t)(b * SEQ) * NPROJP + C_KI;
    v4u st[4];
#define IX_LOAD(c) do { _Pragma("unroll") for (int i = 0; i < 4; ++i) { const int p = tid + 512 * i; st[i] = *(const v4u*)(kibase + (size_t)(256 * (c) + (p >> 3)) * NPROJP + (p & 7) * 8); } } while (0)
#define IX_WRITE(buf) do { _Pragma("unroll") for (int i = 0; i < 4; ++i) { const int p = tid + 512 * i; *(LAS v4u*)(lds + (buf) * IX_KBUF + (p >> 3) * 144 + (p & 7) * 16) = st[i]; } } while (0)
    IX_LOAD(0); IX_WRITE(0);
    __syncthreads();
#pragma unroll
    for (int c = 0; c < 8; ++c) {
        if (c < NC) {
            if (c + 1 < NC) IX_LOAD(c + 1);
#pragma unroll
            for (int tt = 0; tt < 8; ++tt) {
                const int T = 8 * c + tt;
                if (T < NT) {
                    LAS const unsigned char* kb = lds + (c & 1) * IX_KBUF + (32 * tt + r32) * 144 + 16 * hi;
                    f32x16 C = {};
#pragma unroll
                    for (int ks = 0; ks < 4; ++ks) { const bf16x8 bk = *(const LAS bf16x8*)(kb + 32 * ks); C = __builtin_amdgcn_mfma_f32_32x32x16_bf16(aq[ks], bk, C, 0, 0, 0); }
                    float sc = 0.f;
#pragma unroll
                    for (int r = 0; r < 16; ++r) sc += fmaxf(C[r], 0.f) * wv[r];
                    unsigned kk = f2key(sc); kk = kk < 1u ? 1u : kk;
                    key[T] = ((32 * T + r32) <= tq) ? kk : 0u;
                } else key[T] = 0u;
            }
            if (c + 1 < NC) IX_WRITE((c + 1) & 1);
            __syncthreads();
        } else {
#pragma unroll
            for (int tt = 0; tt < 8; ++tt) key[8 * c + tt] = 0u;
        }
    }
#undef IX_LOAD
#undef IX_WRITE
    unsigned T = 0u, need = 0u, cgt = 0u;
    const bool small = (q0 + 2 * wave + 1) < 256;
    if (!small) {
        unsigned prefix = 0u; bool done = false;
        for (int bit = 31; bit >= 0; --bit) {
            const unsigned cand = prefix | (1u << bit);
            unsigned cnt = 0u;
#pragma unroll
            for (int c8 = 0; c8 < 8; ++c8) if (8 * c8 < NT) {
#pragma unroll
                for (int r = 8 * c8; r < 8 * c8 + 8; ++r) cnt += (key[r] >= cand) ? 1u : 0u; }
            cnt = half_sum(cnt);
            const bool take = !done && cnt >= 256u;
            prefix = take ? cand : prefix;
            done = done || (take && cnt == 256u);
            if (__all(done)) break;
        }
        if (done) { T = prefix - 1u; need = 0u; cgt = 256u; }
        else {
            T = prefix; unsigned cnt = 0u;
#pragma unroll
            for (int c8 = 0; c8 < 8; ++c8) if (8 * c8 < NT) {
#pragma unroll
                for (int r = 8 * c8; r < 8 * c8 + 8; ++r) cnt += (key[r] > T) ? 1u : 0u; }
            cgt = half_sum(cnt); need = 256u - cgt;
        }
    }
    LAS unsigned char* lst = lds + IX_LST + wave * 1024;
    *(LAS v4u*)(lst + lane * 16) = (v4u){0xFFFFFFFFu, 0xFFFFFFFFu, 0xFFFFFFFFu, 0xFFFFFFFFu};
    LDS_WAIT();
    LAS unsigned short* lq = (LAS unsigned short*)(lst + hi * 512);
    unsigned base_gt = 0u, base_eq = 0u;
#pragma unroll
    for (int r = 0; r < 64; ++r) if ((r & ~7) < NT) {
        const bool gt = key[r] > T, eq = key[r] == T;
        const unsigned long long mg = __ballot(gt), me = __ballot(eq);
        const unsigned mgh = hi ? (unsigned)(mg >> 32) : (unsigned)mg, meh = hi ? (unsigned)(me >> 32) : (unsigned)me;
        const unsigned below = (1u << r32) - 1u;
        const unsigned rg = __popc(mgh & below), re = __popc(meh & below);
        if (gt) lq[base_gt + rg] = (unsigned short)(32 * r + r32);
        if (eq && (base_eq + re) < need) lq[cgt + base_eq + re] = (unsigned short)(32 * r + r32);
        base_gt += __popc(mgh); base_eq += __popc(meh);
    }
    LDS_WAIT();
    const v4u lo = *(const LAS v4u*)(lst + lane * 16);
    *(v4u*)(idxo + ((size_t)(b * SEQ + q0 + 2 * wave + hi)) * 256 + r32 * 8) = lo;
    __syncthreads();
}

constexpr int SW_V = 36864, SW_WS = SW_V + 32768;
__device__ __forceinline__ void swa_unit(const bf16* proj, bf16* oa, const float* sinks, LAS unsigned char* lds, int u, int tid, int lane, int wave) {
    const int b = u >> 6, nblk = (u >> 2) & 15, kvh = u & 3;
    const int r32 = lane & 31, hi = lane >> 5;
#pragma unroll
    for (int i = 0; i < 4; ++i) {
        const int p = tid + 512 * i, kw = p >> 3, part = p & 7; const int spos = 128 * (nblk - 1) + kw;
        if (spos >= 0) {
            const bf16* src = proj + (size_t)(b * SEQ + spos) * NPROJP;
            const v4u kv = *(const v4u*)(src + C_KA + kvh * 64 + part * 8), vv = *(const v4u*)(src + C_VA + kvh * 64 + part * 8);
            *(LAS v4u*)(lds + kw * 144 + part * 16) = kv;
            *(LAS v4u*)(lds + SW_V + (part >> 2) * 16384 + kw * 64 + (part & 3) * 16) = vv;
        }
    }
    __syncthreads();
    const int hq = kvh * 4 + (wave >> 1);
    const float sink2 = sinks[hq] * LOG2E, slope2 = exp2f(-(float)(hq + 1) * 0.25f) * LOG2E;
    LAS float* wsf = (LAS float*)(lds + SW_WS) + wave * 32;
#pragma unroll 1
    for (int qq = 0; qq < 2; ++qq) {
        const int qt = 2 * (wave & 1) + qq, t0 = 128 * nblk + 32 * qt;
        const bf16* qrow = proj + (size_t)(b * SEQ + t0 + r32) * NPROJP + C_QA + hq * 64 + hi * 8;
        bf16x8 qr[4];
#pragma unroll
        for (int d0 = 0; d0 < 4; ++d0) qr[d0] = *(const bf16x8*)(qrow + 16 * d0);
        float mx = sink2;
        const int jlo = (nblk == 0) ? ((4 - qt) > 0 ? (4 - qt) : 0) : 0;
#pragma unroll 1
        for (int j = jlo; j < 5; ++j) {
            const int kt = qt + j;
            LAS const unsigned char* kb = lds + (32 * kt + r32) * 144 + 16 * hi;
            f32x16 C = {};
#pragma unroll
            for (int d0 = 0; d0 < 4; ++d0) { const bf16x8 kf = *(const LAS bf16x8*)(kb + 32 * d0); C = __builtin_amdgcn_mfma_f32_32x32x16_bf16(kf, qr[d0], C, 0, 0, 0); }
#pragma unroll
            for (int r = 0; r < 16; ++r) { const int rel = (128 + 32 * qt + r32) - (32 * kt + crow(r, hi));
                const float v = (rel >= 0 && rel < 128) ? C[r] - slope2 * (float)rel : NEGBIG; mx = fmaxf(mx, v); }
        }
        mx = fmaxf(mx, __shfl_xor(mx, 32));
        float lsum = 0.f;
        f32x16 o[2]; o[0] = (f32x16){}; o[1] = (f32x16){};
#pragma unroll 1
        for (int j = jlo; j < 5; ++j) {
            const int kt = qt + j;
            LAS const unsigned char* kb = lds + (32 * kt + r32) * 144 + 16 * hi;
            f32x16 C = {};
#pragma unroll
            for (int d0 = 0; d0 < 4; ++d0) { const bf16x8 kf = *(const LAS bf16x8*)(kb + 32 * d0); C = __builtin_amdgcn_mfma_f32_32x32x16_bf16(kf, qr[d0], C, 0, 0, 0); }
#pragma unroll
            for (int r = 0; r < 16; ++r) { const int rel = (128 + 32 * qt + r32) - (32 * kt + crow(r, hi));
                const float v = (rel >= 0 && rel < 128) ? C[r] - slope2 * (float)rel : NEGBIG; const float p = fast_exp2(v - mx); C[r] = p; lsum += p; }
#pragma unroll
            for (int ks = 0; ks < 2; ++ks) {
                v4u pw; pw.x = cvt_pk_bf16(C[8 * ks + 0], C[8 * ks + 1]); pw.y = cvt_pk_bf16(C[8 * ks + 2], C[8 * ks + 3]);
                pw.z = cvt_pk_bf16(C[8 * ks + 4], C[8 * ks + 5]); pw.w = cvt_pk_bf16(C[8 * ks + 6], C[8 * ks + 7]);
                const bf16x8 pa = __builtin_bit_cast(bf16x8, pw);
#pragma unroll
                for (int d0 = 0; d0 < 2; ++d0) {
                    LAS const unsigned char* vp = lds + SW_V + d0 * 16384 + (32 * kt + 16 * ks + 4 * hi + ((lane & 15) >> 2)) * 64 + ((lane >> 4) & 1) * 32 + (lane & 3) * 8;
                    const s16x4 vl = tr_read(vp), vh = tr_read(vp + 512);
                    const bf16x8 vf = (bf16x8){vl[0], vl[1], vl[2], vl[3], vh[0], vh[1], vh[2], vh[3]};
                    o[d0] = __builtin_amdgcn_mfma_f32_32x32x16_bf16(pa, vf, o[d0], 0, 0, 0);
                }
            }
        }
        lsum += __shfl_xor(lsum, 32); lsum += fast_exp2(sink2 - mx);
        if (hi == 0) wsf[r32] = fast_rcp(lsum);
        LDS_WAIT();
        bf16* orow = oa + (size_t)(b * SEQ + t0) * 1024 + hq * 64 + r32;
#pragma unroll
        for (int r = 0; r < 16; ++r) { const int q = crow(r, hi); const float rl = wsf[q];
            const unsigned w0 = cvt_pk_bf16(o[0][r] * rl, 0.f), w1 = cvt_pk_bf16(o[1][r] * rl, 0.f);
            orow[(size_t)q * 1024] = (bf16)(w0 & 0xffffu); orow[(size_t)q * 1024 + 32] = (bf16)(w1 & 0xffffu); }
        LDS_WAIT();
    }
    __syncthreads();
}

constexpr int DS_VBUF = 5120, DS_WAVE = 3 * DS_VBUF + 512;
struct DsaPre { v2u li; bf16x8 qf0, qf1; };
__device__ __forceinline__ DsaPre dsa_prefetch(const bf16* proj, const unsigned short* idx, int b, int t, int lane) {
    DsaPre p; const int i16 = lane & 15, g = lane >> 4;
    p.li = *(const v2u*)(idx + ((size_t)(b * SEQ + t)) * 256 + lane * 4);
    const bf16* qrow = proj + (size_t)(b * SEQ + t) * NPROJP + C_QB + i16 * 64 + 8 * g;
    p.qf0 = *(const bf16x8*)qrow; p.qf1 = *(const bf16x8*)(qrow + 32); return p;
}
__device__ __forceinline__ void dsa_query(const bf16* proj, const DsaPre& pre, bf16* ob, LAS unsigned char* wl, int b, int t, int lane) {
    int i16 = lane & 15, g = lane >> 4, l3 = lane >> 3;
    asm volatile("" : "+v"(i16), "+v"(g), "+v"(l3));
    const int nsel = (t + 1) < 256 ? (t + 1) : 256;
    LAS unsigned char* lst = wl + 3 * DS_VBUF;
    *(LAS v2u*)(lst + lane * 8) = pre.li;
    const bf16x8 qf0 = pre.qf0, qf1 = pre.qf1;
    const float slope2 = exp2f(-(float)(17 + i16) * 0.25f) * LOG2E;
    const bf16* pb = proj + (size_t)(b * SEQ) * NPROJP;
    LAS const unsigned short* lq = (LAS const unsigned short*)lst + i16;
    LAS const unsigned char* lg4 = lst + 8 * g;
    LAS const unsigned short* lv = (LAS const unsigned short*)lst + l3;
    LAS unsigned char* vwr = wl + l3 * 160 + (lane & 7) * 16;
    LAS const unsigned char* vrd = wl + (4 * g + (i16 >> 2)) * 160 + 8 * (i16 & 3);
    asm volatile("" : "+v"(lq), "+v"(lg4), "+v"(lv), "+v"(vwr), "+v"(vrd));
    LDS_WAIT();
    bf16x8 kA[4], kB[4], kC[4]; v4u vA[4], vB[4], vC[4];
#define DSA_ISSUE(c, KF, VV) do { \
        _Pragma("unroll") for (int tt = 0; tt < 2; ++tt) { const int pos = 32 * (c) + 16 * tt + i16; int kidx = lq[32 * (c) + 16 * tt]; kidx = (pos < nsel) ? kidx : 0; \
            const bf16* krow = pb + (size_t)kidx * NPROJP + C_KB + 8 * g; KF[2 * tt] = *(const bf16x8*)krow; KF[2 * tt + 1] = *(const bf16x8*)(krow + 32); } \
        _Pragma("unroll") for (int i = 0; i < 4; ++i) { const int pos = 32 * (c) + 8 * i + l3; int vidx = lv[32 * (c) + 8 * i]; vidx = (pos < nsel) ? vidx : 0; \
            VV[i] = *(const v4u*)(pb + (size_t)vidx * NPROJP + C_VB + (lane & 7) * 8); } } while (0)
    float m = NEGBIG, lsum = 0.f;
    f32x4 o[4];
#pragma unroll
    for (int dt = 0; dt < 4; ++dt) o[dt] = (f32x4){0.f, 0.f, 0.f, 0.f};
#define DSA_CHUNK(c, KF, VV, buf) do { \
        _Pragma("unroll") for (int i = 0; i < 4; ++i) *(LAS v4u*)(vwr + (buf) * DS_VBUF + 8 * i * 160) = VV[i]; \
        f32x4 s0 = {0.f, 0.f, 0.f, 0.f}, s1 = {0.f, 0.f, 0.f, 0.f}; \
        s0 = __builtin_amdgcn_mfma_f32_16x16x32_bf16(KF[0], qf0, s0, 0, 0, 0); s0 = __builtin_amdgcn_mfma_f32_16x16x32_bf16(KF[1], qf1, s0, 0, 0, 0); \
        s1 = __builtin_amdgcn_mfma_f32_16x16x32_bf16(KF[2], qf0, s1, 0, 0, 0); s1 = __builtin_amdgcn_mfma_f32_16x16x32_bf16(KF[3], qf1, s1, 0, 0, 0); \
        { const v2u i4 = *(const LAS v2u*)(lg4 + 64 * (c)), j4 = *(const LAS v2u*)(lg4 + 64 * (c) + 32); const int p0 = 32 * (c) + 4 * g; \
          s0[0] = (p0 + 0 < nsel) ? s0[0] - slope2 * (float)(t - (int)(i4.x & 0xffff)) : NEGBIG; s0[1] = (p0 + 1 < nsel) ? s0[1] - slope2 * (float)(t - (int)(i4.x >> 16)) : NEGBIG; \
          s0[2] = (p0 + 2 < nsel) ? s0[2] - slope2 * (float)(t - (int)(i4.y & 0xffff)) : NEGBIG; s0[3] = (p0 + 3 < nsel) ? s0[3] - slope2 * (float)(t - (int)(i4.y >> 16)) : NEGBIG; \
          s1[0] = (p0 + 16 < nsel) ? s1[0] - slope2 * (float)(t - (int)(j4.x & 0xffff)) : NEGBIG; s1[1] = (p0 + 17 < nsel) ? s1[1] - slope2 * (float)(t - (int)(j4.x >> 16)) : NEGBIG; \
          s1[2] = (p0 + 18 < nsel) ? s1[2] - slope2 * (float)(t - (int)(j4.y & 0xffff)) : NEGBIG; s1[3] = (p0 + 19 < nsel) ? s1[3] - slope2 * (float)(t - (int)(j4.y >> 16)) : NEGBIG; } \
        float cm = fmaxf(fmaxf(fmaxf(s0[0], s0[1]), fmaxf(s0[2], s0[3])), fmaxf(fmaxf(s1[0], s1[1]), fmaxf(s1[2], s1[3]))); \
        cm = fmaxf(cm, __shfl_xor(cm, 16)); cm = fmaxf(cm, __shfl_xor(cm, 32)); \
        const float mn = fmaxf(m, cm), al = fast_exp2(m - mn); m = mn; \
        _Pragma("unroll") for (int r = 0; r < 4; ++r) { s0[r] = fast_exp2(s0[r] - mn); s1[r] = fast_exp2(s1[r] - mn); } \
        lsum = lsum * al + ((s0[0] + s0[1]) + (s0[2] + s0[3])) + ((s1[0] + s1[1]) + (s1[2] + s1[3])); \
        _Pragma("unroll") for (int dt = 0; dt < 4; ++dt) o[dt] = o[dt] * al; \
        v4u pw; pw.x = cvt_pk_bf16(s0[0], s0[1]); pw.y = cvt_pk_bf16(s0[2], s0[3]); pw.z = cvt_pk_bf16(s1[0], s1[1]); pw.w = cvt_pk_bf16(s1[2], s1[3]); \
        const bf16x8 pbv = __builtin_bit_cast(bf16x8, pw); \
        LDS_WAIT(); \
        _Pragma("unroll") for (int dt = 0; dt < 4; ++dt) { \
            const s16x4 vl = tr_read(vrd + (buf) * DS_VBUF + 32 * dt), vh = tr_read(vrd + (buf) * DS_VBUF + 16 * 160 + 32 * dt); \
            const bf16x8 vf = (bf16x8){vl[0], vl[1], vl[2], vl[3], vh[0], vh[1], vh[2], vh[3]}; \
            o[dt] = __builtin_amdgcn_mfma_f32_16x16x32_bf16(vf, pbv, o[dt], 0, 0, 0); } \
        __builtin_amdgcn_sched_barrier(0); } while (0)
    DSA_ISSUE(0, kA, vA); DSA_ISSUE(1, kB, vB);
    DSA_ISSUE(2, kC, vC); DSA_CHUNK(0, kA, vA, 0);
    DSA_ISSUE(3, kA, vA); DSA_CHUNK(1, kB, vB, 1);
    DSA_ISSUE(4, kB, vB); DSA_CHUNK(2, kC, vC, 2);
    DSA_ISSUE(5, kC, vC); DSA_CHUNK(3, kA, vA, 0);
    DSA_ISSUE(6, kA, vA); DSA_CHUNK(4, kB, vB, 1);
    DSA_ISSUE(7, kB, vB); DSA_CHUNK(5, kC, vC, 2);
    DSA_CHUNK(6, kA, vA, 0);
    DSA_CHUNK(7, kB, vB, 1);
#undef DSA_ISSUE
#undef DSA_CHUNK
    lsum += __shfl_xor(lsum, 16); lsum += __shfl_xor(lsum, 32);
    const float rl = fast_rcp(lsum);
    bf16* orow = ob + (size_t)(b * SEQ + t) * 1024 + i16 * 64 + 4 * g;
#pragma unroll
    for (int dt = 0; dt < 4; ++dt) { v2u w; w.x = cvt_pk_bf16(o[dt][0] * rl, o[dt][1] * rl); w.y = cvt_pk_bf16(o[dt][2] * rl, o[dt][3] * rl); *(v2u*)(orow + 16 * dt) = w; }
}

constexpr int RT_PART = 0, RT_RS = 65536, RT_LG = RT_RS + 128;
__device__ __forceinline__ void router_unit(KArgs& a, LAS unsigned char* lds, int u, int tid, int lane, int wave) {
    const float* x2 = a.out; const float* modf = (const float*)(a.ws + WS_MODF); const float* g2 = a.in[I_LN2G];
    bf16* H2 = (bf16*)(a.ws + WS_H);
    const bf16* wrh = (const bf16*)(a.ws + WS_WRH); const bf16* wrl = (const bf16*)(a.ws + WS_WRL);
    const int row0 = u * 32, b = row0 >> 11;
    LAS float* rs = (LAS float*)(lds + RT_RS);
#pragma unroll 1
    for (int i = 0; i < 4; i += 2) {
        const int m = row0 + 4 * wave + i;
        const f32x4* xr0 = (const f32x4*)(x2 + (size_t)m * DM) + lane; const f32x4* xr1 = xr0 + DM / 4;
        f32x4 v0[8], v1[8]; float s0 = 0.f, s1 = 0.f;
#pragma unroll
        for (int j = 0; j < 8; ++j) { v0[j] = xr0[64 * j]; v1[j] = xr1[64 * j]; }
#pragma unroll
        for (int j = 0; j < 8; ++j) { s0 += (v0[j].x * v0[j].x + v0[j].y * v0[j].y) + (v0[j].z * v0[j].z + v0[j].w * v0[j].w); s1 += (v1[j].x * v1[j].x + v1[j].y * v1[j].y) + (v1[j].z * v1[j].z + v1[j].w * v1[j].w); }
        const float r0 = 1.f / sqrtf(wave_sum(s0) * (1.f / DM) + RMS_EPS), r1 = 1.f / sqrtf(wave_sum(s1) * (1.f / DM) + RMS_EPS);
        if (lane == 0) { rs[4 * wave + i] = r0; rs[4 * wave + i + 1] = r1; }
        unsigned long long* o0 = (unsigned long long*)(H2 + (size_t)m * DM) + lane; unsigned long long* o1 = o0 + DM / 4;
#pragma unroll
        for (int j = 0; j < 8; ++j) { const int k = 4 * lane + 256 * j;
            const f32x4 gk = *(const f32x4*)(g2 + k), sc = *(const f32x4*)(modf + b * 12288 + 8192 + k), sh = *(const f32x4*)(modf + b * 12288 + 6144 + k);
            const f32x4 fk = gk * (sc + 1.f);
            const f32x4 y0 = v0[j] * r0 * fk + sh, y1 = v1[j] * r1 * fk + sh;
            o0[64 * j] = (unsigned long long)cvt_pk_bf16(y0.x, y0.y) | ((unsigned long long)cvt_pk_bf16(y0.z, y0.w) << 32);
            o1[64 * j] = (unsigned long long)cvt_pk_bf16(y1.x, y1.y) | ((unsigned long long)cvt_pk_bf16(y1.z, y1.w) << 32); }
    }
    __syncthreads();
    {
        const int r32 = lane & 31, hh = lane >> 5;
        const float rst = rs[r32];
        const size_t rowoff = (size_t)(row0 + r32) * DM;
        f32x16 acc0 = {}, acc1 = {};
#pragma unroll 4
        for (int ks = 0; ks < 16; ++ks) {
            const int k = wave * 256 + 16 * ks + 8 * hh;
            const f32x4 xa = *(const f32x4*)(x2 + rowoff + k), xb = *(const f32x4*)(x2 + rowoff + k + 4);
            const f32x4 ga = *(const f32x4*)(g2 + k), gb = *(const f32x4*)(g2 + k + 4);
            const f32x4 sca = *(const f32x4*)(modf + b * 12288 + 8192 + k), scb = *(const f32x4*)(modf + b * 12288 + 8192 + k + 4);
            const f32x4 sha = *(const f32x4*)(modf + b * 12288 + 6144 + k), shb = *(const f32x4*)(modf + b * 12288 + 6144 + k + 4);
            const f32x4 ha = xa * rst * ga * (sca + 1.f) + sha, hb = xb * rst * gb * (scb + 1.f) + shb;
            v4u hi; hi.x = cvt_pk_bf16(ha.x, ha.y); hi.y = cvt_pk_bf16(ha.z, ha.w); hi.z = cvt_pk_bf16(hb.x, hb.y); hi.w = cvt_pk_bf16(hb.z, hb.w);
            v4u lo; lo.x = cvt_pk_bf16(ha.x - bflo(hi.x), ha.y - bfhi(hi.x)); lo.y = cvt_pk_bf16(ha.z - bflo(hi.y), ha.w - bfhi(hi.y));
            lo.z = cvt_pk_bf16(hb.x - bflo(hi.z), hb.y - bfhi(hi.z)); lo.w = cvt_pk_bf16(hb.z - bflo(hi.w), hb.w - bfhi(hi.w));
            const bf16x8 ah = __builtin_bit_cast(bf16x8, hi), al = __builtin_bit_cast(bf16x8, lo);
            const bf16x8 bh0 = *(const bf16x8*)(wrh + (size_t)r32 * DM + k), bl0 = *(const bf16x8*)(wrl + (size_t)r32 * DM + k);
            const bf16x8 bh1 = *(const bf16x8*)(wrh + (size_t)(32 + r32) * DM + k), bl1 = *(const bf16x8*)(wrl + (size_t)(32 + r32) * DM + k);
            acc0 = __builtin_amdgcn_mfma_f32_32x32x16_bf16(al, bh0, acc0, 0, 0, 0); acc0 = __builtin_amdgcn_mfma_f32_32x32x16_bf16(ah, bl0, acc0, 0, 0, 0); acc0 = __builtin_amdgcn_mfma_f32_32x32x16_bf16(ah, bh0, acc0, 0, 0, 0);
            acc1 = __builtin_amdgcn_mfma_f32_32x32x16_bf16(al, bh1, acc1, 0, 0, 0); acc1 = __builtin_amdgcn_mfma_f32_32x32x16_bf16(ah, bl1, acc1, 0, 0, 0); acc1 = __builtin_amdgcn_mfma_f32_32x32x16_bf16(ah, bh1, acc1, 0, 0, 0);
        }
        LAS float* part = (LAS float*)(lds + RT_PART) + wave * 2048;
#pragma unroll
        for (int r = 0; r < 16; ++r) { const int tkn = crow(r, hh); part[tkn * 64 + r32] = acc0[r]; part[tkn * 64 + 32 + r32] = acc1[r]; }
    }
    __syncthreads();
    LAS float* lg = (LAS float*)(lds + RT_LG);
    for (int o = tid; o < 32 * 36; o += 512) { const int t2 = o / 36, j = o % 36; float s = 0.f;
#pragma unroll
        for (int q = 0; q < 8; ++q) s += ((LAS float*)(lds + RT_PART))[q * 2048 + t2 * 64 + j];
        lg[t2 * 36 + j] = s + ((j < 32) ? a.in[I_BEXP][j] : a.in[I_BGRP][j - 32]); }
    __syncthreads();
    if (tid < 32) {
        const LAS float* l = lg + tid * 36;
        int gi = 0; float gm = l[32];
#pragma unroll
        for (int j = 1; j < 4; ++j) if (l[32 + j] > gm) { gm = l[32 + j]; gi = j; }
        float gs = 0.f;
#pragma unroll
        for (int j = 0; j < 4; ++j) gs += __expf(l[32 + j] - gm);
        const float pg = 1.f / gs;
        float e[8];
#pragma unroll
        for (int j = 0; j < 8; ++j) e[j] = (gi == 0) ? l[j] : (gi == 1) ? l[8 + j] : (gi == 2) ? l[16 + j] : l[24 + j];
        int i1 = 0; float m1 = e[0];
#pragma unroll
        for (int j = 1; j < 8; ++j) if (e[j] > m1) { m1 = e[j]; i1 = j; }
        int i2 = -1; float m2 = -3.0e38f;
#pragma unroll
        for (int j = 0; j < 8; ++j) if (j != i1 && e[j] > m2) { m2 = e[j]; i2 = j; }
        const float p2 = __expf(m2 - m1), inv = 1.f / (1.f + p2);
        const float c1 = pg * inv, c2 = pg * p2 * inv;
        const int e1 = gi * 8 + i1, e2 = gi * 8 + i2, m = row0 + tid;
        LAS unsigned* lcnt = (LAS unsigned*)(lds + RT_LG + 32 * 36 * 4);
        lcnt[tid] = 0u;
        LDS_WAIT(); __builtin_amdgcn_wave_barrier();
        const unsigned lr1 = __hip_atomic_fetch_add(lcnt + e1, 1u, __ATOMIC_RELAXED, __HIP_MEMORY_SCOPE_WORKGROUP);
        const unsigned lr2 = __hip_atomic_fetch_add(lcnt + e2, 1u, __ATOMIC_RELAXED, __HIP_MEMORY_SCOPE_WORKGROUP);
        LDS_WAIT(); __builtin_amdgcn_wave_barrier();
        unsigned* ecnt = (unsigned*)(a.ws + WS_CTL) + CW_ECNT;
        const unsigned mine = lcnt[tid];
        const unsigned gb = mine ? atomicAdd(ecnt + tid * 32, mine) : 0u;
        lcnt[32 + tid] = gb;
        LDS_WAIT(); __builtin_amdgcn_wave_barrier();
        const int pos1 = (int)(lcnt[32 + e1] + lr1), pos2 = (int)(lcnt[32 + e2] + lr2);
        int* rowtok = (int*)(a.ws + WS_ROWTOK); float* roww = (float*)(a.ws + WS_ROWW);
        rowtok[e1 * ECAP + pos1] = m; roww[e1 * ECAP + pos1] = c1;
        rowtok[e2 * ECAP + pos2] = m; roww[e2 * ECAP + pos2] = c2;
        int* tokinfo = (int*)(a.ws + WS_TOK) + m * 4;
        tokinfo[0] = e1; tokinfo[1] = pos1; tokinfo[2] = e2; tokinfo[3] = pos2;
    }
    __syncthreads();
}
__device__ __forceinline__ void moe_table(KArgs& a, LAS unsigned char* lds, int tid) {
    LAS int* tb = (LAS int*)(lds + MOE_TB_OFF); LAS int* cn = tb + 40;
    if (tid == 0) {
        const unsigned* ecnt = (const unsigned*)(a.ws + WS_CTL) + CW_ECNT; int acc = 0;
        for (int e = 0; e < NEXP; ++e) { const int c = (int)__hip_atomic_load(ecnt + e * 32, RLX_AGENT); tb[e] = acc; cn[e] = c; acc += (c + 255) >> 8; }
        tb[NEXP] = acc;
    }
    __syncthreads();
}


namespace wsg {
constexpr int BK = 64, A_STR = 144, B_STR = 288, A_BYTES = 256 * A_STR, B_BYTES = 64 * B_STR, BUF_BYTES = A_BYTES + B_BYTES;
struct Unit { int e, mt, pn, tile; };
struct Order {
    const LAS int* tb; int npn, G, c, total;
    __device__ __forceinline__ bool next(int i, Unit& u) const {
        const int L = i * G + c; if (L >= total) return false;
        int e = 0;
#pragma unroll
        for (int j = 1; j < NEXP; ++j) e += (L >= tb[j] * npn) ? 1 : 0;
        const int idx = L - tb[e] * npn, te = tb[e + 1] - tb[e];
        u.e = e; u.pn = idx / te; u.mt = idx - u.pn * te; u.tile = tb[e] + u.mt; return true;
    }
};
constexpr int A3_BYTES = 32768, A3_RING = 3 * A3_BYTES, B3_OFF = A3_RING;
__device__ __forceinline__ void glds16(const void* gsrc, unsigned lds_dst) { unsigned keep;
    asm volatile("s_mov_b32 %0, m0\n\ts_mov_b32 m0, %2\n\ts_nop 0\n\tglobal_load_lds_dwordx4 %1, off\n\ts_mov_b32 m0, %0" : "=&s"(keep) : "v"(gsrc), "s"(lds_dst) : "memory"); }
template <bool GU>
__device__ __forceinline__ void ws_gemm3(LAS unsigned char* lds, KArgs& a, const Order& S, const LAS int* cnt) {
    const int tid = threadIdx.x, wid = __builtin_amdgcn_readfirstlane(tid >> 6), lane = tid & 63;
    constexpr int K = GU ? DM : DEXP, NK = K / BK, LDW = GU ? DEXP : DM;
    const int nun = (S.total > S.c) ? (S.total - S.c + S.G - 1) / S.G : 0;
    if (nun == 0) return;
    const int total = nun * NK;
    if (wid >= 4) {
        const int p = wid - 4;
        const bf16* Abase = (const bf16*)(a.ws + (GU ? WS_H : WS_ACT));
        const int* rowtok = (const int*)(a.ws + WS_ROWTOK);
        const int k0 = 4 * (2 * p + (lane >> 5)), c4 = 4 * (lane & 31);
        const int kp0 = (k0 & ~12) | ((k0 & 4) << 1) | ((k0 & 8) >> 1);
        Unit UA, UW; int luA = 0, ktA = 0, luW = 0, ktW = 0; (void)S.next(0, UA); UW = UA;
        unsigned aoff[8]; const float* wsrc; int nvalA = 256;
#define WS3_SETUP_A() do { nvalA = cnt[UA.e] - UA.mt * 256; \
            _Pragma("unroll") for (int i = 0; i < 8; ++i) { const int row = 8 * (4 * i + p) + (lane >> 3); const unsigned cc = (unsigned)((lane & 7) ^ ((row >> 1) & 7)); \
            if (GU) { const int local = UA.mt * 256 + row; const unsigned tok = (local < cnt[UA.e]) ? (unsigned)rowtok[UA.e * ECAP + local] : 0u; aoff[i] = tok * (unsigned)(K * 2) + cc * 16u; } \
            else aoff[i] = (unsigned)(UA.tile * 256 + row) * (unsigned)(K * 2) + cc * 16u; } } while (0)
#define WS3_SETUP_W() do { if (GU) wsrc = ((c4 < 64) ? a.in[I_WGU] : a.in[I_WUP]) + (size_t)UW.e * DM * DEXP + (64 * UW.pn + (c4 & 63)) + (size_t)k0 * LDW; \
            else wsrc = a.in[I_WDN] + (size_t)UW.e * DEXP * DM + (128 * UW.pn + c4) + (size_t)k0 * LDW; } while (0)
        WS3_SETUP_A(); WS3_SETUP_W();
        f32x4 wvA[8], wvB[8], wvC[8];
#define WS3_ISSUE_A(slot) do { _Pragma("unroll") for (int i = 0; i < 8; ++i) if (8 * (4 * i + p) < nvalA)   \
                glds16((const char*)Abase + aoff[i] + ktA * 128, (unsigned)__builtin_amdgcn_readfirstlane((slot) * A3_BYTES + (4 * i + p) * 1024)); \
            if (++ktA == NK) { if (luA + 1 < nun) { ktA = 0; ++luA; (void)S.next(luA, UA); WS3_SETUP_A(); } else ktA = NK - 1; } } while (0)
#define WS3_ISSUE_W(WV) do { _Pragma("unroll") for (int i = 0; i < 4; ++i) { \
                WV[i] = *(const f32x4*)(wsrc + (size_t)(ktW * 64 + i) * LDW); \
                WV[4 + i] = *(const f32x4*)(wsrc + (size_t)(ktW * 64 + 32 + i) * LDW); } \
            if (++ktW == NK) { if (luW + 1 < nun) { ktW = 0; ++luW; (void)S.next(luW, UW); WS3_SETUP_W(); } else ktW = NK - 1; } } while (0)
#define WS3_WRITE_W(buf, WV) do { \
            LAS unsigned char* bb_ = lds + B3_OFF + (buf) * B_BYTES; \
            _Pragma("unroll") for (int i = 0; i < 4; ++i) { v2u w_; w_.x = cvt_pk_bf16(WV[i].x, WV[i].y); w_.y = cvt_pk_bf16(WV[i].z, WV[i].w); *(LAS v2u*)(bb_ + (kp0 + i) * B_STR + (lane & 31) * 8) = w_; \
                v2u x_; x_.x = cvt_pk_bf16(WV[4 + i].x, WV[4 + i].y); x_.y = cvt_pk_bf16(WV[4 + i].z, WV[4 + i].w); *(LAS v2u*)(bb_ + (32 + kp0 + i) * B_STR + (lane & 31) * 8) = x_; } } while (0)
#define WS3_BAR() asm volatile("s_waitcnt vmcnt(16) lgkmcnt(0)\n\ts_barrier" ::: "memory")
        WS3_ISSUE_W(wvA); WS3_ISSUE_A(0); WS3_ISSUE_W(wvB); WS3_ISSUE_A(1); WS3_ISSUE_W(wvC);
        WS3_WRITE_W(0, wvA); WS3_BAR();
#define WS3_SUB(j, slotA, WVI, WVW) do { WS3_ISSUE_A(slotA); WS3_ISSUE_W(WVI); WS3_WRITE_W(((j) + 1) & 1, WVW); WS3_BAR(); } while (0)
        int j = 0;
#pragma unroll 1
        for (; j + 3 <= total; j += 3) {
            WS3_SUB(j, 2, wvA, wvB);
            WS3_SUB(j + 1, 0, wvB, wvC);
            WS3_SUB(j + 2, 1, wvC, wvA);
        }
        if (j < total) { WS3_SUB(j, 2, wvA, wvB); if (j + 1 < total) WS3_SUB(j + 1, 0, wvB, wvC); }
        asm volatile("s_waitcnt vmcnt(0)" ::: "memory");
#undef WS3_SETUP_A
#undef WS3_SETUP_W
#undef WS3_ISSUE_A
#undef WS3_ISSUE_W
#undef WS3_WRITE_W
#undef WS3_BAR
#undef WS3_SUB
    } else {
        const int fr = lane & 15, g = lane >> 4;
        f32x4 acc[4][8];
#pragma unroll
        for (int m = 0; m < 4; ++m)
#pragma unroll
            for (int n = 0; n < 8; ++n) acc[m][n] = (f32x4){0.f, 0.f, 0.f, 0.f};
        Unit U; int cu = 0, kt = 0; (void)S.next(0, U);
        __syncthreads();
        int slot = 0;
#pragma unroll 1
        for (int s = 0; s < total; ++s) {
            LAS const unsigned char* ba = lds + slot * A3_BYTES; LAS const unsigned char* bb = lds + B3_OFF + (s & 1) * B_BYTES;
            {
                bf16x8 af[4], bq[4], bn[4];
#define WS3_LDA(ks) do { _Pragma("unroll") for (int m = 0; m < 4; ++m) { const int row = 64 * wid + 16 * m + fr; af[m] = *(const LAS bf16x8*)(ba + row * 128 + (((4 * (ks) + g) ^ ((row >> 1) & 7)) << 4)); } } while (0)
#define WS3_LDB(dst, ks, h) do { _Pragma("unroll") for (int n = 0; n < 4; ++n) { LAS const unsigned char* pp = bb + (32 * (ks) + 4 * (g & 1) + 16 * (g >> 1) + (fr >> 2)) * B_STR + (16 * (4 * (h) + n) + 4 * (fr & 3)) * 2; \
                    const s16x4 vl = tr_read(pp), vh = tr_read(pp + 8 * B_STR); dst[n] = (bf16x8){vl[0], vl[1], vl[2], vl[3], vh[0], vh[1], vh[2], vh[3]}; } } while (0)
#define WS3_MMA(src, h) do { _Pragma("unroll") for (int m = 0; m < 4; ++m) _Pragma("unroll") for (int n = 0; n < 4; ++n) acc[m][4 * (h) + n] = __builtin_amdgcn_mfma_f32_16x16x32_bf16(src[n], af[m], acc[m][4 * (h) + n], 0, 0, 0); } while (0)
                WS3_LDA(0); WS3_LDB(bq, 0, 0);
                WS3_LDB(bn, 0, 1); WS3_MMA(bq, 0);
                WS3_LDB(bq, 1, 0); WS3_MMA(bn, 1);
                WS3_LDA(1);
                WS3_LDB(bn, 1, 1); WS3_MMA(bq, 0);
                WS3_MMA(bn, 1);
#undef WS3_LDA
#undef WS3_LDB
#undef WS3_MMA
            }
            slot = (slot == 2) ? 0 : slot + 1;
            if (++kt == NK) {
                const size_t prow0 = (size_t)U.tile * 256 + 64 * wid + fr;
                if (GU) {
                    bf16* act = (bf16*)(a.ws + WS_ACT); const float* roww = (const float*)(a.ws + WS_ROWW);
#pragma unroll
                    for (int m = 0; m < 4; ++m) { const int local = U.mt * 256 + 64 * wid + 16 * m + fr;
                        const float w = (local < cnt[U.e]) ? roww[U.e * ECAP + local] : 0.f;
#pragma unroll
                        for (int n = 0; n < 4; ++n) { float o[4];
#pragma unroll
                            for (int r = 0; r < 4; ++r) { const float gt = acc[m][n][r]; o[r] = gt * sigmoidf_(gt) * acc[m][n + 4][r] * w; }
                            v2u wv2; wv2.x = cvt_pk_bf16(o[0], o[1]); wv2.y = cvt_pk_bf16(o[2], o[3]);
                            *(v2u*)(act + (prow0 + 16 * m) * DEXP + 64 * U.pn + 16 * n + 4 * g) = wv2; } }
                } else {
                    bf16* Y = (bf16*)(a.ws + WS_Y);
#pragma unroll
                    for (int m = 0; m < 4; ++m)
#pragma unroll
                        for (int q = 0; q < 4; ++q) { v4u w4; w4.x = cvt_pk_bf16(acc[m][2 * q][0], acc[m][2 * q][1]); w4.y = cvt_pk_bf16(acc[m][2 * q][2], acc[m][2 * q][3]);
                            w4.z = cvt_pk_bf16(acc[m][2 * q + 1][0], acc[m][2 * q + 1][1]); w4.w = cvt_pk_bf16(acc[m][2 * q + 1][2], acc[m][2 * q + 1][3]);
                            *(v4u*)(Y + (prow0 + 16 * m) * DM + 128 * U.pn + 32 * g + 8 * q) = w4; }
                }
#pragma unroll
                for (int m = 0; m < 4; ++m)
#pragma unroll
                    for (int n = 0; n < 8; ++n) acc[m][n] = (f32x4){0.f, 0.f, 0.f, 0.f};
                kt = 0; ++cu; if (cu < nun) (void)S.next(cu, U);
            }
            __syncthreads();
        }
    }
    __syncthreads();
}
}

__device__ __forceinline__ int fresh_tid() { int t = threadIdx.x; asm volatile("" : "+v"(t)); return t; }
#define PH_IDS const int tid = fresh_tid(), lane = tid & 63, wave = __builtin_amdgcn_readfirstlane(tid >> 6); (void)lane; (void)wave; KArgs& args = *kargs(); unsigned char* ws = args.ws; (void)ws
constexpr int NPHASE = 11;
__global__ void __launch_bounds__(NWAVES * 64, 2) mk_fwd(Args args_) {
    extern __shared__ __attribute__((aligned(16))) unsigned char lds_raw[];
    LAS unsigned char* lds = (LAS unsigned char*)lds_raw;
    volatile LAS unsigned* MISC = (volatile LAS unsigned*)(lds + MISC_OFF);
    const int tid0 = threadIdx.x;
    const int G = gridDim.x; const int bx = blockIdx.x; const int vcu = (G % 8 == 0) ? (bx % 8) * (G / 8) + bx / 8 : bx;
    gu32* ctl = (gu32*)(args_.ws + WS_CTL);
    for (int u = tid0; u < (LDS_BYTES - LDSCTL_OFF) / 4; u += NWAVES * 64) ((LAS unsigned*)(lds + LDSCTL_OFF))[u] = 0u;
    __syncthreads();
    XcdBarrier bar; bar.bar = (unsigned*)ctl + CW_BAR; bar.x = 0; bar.st = nullptr;
    if (!MK_LAUNCH_PER_PHASE) bar = xcd_barrier_post((unsigned*)ctl + CW_BAR, MISC + 8);
    const int lo = args_.ph_lo, hi = args_.ph_hi;
#ifndef PH_MASK
#define PH_MASK 0x7ff
#endif
#ifndef PH_REP
#define PH_REP 0
#endif
#define NREP(k) (1 + ((PH_REP >> (k)) & 1))
#define IN(k) (((PH_MASK >> (k)) & 1) && lo <= (k) && (k) < hi)
#define SEAM(k) do { if (IN(k) && IN((k) + 1)) { if (!MK_LAUNCH_PER_PHASE) xcd_barrier(bar); } } while (0)
    if (IN(0)) { PH_IDS; for (int rep = 0; rep < NREP(0); ++rep) { p0_prologue(args, lds, vcu, G, tid, lane, wave); if (rep) xcd_barrier(bar); } }
    SEAM(0);
    if (IN(1)) { PH_IDS; for (int rep = 0; rep < NREP(1); ++rep) { p1_norm1(args, lds, vcu, G, tid, lane, wave); if (rep) xcd_barrier(bar); } }
    SEAM(1);
    if (IN(2)) { PH_IDS;
        pg8::Gemm g{(const bf16*)(ws + WS_H), nullptr, (const bf16*)(ws + WS_WTIN), nullptr, DM};
        pg8::StaticOrder S; S.init(MTOK, NPROJP, G, bx);
        pg8::EpiStore E{(bf16*)(ws + WS_PROJ), NPROJP};
        for (int rep = 0; rep < NREP(2); ++rep) { pg8::gemm_phase<pg8::EpiStore, pg8::StaticOrder, true, false>(lds, g, S, E); if (rep) xcd_barrier(bar); }
    }
    SEAM(2);
    if (IN(3)) { const int tid = threadIdx.x, lane = tid & 63, wave = __builtin_amdgcn_readfirstlane(tid >> 6); KArgs& args = *kargs(); unsigned char* ws = args.ws;
        bf16* PROJ = (bf16*)(ws + WS_PROJ);
        prep_norms(args, vcu, G, lane, wave);
        if (!(DBG_SKIP & 2)) {
            unsigned short* idxo = (unsigned short*)(ws + WS_IDX);
            for (int rep = 0; rep < NREP(3); ++rep) { for (int i = vcu; i < 512; i += G) { const int u = (i < 256) ? i : 767 - i;
                indexer_unit(PROJ, idxo, lds, (u & 3) * 128 + (u >> 2), tid, lane, wave); } if (rep) xcd_barrier(bar); }
        }
    }
    SEAM(3);
    if (IN(4)) { PH_IDS;
        bf16* PROJ = (bf16*)(ws + WS_PROJ); bf16* OA = (bf16*)(ws + WS_OA); bf16* OB = (bf16*)(ws + WS_OB);
        if (!(DBG_SKIP & 1)) { for (int rep = 0; rep < NREP(11); ++rep) { for (int u = vcu; u < 256; u += G) swa_unit(PROJ, OA, args.in[I_SINKS], lds, u, tid, lane, wave); if (rep) xcd_barrier(bar); } }
        else { for (size_t i = (size_t)bx * 512 + tid; i < (size_t)MTOK * 1024 / 8; i += (size_t)G * 512) ((v4u*)OA)[i] = (v4u){0u, 0u, 0u, 0u}; }
        if (!(DBG_SKIP & 2)) {
            const unsigned short* idx = (const unsigned short*)(ws + WS_IDX);
            LAS unsigned char* wl = lds + wave * DS_WAVE;
            const int gw = vcu * NWAVES + wave, NGW = G * NWAVES;
            for (int rep = 0; rep < NREP(4); ++rep) {
                int q = gw; int qq = (q & 1) ? (MTOK - 1 - (q >> 1)) : (q >> 1);
                DsaPre pre = dsa_prefetch(PROJ, idx, qq >> 11, qq & 2047, lane);
                for (; q < MTOK; q += NGW) {
                    const DsaPre cur = pre; const int cb = qq >> 11, ct = qq & 2047;
                    const int qn = q + NGW; if (qn < MTOK) { qq = (qn & 1) ? (MTOK - 1 - (qn >> 1)) : (qn >> 1); pre = dsa_prefetch(PROJ, idx, qq >> 11, qq & 2047, lane); }
                    dsa_query(PROJ, cur, OB, wl, cb, ct, lane);
                }
                if (rep) xcd_barrier(bar); }
        } else { for (size_t i = (size_t)bx * 512 + tid; i < (size_t)MTOK * 1024 / 8; i += (size_t)G * 512) ((v4u*)OB)[i] = (v4u){0u, 0u, 0u, 0u}; }
        __syncthreads();
    }
    SEAM(4);
    if (IN(5)) { PH_IDS;
        pg8::Gemm g{(const bf16*)(ws + WS_OA), (const bf16*)(ws + WS_OB), (const bf16*)(ws + WS_WTA), (const bf16*)(ws + WS_WTB), 1024};
        pg8::PairOrder S; S.init(MTOK, DM, G, bx);
        pg8::EpiGate E{(bf16*)(ws + WS_PROJ), (bf16*)(ws + WS_T), (bf16*)(ws + WS_MRG)};
        for (int rep = 0; rep < NREP(5); ++rep) { pg8::gemm_phase<pg8::EpiGate, pg8::PairOrder, true, false>(lds, g, S, E); if (rep) xcd_barrier(bar); }
    }
    SEAM(5);
    if (IN(6)) { PH_IDS;
        pg8::Gemm g{(const bf16*)(ws + WS_MRG), nullptr, (const bf16*)(ws + WS_WTO), nullptr, DM};
        pg8::StaticOrder S; S.init(MTOK, DM, G, bx);
        pg8::EpiOut E{args.in[I_X], (const float*)(ws + WS_MODF), args.out};
        for (int rep = 0; rep < NREP(6); ++rep) { pg8::gemm_phase<pg8::EpiOut, pg8::StaticOrder, true, false>(lds, g, S, E); if (rep) xcd_barrier(bar); }
    }
    SEAM(6);
    if (IN(7)) { PH_IDS; if (!(DBG_SKIP & 4)) for (int u = vcu; u < 256; u += G) router_unit(args, lds, u, tid, lane, wave); }
    SEAM(7);
    if (IN(8)) { PH_IDS; if (!(DBG_SKIP & 4)) {
        moe_table(args, lds, tid);
        const LAS int* tb = (const LAS int*)(lds + MOE_TB_OFF); const LAS int* cn = tb + 40;
        wsg::Order S{tb, 8, G, vcu, tb[NEXP] * 8};
        for (int rep = 0; rep < NREP(8); ++rep) { wsg::ws_gemm3<true>(lds, args, S, cn); if (rep) xcd_barrier(bar); }
    } }
    SEAM(8);
    if (IN(9)) { PH_IDS; if (!(DBG_SKIP & 4)) {
        moe_table(args, lds, tid);
        const LAS int* tb = (const LAS int*)(lds + MOE_TB_OFF); const LAS int* cn = tb + 40;
        wsg::Order S{tb, 16, G, vcu, tb[NEXP] * 16};
        for (int rep = 0; rep < NREP(9); ++rep) { wsg::ws_gemm3<false>(lds, args, S, cn); if (rep) xcd_barrier(bar); }
    } }
    SEAM(9);
    if (IN(10)) { PH_IDS; if (!(DBG_SKIP & 4)) {
        moe_table(args, lds, tid);
        const LAS int* tb = (const LAS int*)(lds + MOE_TB_OFF);
        const int gw = vcu * NWAVES + wave, NGW = G * NWAVES;
        const float* modf = (const float*)(ws + WS_MODF); const bf16* Y = (const bf16*)(ws + WS_Y);
        for (int m = gw; m < MTOK; m += NGW) {
            const int b = m >> 11; const int* ti = (const int*)(ws + WS_TOK) + m * 4;
            const size_t r1 = (size_t)tb[ti[0]] * 256 + ti[1], r2 = (size_t)tb[ti[2]] * 256 + ti[3];
            float* orow = args.out + (size_t)m * DM;
#pragma unroll
            for (int j = 0; j < 4; ++j) { const int kp = 8 * lane + 512 * j;
                const int k = (kp & ~127) + 32 * ((kp >> 3) & 3) + 4 * ((kp >> 5) & 3), k2 = k + 16;
                const v4u y1 = *(const v4u*)(Y + r1 * DM + kp), y2 = *(const v4u*)(Y + r2 * DM + kp);
                const f32x4 g0 = *(const f32x4*)(modf + b * 12288 + 10240 + k), g1 = *(const f32x4*)(modf + b * 12288 + 10240 + k2);
                f32x4 x0 = *(const f32x4*)(orow + k), x1 = *(const f32x4*)(orow + k2);
                x0.x += g0.x * (bflo(y1.x) + bflo(y2.x)); x0.y += g0.y * (bfhi(y1.x) + bfhi(y2.x)); x0.z += g0.z * (bflo(y1.y) + bflo(y2.y)); x0.w += g0.w * (bfhi(y1.y) + bfhi(y2.y));
                x1.x += g1.x * (bflo(y1.z) + bflo(y2.z)); x1.y += g1.y * (bfhi(y1.z) + bfhi(y2.z)); x1.z += g1.z * (bflo(y1.w) + bflo(y2.w)); x1.w += g1.w * (bfhi(y1.w) + bfhi(y2.w));
                *(f32x4*)(orow + k) = x0; *(f32x4*)(orow + k2) = x1; }
        }
    } }
#undef IN
#undef SEAM
}

extern "C" void kernel_launch(void* const* d_in, const int* in_sizes, int n_in, void* d_out, int out_size, void* d_ws, size_t ws_size, hipStream_t stream) {
    static int grid = 0;
    if (grid == 0) {
        if (n_in != 22 || out_size != MTOK * DM || ws_size < WS_END) { fprintf(stderr, "kernel_launch: unexpected shapes (n_in %d, out %d, ws %zu < %zu)\n", n_in, out_size, ws_size, (size_t)WS_END); grid = -1; return; }
        int dev = 0, cus = 0;
        if (hipGetDevice(&dev) != hipSuccess || hipDeviceGetAttribute(&cus, hipDeviceAttributeMultiprocessorCount, dev) != hipSuccess) { grid = -1; return; }
        if (hipFuncSetAttribute((const void*)mk_fwd, hipFuncAttributeMaxDynamicSharedMemorySize, LDS_BYTES) != hipSuccess) { fprintf(stderr, "kernel_launch: hipFuncSetAttribute failed\n"); grid = -1; return; }
        int per_cu = 0;
        if (hipOccupancyMaxActiveBlocksPerMultiprocessor(&per_cu, (const void*)mk_fwd, NWAVES * 64, LDS_BYTES) != hipSuccess || per_cu < 1) fprintf(stderr, "kernel_launch: occupancy query says %d\n", per_cu);
        (void)hipGetLastError();
        grid = cus;
    }
    if (grid < 0) return;
    if (hipMemsetAsync((char*)d_ws + WS_CTL, 0, CTL_ZERO_BYTES, stream) != hipSuccess) { fprintf(stderr, "kernel_launch: memset failed\n"); return; }
    Args a{};
    for (int i = 0; i < 22; ++i) a.in[i] = (const float*)d_in[i];
    a.out = (float*)d_out; a.ws = (unsigned char*)d_ws;
#if MK_LAUNCH_PER_PHASE
    for (int p = 0; p < NPHASE; ++p) { a.ph_lo = p; a.ph_hi = p + 1; hipLaunchKernelGGL(mk_fwd, dim3(grid), dim3(NWAVES * 64), LDS_BYTES, stream, a); }
#else
    a.ph_lo = 0; a.ph_hi = NPHASE;
    hipLaunchKernelGGL(mk_fwd, dim3(grid), dim3(NWAVES * 64), LDS_BYTES, stream, a);
#endif
    const hipError_t le = hipPeekAtLastError();
    if (le != hipSuccess) fprintf(stderr, "kernel_launch: launch failed: %s\n", hipGetErrorName(le));
}
```

```cpp
#include <hip/hip_runtime.h>
#include <cstdio>
#include <cstdint>

#ifndef MK_LAUNCH_PER_PHASE
#define MK_LAUNCH_PER_PHASE 0
#endif
#ifndef DBG_SKIP
#define DBG_SKIP 0
#endif

#define GAS __attribute__((address_space(1)))
#define LAS __attribute__((address_space(3)))
typedef unsigned short bf16;
typedef unsigned v4u __attribute__((ext_vector_type(4)));
typedef unsigned v2u __attribute__((ext_vector_type(2)));
typedef float f32x4 __attribute__((ext_vector_type(4)));
typedef float f32x16 __attribute__((ext_vector_type(16)));
typedef short bf16x8 __attribute__((ext_vector_type(8)));
typedef short s16x4 __attribute__((ext_vector_type(4)));
typedef GAS unsigned gu32;

constexpr int NB = 4, SEQ = 2048, DM = 2048, MTOK = NB * SEQ;
constexpr int NPROJ = 7888, NPROJP = 7936;
constexpr int C_QA = 0, C_KA = 1024, C_VA = 1280, C_QB = 1536, C_KB = 2560, C_VB = 2624, C_QI = 2688, C_KI = 3712, C_WI = 3776, C_GA = 3792, C_GB = 5840;
constexpr int NEXP = 32, DEXP = 512, ECAP = 8192, PADROWS = 24576;
constexpr float LOG2E = 1.4426950408889634f;
constexpr float RMS_EPS = 1e-6f;
constexpr float NEGBIG = -1e30f;

constexpr size_t MiB = 1u << 20;
constexpr size_t WS_CTL = 0, CTL_ZERO_BYTES = 128 * 1024;
constexpr size_t WS_MODP = 1 * MiB;
constexpr size_t WS_MODF = 2 * MiB;
constexpr size_t WS_CB   = 2 * MiB + 512 * 1024;
constexpr size_t WS_TOK  = 2 * MiB + 768 * 1024;
constexpr size_t WS_ROWTOK = 3 * MiB;
constexpr size_t WS_ROWW = 4 * MiB;
constexpr size_t WS_IDX  = 5 * MiB;
constexpr size_t WS_WTIN = 9 * MiB;
constexpr size_t WS_WTA  = 40 * MiB, WS_WTB = 44 * MiB, WS_WTO = 48 * MiB;
constexpr size_t WS_WRH = 56 * MiB, WS_WRL = 57 * MiB;
constexpr size_t WS_WTGU = 60 * MiB;
constexpr size_t WS_WTD  = 184 * MiB;
constexpr size_t WS_H    = 248 * MiB;
constexpr size_t WS_PROJ = 280 * MiB;
constexpr size_t WS_Y    = WS_PROJ;
constexpr size_t WS_OA   = 404 * MiB, WS_OB = 420 * MiB;
constexpr size_t WS_T    = 436 * MiB;
constexpr size_t WS_X2   = WS_T;
constexpr size_t WS_MRG  = 468 * MiB;
constexpr size_t WS_ACT  = 500 * MiB;
constexpr size_t WS_END  = 524 * MiB;
constexpr int CW_BAR = 4096;
constexpr int CW_ECNT = 16384;

constexpr int RING_BYTES = 135168;
constexpr int LDSCTL_OFF = RING_BYTES, MISC_OFF = LDSCTL_OFF + 320;
constexpr int MOE_TB_OFF = LDSCTL_OFF + 1024;
constexpr int MOE_NOFF = LDSCTL_OFF + 2048;
constexpr int LDS_BYTES = 147456;
constexpr int NWAVES = 8;

#define RLX_AGENT __ATOMIC_RELAXED, __HIP_MEMORY_SCOPE_AGENT
#define LDS_WAIT() asm volatile("s_waitcnt lgkmcnt(0)" ::: "memory")
#define VM_WAIT() asm volatile("s_waitcnt vmcnt(0)" ::: "memory")

__device__ __forceinline__ unsigned cvt_pk_bf16(float lo, float hi) { unsigned r; asm volatile("v_cvt_pk_bf16_f32 %0, %1, %2" : "=v"(r) : "v"(lo), "v"(hi)); return r; }
__device__ __forceinline__ float bflo(unsigned w) { return __uint_as_float(w << 16); }
__device__ __forceinline__ float bfhi(unsigned w) { return __uint_as_float(w & 0xffff0000u); }
__device__ __forceinline__ float fast_exp2(float x) { return __builtin_amdgcn_exp2f(x); }
__device__ __forceinline__ float fast_rcp(float x) { return __builtin_amdgcn_rcpf(x); }
__device__ __forceinline__ float sigmoidf_(float x) { return fast_rcp(1.f + fast_exp2(-x * LOG2E)); }
__device__ __forceinline__ float wave_sum(float v) {
#pragma unroll
    for (int o = 1; o < 64; o <<= 1) v += __shfl_xor(v, o);
    return v;
}
__device__ __forceinline__ s16x4 tr_read(LAS const unsigned char* p) {
    typedef short v4i16_t __attribute__((ext_vector_type(4)));
    return __builtin_bit_cast(s16x4, __builtin_amdgcn_ds_read_tr16_b64_v4i16((LAS v4i16_t*)p));
}
__device__ __forceinline__ int crow(int r, int hi) { return (r & 3) + 8 * (r >> 2) + 4 * hi; }

namespace pg8 {
typedef unsigned short bf16_t;
typedef unsigned u32x4 __attribute__((ext_vector_type(4)));
constexpr int BM = 256, BK = 64, HALF = 128, HTB = HALF * BK * 2, STAGE_BYTES = 8 * HTB, NXCD = 8, WGM = 8;
__host__ __device__ __forceinline__ int lds_byte(int r, int c) { const int st = (r >> 4) * 2 + (c >> 5), rr = r & 15, cc = c & 31, ob = rr * 64 + cc * 2; return st * 1024 + (ob ^ (((ob >> 9) & 1) << 5)); }
__host__ __device__ __forceinline__ void stage_rc(int b, int& R, int& C) { const int st = b / 1024, sb = b % 1024, swz = sb ^ (((sb >> 9) & 1) << 5); R = (st >> 1) * 16 + swz / 64; C = (st & 1) * 32 + (swz % 64) / 2; }
__host__ __device__ __forceinline__ int perm32(int rho) { const int n = rho >> 4, i = rho & 15; return 8 * (i >> 2) + 4 * n + (i & 3); }

struct Unit { int pm, pn, pb, ga; };
struct Gemm { const bf16_t* A0; const bf16_t* A1; const bf16_t* B0; const bf16_t* B1; int K; };

struct StaticOrder {
    static constexpr bool PAIR = false;
    int nM, nN, nwg, G, c;
    __device__ void init(int M, int N, int G_, int c_) { nM = M / BM; nN = N / BM; nwg = nM * nN; G = G_; c = c_; }
    __device__ bool next(int i, Unit& u) const {
        const long L = (long)i * G + c; if (L >= nwg) return false;
        int wgid = (int)L; { const int q = nwg / NXCD, r = nwg % NXCD, xcd = wgid % NXCD, off = wgid / NXCD; wgid = (xcd < r ? xcd * (q + 1) : r * (q + 1) + (xcd - r) * q) + off; }
        const int nig = WGM * nN, gid = wgid / nig, fm = gid * WGM, gsz = (nM - fm) < WGM ? (nM - fm) : WGM;
        u.pm = fm + ((wgid % nig) % gsz); u.pn = (wgid % nig) / gsz; u.pb = u.pn; u.ga = 0; return true;
    }
    __device__ __forceinline__ unsigned arow(const Unit&, int) const { return 0u; }
};
struct PairOrder {
    static constexpr bool PAIR = true;
    int nM, nN, nwg, G, c;
    __device__ void init(int M, int N, int G_, int c_) { nM = M / BM; nN = N / BM; nwg = nM * nN; G = G_; c = c_; }
    __device__ bool next(int i, Unit& u) const {
        const long L = (long)(i >> 1) * G + c; if (L >= nwg) return false;
        int wgid = (int)L; { const int q = nwg / NXCD, r = nwg % NXCD, xcd = wgid % NXCD, off = wgid / NXCD; wgid = (xcd < r ? xcd * (q + 1) : r * (q + 1) + (xcd - r) * q) + off; }
        const int nig = WGM * nN, gid = wgid / nig, fm = gid * WGM, gsz = (nM - fm) < WGM ? (nM - fm) : WGM;
        u.pm = fm + ((wgid % nig) % gsz); u.pn = (wgid % nig) / gsz; u.pb = u.pn; u.ga = i & 1; return true;
    }
    __device__ __forceinline__ unsigned arow(const Unit&, int) const { return 0u; }
};
struct MoeOrder {
    static constexpr bool PAIR = false;
    const LAS int* tb; const LAS int* cnt; const int* rowtok; int npn, G, c, total; bool gather;
    __device__ bool next(int i, Unit& u) const {
        const int L = i * G + c; if (L >= total) return false;
        const int tile = L / npn, pn = L - tile * npn; int e = 0;
#pragma unroll
        for (int j = 1; j < NEXP; ++j) e += (tile >= tb[j]) ? 1 : 0;
        u.pm = tile; u.pn = pn; u.pb = e * npn + pn; u.ga = e; return true;
    }
    __device__ __forceinline__ unsigned arow(const Unit& u, int r) const {
        const int e = u.ga, local = (u.pm - tb[e]) * 256 + r;
        return (local < cnt[e]) ? (unsigned)rowtok[e * ECAP + local] : 0u;
    }
};

template <class Epi, class Sched, bool ALIGN_EPI, bool GATHER>
__device__ __forceinline__ void gemm_phase(LAS unsigned char* lds, const Gemm g, const Sched& S, const Epi& E) {
    const int tid = threadIdx.x, wid = __builtin_amdgcn_readfirstlane(tid >> 6), lane = tid & 63, wr = wid >> 2, wc = wid & 3, fr = lane & 15, fq = lane >> 4;
    const int K = g.K, nt = K / BK;
    unsigned voffA[2], voffB[2]; int RA[2], CA[2];
#pragma unroll
    for (int i = 0; i < 2; ++i) { int R, C; stage_rc(tid * 16 + i * 8192, R, C); const int Rb = Epi::PERM ? ((R & ~31) + perm32(R & 31)) : R;
        RA[i] = R; CA[i] = C; voffA[i] = (unsigned)(R * K + C) * 2u; voffB[i] = (unsigned)(Rb * K + C) * 2u; }
    const size_t kstep = (size_t)(BK * 2);
    const size_t hstep = (size_t)HALF * K * 2;
    const size_t tstep = 2 * hstep;
    const unsigned ldsw = (unsigned)wid * 1024u;
    const int aoff = lds_byte(wr * 64 + fr, fq * 8), boff = lds_byte(wc * 32 + fr, fq * 8);
    LAS unsigned* noff = (LAS unsigned*)(lds + MOE_NOFF) + tid * 4;
#define PG8_SA(b, h) (((b) * 2 + (h)) * HTB)
#define PG8_SB(b, h) ((4 + (b) * 2 + (h)) * HTB)
#define PG8_STAGE(bufoff, gbase, voff) do { _Pragma("unroll") for (int _i = 0; _i < 2; ++_i) \
        __builtin_amdgcn_global_load_lds((const unsigned*)((const char*)(gbase) + (voff)[_i]), (LAS unsigned*)(lds + (bufoff) + ldsw + _i * 8192), 16, 0, 0); } while (0)
#define PG8_LDA(dst, b, h) do { _Pragma("unroll") for (int m = 0; m < 4; ++m) _Pragma("unroll") for (int k = 0; k < 2; ++k) dst[m][k] = *(const LAS bf16x8*)(lds + PG8_SA(b, h) + aoff + m * 2048 + k * 1024); } while (0)
#define PG8_LDB(dst, b, h) do { _Pragma("unroll") for (int n = 0; n < 2; ++n) _Pragma("unroll") for (int k = 0; k < 2; ++k) dst[n][k] = *(const LAS bf16x8*)(lds + PG8_SB(b, h) + boff + n * 2048 + k * 1024); } while (0)
#define PG8_MMA(ai, bj, At, Bt) do { __builtin_amdgcn_s_setprio(1); _Pragma("unroll") for (int m = 0; m < 4; ++m) _Pragma("unroll") for (int n = 0; n < 2; ++n) _Pragma("unroll") for (int k = 0; k < 2; ++k) \
        acc[ai][bj][m][n] = __builtin_amdgcn_mfma_f32_16x16x32_bf16(Bt[n][k], At[m][k], acc[ai][bj][m][n], 0, 0, 0); __builtin_amdgcn_s_setprio(0); } while (0)
#define PG8_WAIT_V(n) asm volatile("s_waitcnt vmcnt(" #n ")" ::: "memory")
#define PG8_WAIT_L(n) asm volatile("s_waitcnt lgkmcnt(" #n ")" ::: "memory")
#define PG8_BAR __builtin_amdgcn_s_barrier()
#define PG8_SCHED __builtin_amdgcn_sched_barrier(0)
    Unit cur, nxt; int ui = 0;
    if (!S.next(0, cur)) return;
    f32x4 acc[2][2][4][2];
#pragma unroll
    for (int a = 0; a < 2; ++a)
#pragma unroll
        for (int b = 0; b < 2; ++b)
#pragma unroll
            for (int m = 0; m < 4; ++m)
#pragma unroll
                for (int n = 0; n < 2; ++n) acc[a][b][m][n] = (f32x4){0.f, 0.f, 0.f, 0.f};
    bf16x8 At[4][2], B0[2][2], B1[2][2];
    unsigned cO0[2], cO1[2];
    const char* cA; const char* cB;
    if constexpr (GATHER) {
        cA = (const char*)g.A0;
#pragma unroll
        for (int i = 0; i < 2; ++i) { cO0[i] = S.arow(cur, RA[i]) * (unsigned)(K * 2) + (unsigned)CA[i] * 2u; cO1[i] = S.arow(cur, HALF + RA[i]) * (unsigned)(K * 2) + (unsigned)CA[i] * 2u; }
    } else {
        cA = (const char*)((Sched::PAIR && cur.ga) ? g.A1 : g.A0) + (size_t)cur.pm * tstep;
#pragma unroll
        for (int i = 0; i < 2; ++i) { cO0[i] = voffA[i]; cO1[i] = voffA[i] + (unsigned)hstep; }
    }
    cB = (const char*)((Sched::PAIR && cur.ga) ? g.B1 : g.B0) + (size_t)cur.pb * tstep;
    PG8_STAGE(PG8_SB(0, 0), cB, voffB); PG8_STAGE(PG8_SB(0, 1), cB + hstep, voffB); PG8_STAGE(PG8_SA(0, 0), cA, cO0); PG8_STAGE(PG8_SA(0, 1), cA, cO1);
    if (wr == 1) PG8_BAR;
    PG8_WAIT_V(2); PG8_BAR;
    PG8_STAGE(PG8_SB(1, 0), cB + kstep, voffB); PG8_STAGE(PG8_SA(1, 0), cA + kstep, cO0); PG8_STAGE(PG8_SB(1, 1), cB + hstep + kstep, voffB);
    PG8_WAIT_V(6); PG8_BAR;
    for (;;) {
        const bool has_next = S.next(ui + 1, nxt);
        const char* nA; const char* nB;
        if constexpr (GATHER) {
            nA = cA;
            if (has_next) {
                u32x4 o; o.x = S.arow(nxt, RA[0]) * (unsigned)(K * 2) + (unsigned)CA[0] * 2u; o.y = S.arow(nxt, RA[1]) * (unsigned)(K * 2) + (unsigned)CA[1] * 2u;
                o.z = S.arow(nxt, HALF + RA[0]) * (unsigned)(K * 2) + (unsigned)CA[0] * 2u; o.w = S.arow(nxt, HALF + RA[1]) * (unsigned)(K * 2) + (unsigned)CA[1] * 2u;
                *(LAS u32x4*)noff = o;
            } else { u32x4 o; o.x = cO0[0]; o.y = cO0[1]; o.z = cO1[0]; o.w = cO1[1]; *(LAS u32x4*)noff = o; }
        } else {
            nA = has_next ? (const char*)((Sched::PAIR && nxt.ga) ? g.A1 : g.A0) + (size_t)nxt.pm * tstep : cA;
        }
        nB = has_next ? (const char*)((Sched::PAIR && nxt.ga) ? g.B1 : g.B0) + (size_t)nxt.pb * tstep : cB;
        for (int t = 0; t < nt; t += 2) {
            const bool last = (t == nt - 2);
            const char* a1 = cA + (size_t)(t + 1) * kstep;
            const char* a2 = last ? nA : cA + (size_t)(t + 2) * kstep; const char* b2 = last ? nB : cB + (size_t)(t + 2) * kstep;
            const char* a3 = a2 + kstep; const char* b3 = b2 + kstep;
            unsigned sO0[2], sO1[2];
            if constexpr (GATHER) {
                if (last) { const u32x4 o = *(const LAS u32x4*)noff; sO0[0] = o.x; sO0[1] = o.y; sO1[0] = o.z; sO1[1] = o.w; }
                else { sO0[0] = cO0[0]; sO0[1] = cO0[1]; sO1[0] = cO1[0]; sO1[1] = cO1[1]; }
            } else { sO0[0] = cO0[0]; sO0[1] = cO0[1]; sO1[0] = cO1[0]; sO1[1] = cO1[1]; }
            PG8_LDB(B0, 0, 0); PG8_LDB(B1, 0, 1); PG8_SCHED; PG8_LDA(At, 0, 0); PG8_STAGE(PG8_SA(1, 1), a1, cO1);
            PG8_WAIT_V(8); PG8_WAIT_L(0); PG8_BAR; PG8_MMA(0, 0, At, B0); PG8_MMA(0, 1, At, B1); PG8_BAR; PG8_SCHED;
            PG8_LDA(At, 0, 1); PG8_STAGE(PG8_SB(0, 0), b2, voffB); PG8_STAGE(PG8_SB(0, 1), b2 + hstep, voffB); PG8_STAGE(PG8_SA(0, 0), a2, sO0);
            PG8_WAIT_V(8); PG8_WAIT_L(0); PG8_BAR; PG8_MMA(1, 0, At, B0); PG8_MMA(1, 1, At, B1); PG8_BAR; PG8_SCHED;
            PG8_LDB(B0, 1, 0); PG8_LDB(B1, 1, 1); PG8_SCHED; PG8_LDA(At, 1, 0); PG8_STAGE(PG8_SA(0, 1), a2, sO1);
            PG8_WAIT_V(8); PG8_WAIT_L(0); PG8_BAR; PG8_MMA(0, 0, At, B0); PG8_MMA(0, 1, At, B1); PG8_BAR; PG8_SCHED;
            PG8_LDA(At, 1, 1); PG8_STAGE(PG8_SB(1, 0), b3, voffB); PG8_STAGE(PG8_SB(1, 1), b3 + hstep, voffB); PG8_STAGE(PG8_SA(1, 0), a3, sO0);
            PG8_WAIT_V(8); PG8_WAIT_L(0); PG8_BAR; PG8_MMA(1, 0, At, B0); PG8_MMA(1, 1, At, B1); PG8_BAR; PG8_SCHED;
        }
        if constexpr (ALIGN_EPI) { if (wr == 0) PG8_BAR; }
        E(acc, cur, wr, wc, fr, fq);
        if (!has_next) break;
#pragma unroll
        for (int a = 0; a < 2; ++a)
#pragma unroll
            for (int b = 0; b < 2; ++b)
#pragma unroll
                for (int m = 0; m < 4; ++m)
#pragma unroll
                    for (int n = 0; n < 2; ++n) acc[a][b][m][n] = (f32x4){0.f, 0.f, 0.f, 0.f};
        cur = nxt; cA = nA; cB = nB; ++ui;
        if constexpr (GATHER) { const u32x4 o = *(const LAS u32x4*)noff; cO0[0] = o.x; cO0[1] = o.y; cO1[0] = o.z; cO1[1] = o.w; }
        if constexpr (ALIGN_EPI) { if (wr == 1) PG8_BAR; }
    }
    PG8_WAIT_V(0);
    if constexpr (!ALIGN_EPI) { if (wr == 0) PG8_BAR; }
    PG8_BAR;
#undef PG8_SA
#undef PG8_SB
#undef PG8_STAGE
#undef PG8_LDA
#undef PG8_LDB
#undef PG8_MMA
#undef PG8_WAIT_V
#undef PG8_WAIT_L
#undef PG8_BAR
#undef PG8_SCHED
}

struct EpiStore {
    static constexpr bool PERM = true;
    bf16_t* O; int ldc;
    __device__ __forceinline__ void operator()(const f32x4 (&acc)[2][2][4][2], const Unit& u, int wr, int wc, int fr, int fq) const {
        const int row0 = u.pm * BM + wr * 64 + fr, col0 = u.pn * BM + wc * 32 + 8 * fq;
#pragma unroll
        for (int ai = 0; ai < 2; ++ai)
#pragma unroll
            for (int m = 0; m < 4; ++m) { bf16_t* rowp = O + (size_t)(row0 + ai * HALF + m * 16) * ldc + col0;
#pragma unroll
                for (int bj = 0; bj < 2; ++bj) { const f32x4 v0 = acc[ai][bj][m][0], v1 = acc[ai][bj][m][1];
                    u32x4 w; w.x = cvt_pk_bf16(v0[0], v0[1]); w.y = cvt_pk_bf16(v0[2], v0[3]); w.z = cvt_pk_bf16(v1[0], v1[1]); w.w = cvt_pk_bf16(v1[2], v1[3]);
                    *(u32x4*)(rowp + bj * HALF) = w; } }
    }
};
struct EpiGate {
    static constexpr bool PERM = true;
    const bf16_t* proj; bf16_t* T; bf16_t* mrg;
    __device__ __forceinline__ void operator()(const f32x4 (&acc)[2][2][4][2], const Unit& u, int wr, int wc, int fr, int fq) const {
        const int row0 = u.pm * BM + wr * 64 + fr, col0 = u.pn * BM + wc * 32 + 8 * fq;
        const int gcol = (u.ga ? C_GB : C_GA) + col0;
        const ptrdiff_t dsel = u.ga ? (mrg - T) : (ptrdiff_t)0;
#pragma unroll
        for (int ai = 0; ai < 2; ++ai) { constexpr int m0 = 0;
            u32x4 gt[4][2], tv[4][2];
#pragma unroll
            for (int m = m0; m < m0 + 4; ++m) { const size_t row = (size_t)(row0 + ai * HALF + m * 16);
#pragma unroll
                for (int bj = 0; bj < 2; ++bj) { gt[m][bj] = __builtin_nontemporal_load((const u32x4*)(proj + row * NPROJP + gcol + bj * HALF));
                    tv[m][bj] = u.ga ? __builtin_nontemporal_load((const u32x4*)(T + row * DM + col0 + bj * HALF)) : (u32x4){0u, 0u, 0u, 0u}; } }
#pragma unroll
            for (int m = m0; m < m0 + 4; ++m) { const size_t row = (size_t)(row0 + ai * HALF + m * 16);
#pragma unroll
                for (int bj = 0; bj < 2; ++bj) { const f32x4 v0 = acc[ai][bj][m][0], v1 = acc[ai][bj][m][1]; const u32x4 g4 = gt[m][bj], t4 = tv[m][bj];
                    float r[8];
                    r[0] = v0[0] * sigmoidf_(bflo(g4.x)) + bflo(t4.x); r[1] = v0[1] * sigmoidf_(bfhi(g4.x)) + bfhi(t4.x); r[2] = v0[2] * sigmoidf_(bflo(g4.y)) + bflo(t4.y); r[3] = v0[3] * sigmoidf_(bfhi(g4.y)) + bfhi(t4.y);
                    r[4] = v1[0] * sigmoidf_(bflo(g4.z)) + bflo(t4.z); r[5] = v1[1] * sigmoidf_(bfhi(g4.z)) + bfhi(t4.z); r[6] = v1[2] * sigmoidf_(bflo(g4.w)) + bflo(t4.w); r[7] = v1[3] * sigmoidf_(bfhi(g4.w)) + bfhi(t4.w);
                    u32x4 w; w.x = cvt_pk_bf16(r[0], r[1]); w.y = cvt_pk_bf16(r[2], r[3]); w.z = cvt_pk_bf16(r[4], r[5]); w.w = cvt_pk_bf16(r[6], r[7]);
                    *(u32x4*)(T + dsel + row * DM + col0 + bj * HALF) = w; } }
        }
    }
};
struct EpiOut {
    static constexpr bool PERM = true;
    const float* x; const float* modf; bf16_t* x2;
    __device__ __forceinline__ void operator()(const f32x4 (&acc)[2][2][4][2], const Unit& u, int wr, int wc, int fr, int fq) const {
        const int row0 = u.pm * BM + wr * 64 + fr, col0 = u.pn * BM + wc * 32 + 8 * fq;
        const int b = (u.pm * BM) >> 11;
        f32x4 gv[2][2];
#pragma unroll
        for (int bj = 0; bj < 2; ++bj)
#pragma unroll
            for (int n = 0; n < 2; ++n) gv[bj][n] = *(const f32x4*)(modf + b * 12288 + 4096 + col0 + bj * HALF + 4 * n);
#pragma unroll
        for (int ai = 0; ai < 2; ++ai) { constexpr int m0 = 0;
            f32x4 xv[4][2][2];
#pragma unroll
            for (int m = m0; m < m0 + 4; ++m) { const size_t off = (size_t)(row0 + ai * HALF + m * 16) * DM + col0;
#pragma unroll
                for (int bj = 0; bj < 2; ++bj)
#pragma unroll
                    for (int n = 0; n < 2; ++n) xv[m][bj][n] = __builtin_nontemporal_load((const f32x4*)(x + off + bj * HALF + 4 * n)); }
#pragma unroll
            for (int m = m0; m < m0 + 4; ++m) { const size_t off = (size_t)(row0 + ai * HALF + m * 16) * DM + col0;
#pragma unroll
                for (int bj = 0; bj < 2; ++bj) { const f32x4 r0 = xv[m][bj][0] + gv[bj][0] * acc[ai][bj][m][0], r1 = xv[m][bj][1] + gv[bj][1] * acc[ai][bj][m][1];
                    u32x4 w; w.x = cvt_pk_bf16(r0[0], r0[1]); w.y = cvt_pk_bf16(r0[2], r0[3]); w.z = cvt_pk_bf16(r1[0], r1[1]); w.w = cvt_pk_bf16(r1[2], r1[3]);
                    *(u32x4*)(x2 + off + bj * HALF) = w; } }
        }
    }
};
struct EpiMoeGU {
    static constexpr bool PERM = true;
    bf16_t* act; const float* roww; const LAS int* tb; const LAS int* cnt;
    __device__ __forceinline__ void operator()(const f32x4 (&acc)[2][2][4][2], const Unit& u, int wr, int wc, int fr, int fq) const {
        const int e = u.ga, lbase = (u.pm - tb[e]) * 256, n_e = cnt[e];
        const int r0 = wr * 64 + fr, col0 = u.pn * HALF + wc * 32 + 8 * fq;
#pragma unroll
        for (int ai = 0; ai < 2; ++ai)
#pragma unroll
            for (int m = 0; m < 4; ++m) { const int r = r0 + ai * HALF + m * 16; const int local = lbase + r;
                const float w = (local < n_e) ? roww[e * ECAP + local] : 0.f;
                float o[8];
#pragma unroll
                for (int n = 0; n < 2; ++n)
#pragma unroll
                    for (int j = 0; j < 4; ++j) { const float gte = acc[ai][0][m][n][j], up = acc[ai][1][m][n][j]; o[4 * n + j] = gte * sigmoidf_(gte) * up * w; }
                u32x4 wv; wv.x = cvt_pk_bf16(o[0], o[1]); wv.y = cvt_pk_bf16(o[2], o[3]); wv.z = cvt_pk_bf16(o[4], o[5]); wv.w = cvt_pk_bf16(o[6], o[7]);
                *(u32x4*)(act + (size_t)(u.pm * 256 + r) * DEXP + col0) = wv; }
    }
};
}

#define XB_TMO      128
#define XB_XCNT(j)  (256  + 64 * (j))
#define XB_XSUB(j)  (1280 + 64 * (j))
#define XB_XGEN(j)  (2304 + 64 * (j))
#define XB_TOP      3328
#define XB_TOPGEN   3392
#define XCD_BAR_WORDS 3456
#define XB_SPIN_CAP (1u << 18)
__device__ __forceinline__ unsigned xb_ld(unsigned* p)              { return __hip_atomic_load(p, __ATOMIC_RELAXED, __HIP_MEMORY_SCOPE_AGENT); }
__device__ __forceinline__ unsigned xb_add(unsigned* p, unsigned v) { return __hip_atomic_fetch_add(p, v, __ATOMIC_RELAXED, __HIP_MEMORY_SCOPE_AGENT); }
__device__ __forceinline__ unsigned xb_xcc_id() { return (unsigned)__builtin_amdgcn_s_getreg((3 << 11) | 20) & 0xFu; }
#define XB_SPIN(cond, bar) do { unsigned _sp = 0; while (cond) { __builtin_amdgcn_s_sleep(1); \
    if ((++_sp & 255u) == 0u) { if (xb_ld(&(bar)[XB_TMO])) break; if (_sp > XB_SPIN_CAP) { atomicAdd(&(bar)[XB_TMO], 1u); break; } } } } while (0)
struct XcdBarrier { unsigned* bar; unsigned x; volatile LAS unsigned* st; };
__device__ __forceinline__ XcdBarrier xcd_barrier_post(unsigned* bar, volatile LAS unsigned* st) {
    XcdBarrier b; b.bar = bar; b.x = xb_xcc_id(); b.st = st;
    if (threadIdx.x == 0) (void)xb_add(&bar[XB_XCNT(b.x)], 1u);
    return b;
}
__device__ __forceinline__ void xcd_barrier_complete(unsigned* bar, unsigned x, unsigned& nloc, unsigned& nx) {
    const unsigned G = gridDim.x * gridDim.y * gridDim.z;
    unsigned sum, cnt, mine, sp = 0u;
    for (;;) {
        sum = 0u; cnt = 0u; mine = 0u;
#pragma unroll
        for (unsigned j = 0; j < 16; ++j) { const unsigned c = xb_ld(&bar[XB_XCNT(j)]); sum += c; cnt += (c > 0u) ? 1u : 0u; mine = (j == x) ? c : mine; }
        if (sum == G) break;
        __builtin_amdgcn_s_sleep(1);
        if ((++sp & 255u) == 0u) { if (xb_ld(&bar[XB_TMO])) break; if (sp > XB_SPIN_CAP) { atomicAdd(&bar[XB_TMO], 1u); break; } }
    }
    nloc = mine > 0u ? mine : 1u; nx = cnt > 0u ? cnt : 1u;
}
__device__ __forceinline__ void xcd_barrier(const XcdBarrier& b) {
    asm volatile("s_waitcnt vmcnt(0)" ::: "memory");
    __syncthreads();
    if (threadIdx.x == 0) {
        unsigned* bar = b.bar;
        __builtin_amdgcn_s_waitcnt(0);
        unsigned nloc = b.st[0], nx = b.st[1];
        if (nloc == 0u) { xcd_barrier_complete(bar, b.x, nloc, nx); b.st[0] = nloc; b.st[1] = nx; }
        const unsigned old = xb_add(&bar[XB_XSUB(b.x)], 1u);
        const unsigned gen = old / nloc;
        if (old + 1u == (gen + 1u) * nloc) {
            __builtin_amdgcn_fence(__ATOMIC_RELEASE, "agent");
            asm volatile("s_waitcnt vmcnt(0)" ::: "memory");
            const unsigned og = xb_add(&bar[XB_TOP], 1u);
            const unsigned tg = og / nx;
            if (og + 1u == (tg + 1u) * nx) xb_add(&bar[XB_TOPGEN], 1u);
            else XB_SPIN(xb_ld(&bar[XB_TOPGEN]) == tg, bar);
            __builtin_amdgcn_fence(__ATOMIC_ACQUIRE, "agent");
            xb_add(&bar[XB_XGEN(b.x)], 1u);
            asm volatile("s_waitcnt vmcnt(0)" ::: "memory");
        } else {
            XB_SPIN(xb_ld(&bar[XB_XGEN(b.x)]) == gen, bar);
            __builtin_amdgcn_fence(__ATOMIC_ACQUIRE, "agent");
            asm volatile("s_waitcnt vmcnt(0)" ::: "memory");
        }
    }
    __syncthreads();
}

struct Args { const float* in[22]; float* out; unsigned char* ws; int ph_lo, ph_hi; };
typedef __attribute__((address_space(4))) const Args KArgs;
__device__ __forceinline__ KArgs* kargs() { KArgs* p = (KArgs*)__builtin_amdgcn_kernarg_segment_ptr(); asm volatile("" : "+s"(p)); return p; }
enum { I_X = 0, I_C, I_WADA, I_BADA, I_LN1G, I_WIN, I_SWAQN, I_SWAKN, I_SINKS, I_DSAQN, I_DSAKN, I_WBA, I_WBB, I_WOUT, I_LN2G, I_WGRP, I_BGRP, I_WEXP, I_BEXP, I_WGU, I_WUP, I_WDN };

__device__ __forceinline__ void p0_adaln_item(KArgs& a, LAS unsigned char* lds, int j, int tid) {
    LAS float* condl = (LAS float*)lds;
    LAS float* red = (LAS float*)(lds + 8192);
    const int cr = j & 63, kq = j >> 6;
    const float* cin = a.in[I_C];
    { float cv[4];
#pragma unroll
      for (int j = 0; j < 4; ++j) { const int i = tid + 512 * j, kk = i >> 2, b = i & 3; cv[j] = cin[b * 2048 + kq * 512 + kk]; }
#pragma unroll
      for (int j = 0; j < 4; ++j) { const int i = tid + 512 * j, kk = i >> 2, b = i & 3; const float c = cv[j]; condl[kk * 4 + b] = c * fast_rcp(1.f + __expf(-c)); } }
    __syncthreads();
    if (tid < 480) {
        const int cg = tid % 48, ks = tid / 48;
        const float* wp = a.in[I_WADA] + (size_t)(kq * 512) * 12288 + cr * 192 + cg * 4;
        f32x4 acc[4];
#pragma unroll
        for (int b = 0; b < 4; ++b) acc[b] = (f32x4){0.f, 0.f, 0.f, 0.f};
#pragma unroll 13
        for (int kk = ks; kk < 512; kk += 10) {
            const f32x4 w = __builtin_nontemporal_load((const f32x4*)(wp + (size_t)kk * 12288));
            const f32x4 c = *(const LAS f32x4*)(condl + kk * 4);
            acc[0] += c.x * w; acc[1] += c.y * w; acc[2] += c.z * w; acc[3] += c.w * w;
        }
#pragma unroll
        for (int b = 0; b < 4; ++b) *(LAS f32x4*)(red + (ks * 4 + b) * 192 + cg * 4) = acc[b];
    }
    __syncthreads();
    float* modp = (float*)(a.ws + WS_MODP);
    for (int o = tid; o < 768; o += 512) { const int b = o / 192, col = o % 192; float s = 0.f;
#pragma unroll
        for (int ks = 0; ks < 10; ++ks) s += red[(ks * 4 + b) * 192 + col];
        modp[(kq * 4 + b) * 12288 + cr * 192 + col] = s; }
    __syncthreads();
}
__device__ __forceinline__ void tr_item(const float* W, int N, int Nvalid, int K, bf16* WT, int drow0, int k0, int n0, LAS unsigned char* scr, int lane) {
    const int n4 = lane & 15, kr = lane >> 4;
    const bool ok = (n0 + 4 * n4) < Nvalid;
    f32x4 v[16];
#pragma unroll
    for (int i = 0; i < 16; ++i) v[i] = ok ? __builtin_nontemporal_load((const f32x4*)(W + (size_t)(k0 + kr + 4 * i) * N + n0 + 4 * n4)) : (f32x4){0.f, 0.f, 0.f, 0.f};
#pragma unroll
    for (int i = 0; i < 16; ++i) { const int k = kr + 4 * i, pos = (k & ~12) | ((k & 4) << 1) | ((k & 8) >> 1);
        v2u w; w.x = cvt_pk_bf16(v[i].x, v[i].y); w.y = cvt_pk_bf16(v[i].z, v[i].w); *(LAS v2u*)(scr + pos * 160 + n4 * 8) = w; }
    LDS_WAIT(); asm volatile("" ::: "memory");
    const int i16 = lane & 15, g = lane >> 4;
    LAS const unsigned char* rd = scr + (4 * (g & 1) + 16 * (g >> 1) + (i16 >> 2)) * 160 + 8 * (i16 & 3);
#pragma unroll
    for (int nt = 0; nt < 4; ++nt)
#pragma unroll
        for (int kh = 0; kh < 2; ++kh) {
            const s16x4 vl = tr_read(rd + (32 * kh) * 160 + 32 * nt), vh = tr_read(rd + (32 * kh + 8) * 160 + 32 * nt);
            v4u o = __builtin_bit_cast(v4u, (bf16x8){vl[0], vl[1], vl[2], vl[3], vh[0], vh[1], vh[2], vh[3]});
            *(v4u*)(WT + (size_t)(drow0 + 16 * nt + i16) * K + k0 + 32 * kh + 8 * g) = o; }
    LDS_WAIT(); asm volatile("" ::: "memory");
}
__device__ __forceinline__ void p0_prologue(KArgs& a, LAS unsigned char* lds, int vcu, int G, int tid, int lane, int wave) {
    for (int j = vcu; j < 256; j += G) p0_adaln_item(a, lds, j, tid);
    LAS unsigned char* scr = lds + wave * 10240;
    const int gw = vcu * NWAVES + wave, NGW = G * NWAVES;
    constexpr int I_IN = 32 * 124, I_BR = 16 * 32, I_OUT = 32 * 32;
    constexpr int NITEMS = I_IN + 2 * I_BR + I_OUT;
    unsigned char* ws = a.ws;
    for (int it = gw; it < NITEMS; it += NGW) {
        int r = it;
        if (r < I_IN) { const int kb = r / 124, nb = r % 124; tr_item(a.in[I_WIN], NPROJ, NPROJ, 2048, (bf16*)(ws + WS_WTIN), 64 * nb, 64 * kb, 64 * nb, scr, lane); continue; } r -= I_IN;
        if (r < I_BR) { const int kb = r / 32, nb = r % 32; tr_item(a.in[I_WBA], 2048, 2048, 1024, (bf16*)(ws + WS_WTA), 64 * nb, 64 * kb, 64 * nb, scr, lane); continue; } r -= I_BR;
        if (r < I_BR) { const int kb = r / 32, nb = r % 32; tr_item(a.in[I_WBB], 2048, 2048, 1024, (bf16*)(ws + WS_WTB), 64 * nb, 64 * kb, 64 * nb, scr, lane); continue; } r -= I_BR;
        { const int kb = r / 32, nb = r % 32; tr_item(a.in[I_WOUT], 2048, 2048, 2048, (bf16*)(ws + WS_WTO), 64 * nb, 64 * kb, 64 * nb, scr, lane); }
    }
    __syncthreads();
}

__device__ __forceinline__ float modval(const float* modp, const float* bada, int b, int n) {
    return ((modp[(0 * 4 + b) * 12288 + n] + modp[(1 * 4 + b) * 12288 + n]) + (modp[(2 * 4 + b) * 12288 + n] + modp[(3 * 4 + b) * 12288 + n])) + bada[n];
}
__device__ __forceinline__ void p1_norm1(KArgs& a, LAS unsigned char* lds, int vcu, int G, int tid, int lane, int wave) {
    const float* modp = (const float*)(a.ws + WS_MODP); const float* bada = a.in[I_BADA];
    float* modf = (float*)(a.ws + WS_MODF);
    LAS float* A4 = (LAS float*)lds; LAS float* B4 = A4 + 2048;
    const float* g1 = a.in[I_LN1G];
    for (int i = vcu * 512 + tid; i < 4 * 12288; i += G * 512) { const int b = i / 12288, n = i % 12288; modf[i] = modval(modp, bada, b, n); }
    { bf16* wrf = (bf16*)(a.ws + WS_WRH);
      for (int i = vcu * 512 + tid; i < 64 * 2048; i += G * 512) { const int k = i >> 6, n = i & 63;
          const float w = (n < 32) ? a.in[I_WEXP][k * 32 + n] : (n < 36) ? a.in[I_WGRP][k * 4 + (n - 32)] : 0.f;
          const unsigned hi = cvt_pk_bf16(w, 0.f) & 0xffffu; const float lo = w - bflo(hi);
          const size_t base = ((size_t)(((k >> 4) * 2 + (n >> 5)) * 2) * 64 + (n & 31) + 32 * ((k >> 3) & 1)) * 8 + (k & 7);
          wrf[base] = (bf16)hi; wrf[base + 64 * 8] = (bf16)(cvt_pk_bf16(lo, 0.f) & 0xffffu); } }
    const float* x = a.in[I_X]; bf16* H = (bf16*)(a.ws + WS_H);
    for (int blk = vcu; blk < 256; blk += G) {
        const int b = blk >> 6;
        {
            const int m = blk * 32 + wave * 4;
            const f32x4* xr = (const f32x4*)(x + (size_t)m * DM) + lane;
            f32x4 v[4][8]; float rs4[4];
#pragma unroll
            for (int t4 = 0; t4 < 4; ++t4)
#pragma unroll
                for (int j = 0; j < 8; ++j) v[t4][j] = __builtin_nontemporal_load(xr + (size_t)t4 * (DM / 4) + 64 * j);
            __syncthreads();
            { float av[4], bv[4];
#pragma unroll
              for (int i = 0; i < 4; ++i) { const int k = tid + 512 * i; av[i] = g1[k] * (1.f + modval(modp, bada, b, 2048 + k)); bv[i] = modval(modp, bada, b, k); }
#pragma unroll
              for (int i = 0; i < 4; ++i) { const int k = tid + 512 * i; A4[k] = av[i]; B4[k] = bv[i]; } }
            __syncthreads();
#pragma unroll
            for (int t4 = 0; t4 < 4; ++t4) { float s_ = 0.f;
#pragma unroll
                for (int j = 0; j < 8; ++j) s_ += (v[t4][j].x * v[t4][j].x + v[t4][j].y * v[t4][j].y) + (v[t4][j].z * v[t4][j].z + v[t4][j].w * v[t4][j].w);
                rs4[t4] = 1.f / sqrtf(wave_sum(s_) * (1.f / DM) + RMS_EPS); }
            unsigned long long* o8 = (unsigned long long*)(H + (size_t)m * DM) + lane;
#pragma unroll
            for (int j = 0; j < 8; ++j) { const int k = 4 * lane + 256 * j; const f32x4 A = *(const LAS f32x4*)(A4 + k), Bv = *(const LAS f32x4*)(B4 + k);
#pragma unroll
                for (int t4 = 0; t4 < 4; ++t4) { const f32x4 y = v[t4][j] * rs4[t4] * A + Bv;
                    o8[(size_t)t4 * (DM / 4) + 64 * j] = (unsigned long long)cvt_pk_bf16(y.x, y.y) | ((unsigned long long)cvt_pk_bf16(y.z, y.w) << 32); } }
        }
    }
}

__device__ __forceinline__ void prep_norms(KArgs& a, int vcu, int G, int lane, int wave) {
    bf16* proj = (bf16*)(a.ws + WS_PROJ);
    const int gw = vcu * NWAVES + wave, NGW = G * NWAVES;
    const int sub = lane & 7, grp = lane >> 3;
    for (int v80 = gw; v80 < MTOK * 5 / 8; v80 += 3 * NGW) {
        v4u wv[3]; bf16* pp[3]; const float* gn[3]; bool ok[3];
#pragma unroll
        for (int j = 0; j < 3; ++j) { const int v8 = v80 + j * NGW; ok[j] = v8 < MTOK * 5 / 8; const int v = (ok[j] ? v8 : gw) * 8 + grp, m = v / 5, w5 = v - 5 * m;
            const int col = (w5 < 4) ? C_KA + 64 * w5 : C_KB; gn[j] = (w5 < 4) ? a.in[I_SWAKN] : a.in[I_DSAKN];
            pp[j] = proj + (size_t)m * NPROJP + col + sub * 8; wv[j] = *(const v4u*)pp[j]; }
#pragma unroll
        for (int j = 0; j < 3; ++j) if (ok[j]) {
            const v4u w = wv[j];
            float f[8] = {bflo(w.x), bfhi(w.x), bflo(w.y), bfhi(w.y), bflo(w.z), bfhi(w.z), bflo(w.w), bfhi(w.w)};
            float ss = 0.f;
#pragma unroll
            for (int i = 0; i < 8; ++i) ss += f[i] * f[i];
            ss += __shfl_xor(ss, 1); ss += __shfl_xor(ss, 2); ss += __shfl_xor(ss, 4);
            const float r = 1.f / sqrtf(ss * (1.f / 64.f) + RMS_EPS);
            const f32x4 g0 = *(const f32x4*)(gn[j] + sub * 8), g1 = *(const f32x4*)(gn[j] + sub * 8 + 4);
            v4u o; o.x = cvt_pk_bf16(f[0] * r * g0.x, f[1] * r * g0.y); o.y = cvt_pk_bf16(f[2] * r * g0.z, f[3] * r * g0.w);
            o.z = cvt_pk_bf16(f[4] * r * g1.x, f[5] * r * g1.y); o.w = cvt_pk_bf16(f[6] * r * g1.z, f[7] * r * g1.w);
            *(v4u*)pp[j] = o;
        }
    }
}
__device__ __forceinline__ unsigned f2key(float f) { const unsigned u = __float_as_uint(f); return (u & 0x80000000u) ? ~u : (u | 0x80000000u); }
__device__ __forceinline__ unsigned half_sum(unsigned v) {
    v += (unsigned)__builtin_amdgcn_update_dpp(0, (int)v, 0xB1, 0xF, 0xF, false);
    v += (unsigned)__builtin_amdgcn_update_dpp(0, (int)v, 0x4E, 0xF, 0xF, false);
    v += (unsigned)__builtin_amdgcn_update_dpp(0, (int)v, 0x141, 0xF, 0xF, false);
    v += (unsigned)__builtin_amdgcn_update_dpp(0, (int)v, 0x140, 0xF, 0xF, false);
    v += (unsigned)__builtin_amdgcn_ds_swizzle((int)v, 0x401F);
    return v;
}
constexpr int IX_KBUF = 36864;
constexpr int IX_LST = 2 * IX_KBUF;
__device__ __forceinline__ void indexer_unit(const bf16* proj, unsigned short* idxo, LAS unsigned char* lds, int u, int tid, int lane, int wave) {
    const int b = u >> 7, q0 = (u & 127) << 4;
    const int r32 = lane & 31, hi = lane >> 5;
    const int tq = q0 + 2 * wave + hi;
    const int NT = (q0 + 47) >> 5, NC = (NT + 7) >> 3;
    bf16x8 aq[4]; float wv[16];
    {
        const int sel = (r32 >> 2) & 1, head = (r32 & 3) + 4 * (r32 >> 3);
        const bf16* qrow = proj + (size_t)(b * SEQ + q0 + 2 * wave + sel) * NPROJP + C_QI + head * 64 + hi * 8;
#pragma unroll
        for (int ks = 0; ks < 4; ++ks) aq[ks] = *(const bf16x8*)(qrow + 16 * ks);
        const bf16* wrow = proj + (size_t)(b * SEQ + tq) * NPROJP + C_WI;
        const v4u w0 = *(const v4u*)wrow, w1 = *(const v4u*)(wrow + 8);
        const float c = 0.25f * 0.125f;
        wv[0] = bflo(w0.x) * c; wv[1] = bfhi(w0.x) * c; wv[2] = bflo(w0.y) * c; wv[3] = bfhi(w0.y) * c; wv[4] = bflo(w0.z) * c; wv[5] = bfhi(w0.z) * c; wv[6] = bflo(w0.w) * c; wv[7] = bfhi(w0.w) * c;
        wv[8] = bflo(w1.x) * c; wv[9] = bfhi(w1.x) * c; wv[10] = bflo(w1.y) * c; wv[11] = bfhi(w1.y) * c; wv[12] = bflo(w1.z) * c; wv[13] = bfhi(w1.z) * c; wv[14] = bflo(w1.w) * c; wv[15] = bfhi(w1.w) * c;
    }
    unsigned key[64];
    const bf16* kibase = proj + (size_t)(b * SEQ) * NPROJP + C_KI;
    v4u st[4];
#define IX_LOAD(c) do { _Pragma("unroll") for (int i = 0; i < 4; ++i) { const int p = tid + 512 * i; st[i] = *(const v4u*)(kibase + (size_t)(256 * (c) + (p >> 3)) * NPROJP + (p & 7) * 8); } } while (0)
#define IX_WRITE(buf) do { _Pragma("unroll") for (int i = 0; i < 4; ++i) { const int p = tid + 512 * i; *(LAS v4u*)(lds + (buf) * IX_KBUF + (p >> 3) * 144 + (p & 7) * 16) = st[i]; } } while (0)
    IX_LOAD(0); IX_WRITE(0);
    __syncthreads();
#pragma unroll
    for (int c = 0; c < 8; ++c) {
        if (c < NC) {
            if (c + 1 < NC) IX_LOAD(c + 1);
#pragma unroll
            for (int tt = 0; tt < 8; ++tt) {
                const int T = 8 * c + tt;
                if (T < NT) {
                    LAS const unsigned char* kb = lds + (c & 1) * IX_KBUF + (32 * tt + r32) * 144 + 16 * hi;
                    f32x16 C = {};
#pragma unroll
                    for (int ks = 0; ks < 4; ++ks) { const bf16x8 bk = *(const LAS bf16x8*)(kb + 32 * ks); C = __builtin_amdgcn_mfma_f32_32x32x16_bf16(aq[ks], bk, C, 0, 0, 0); }
                    float sc = 0.f;
#pragma unroll
                    for (int r = 0; r < 16; ++r) sc += fmaxf(C[r], 0.f) * wv[r];
                    unsigned kk = f2key(sc); kk = kk < 1u ? 1u : kk;
                    key[T] = ((32 * T + r32) <= tq) ? kk : 0u;
                } else key[T] = 0u;
            }
            if (c + 1 < NC) IX_WRITE((c + 1) & 1);
            __syncthreads();
        } else {
#pragma unroll
            for (int tt = 0; tt < 8; ++tt) key[8 * c + tt] = 0u;
        }
    }
#undef IX_LOAD
#undef IX_WRITE
    unsigned T = 0u, need = 0u, cgt = 0u;
    const bool small = (q0 + 2 * wave + 1) < 256;
    if (!small) {
        unsigned prefix = 0u; bool done = false;
        for (int bit = 31; bit >= 0; --bit) {
            const unsigned cand = prefix | (1u << bit);
            unsigned cnt = 0u;
#pragma unroll
            for (int c8 = 0; c8 < 8; ++c8) if (8 * c8 < NT) {
#pragma unroll
                for (int r = 8 * c8; r < 8 * c8 + 8; ++r) cnt += (key[r] >= cand) ? 1u : 0u; }
            cnt = half_sum(cnt);
            const bool take = !done && cnt >= 256u;
            prefix = take ? cand : prefix;
            done = done || (take && cnt == 256u);
            if (__all(done)) break;
        }
        if (done) { T = prefix - 1u; need = 0u; cgt = 256u; }
        else {
            T = prefix; unsigned cnt = 0u;
#pragma unroll
            for (int c8 = 0; c8 < 8; ++c8) if (8 * c8 < NT) {
#pragma unroll
                for (int r = 8 * c8; r < 8 * c8 + 8; ++r) cnt += (key[r] > T) ? 1u : 0u; }
            cgt = half_sum(cnt); need = 256u - cgt;
        }
    }
    LAS unsigned char* lst = lds + IX_LST + wave * 1024;
    *(LAS v4u*)(lst + lane * 16) = (v4u){0xFFFFFFFFu, 0xFFFFFFFFu, 0xFFFFFFFFu, 0xFFFFFFFFu};
    LDS_WAIT();
    LAS unsigned short* lq = (LAS unsigned short*)(lst + hi * 512);
    if (__all(need == 0u)) {
        unsigned base_gt = 0u;
#pragma unroll
        for (int r = 0; r < 64; ++r) if ((r & ~7) < NT) {
            const bool gt = key[r] > T;
            const unsigned long long mg = __ballot(gt);
            const unsigned mgh = hi ? (unsigned)(mg >> 32) : (unsigned)mg;
            if (gt) lq[base_gt + __popc(mgh & ((1u << r32) - 1u))] = (unsigned short)(32 * r + r32);
            base_gt += __popc(mgh);
        }
    } else {
    unsigned base_gt = 0u, base_eq = 0u;
#pragma unroll
    for (int r = 0; r < 64; ++r) if ((r & ~7) < NT) {
        const bool gt = key[r] > T, eq = key[r] == T;
        const unsigned long long mg = __ballot(gt), me = __ballot(eq);
        const unsigned mgh = hi ? (unsigned)(mg >> 32) : (unsigned)mg, meh = hi ? (unsigned)(me >> 32) : (unsigned)me;
        const unsigned below = (1u << r32) - 1u;
        const unsigned rg = __popc(mgh & below), re = __popc(meh & below);
        if (gt) lq[base_gt + rg] = (unsigned short)(32 * r + r32);
        if (eq && (base_eq + re) < need) lq[cgt + base_eq + re] = (unsigned short)(32 * r + r32);
        base_gt += __popc(mgh); base_eq += __popc(meh);
    }
    }
    LDS_WAIT();
    const v4u lo = *(const LAS v4u*)(lst + lane * 16);
    *(v4u*)(idxo + ((size_t)(b * SEQ + q0 + 2 * wave + hi)) * 256 + r32 * 8) = lo;
    __syncthreads();
}

constexpr int SW_V = 36864, SW_WS = SW_V + 32768;
__device__ __forceinline__ void swa_unit(const bf16* proj, bf16* oa, const float* sinks, const float* gq, const float* gk, const LAS float* gql, LAS unsigned char* lds, int u, int tid, int lane, int wave) {
    const int b = u >> 6, nblk = (u >> 2) & 15, kvh = u & 3;
    const int r32 = lane & 31, hi = lane >> 5;
    {
        v4u kv[4], vv[4];
#pragma unroll
        for (int i = 0; i < 4; ++i) {
            const int p = tid + 512 * i, kw = p >> 3, part = p & 7; int spos = 128 * (nblk - 1) + kw; spos = spos < 0 ? 0 : spos;
            const bf16* src = proj + (size_t)(b * SEQ + spos) * NPROJP;
            kv[i] = *(const v4u*)(src + C_KA + kvh * 64 + part * 8); vv[i] = *(const v4u*)(src + C_VA + kvh * 64 + part * 8);
        }
#pragma unroll
        for (int i = 0; i < 4; ++i) {
            const int p = tid + 512 * i, kw = p >> 3, part = p & 7;
            *(LAS v4u*)(lds + kw * 144 + part * 16) = kv[i];
            *(LAS v4u*)(lds + SW_V + (part >> 2) * 16384 + kw * 64 + (part & 3) * 16) = vv[i];
        }
    }
    __syncthreads();
    const int hq = kvh * 4 + (wave >> 1);
    const float sink2 = sinks[hq] * LOG2E, slope2 = exp2f(-(float)(hq + 1) * 0.25f) * LOG2E;
    float gqm = fabsf(gq[lane]), gkm = fabsf(gk[lane]);
#pragma unroll
    for (int o_ = 1; o_ < 64; o_ <<= 1) { gqm = fmaxf(gqm, __shfl_xor(gqm, o_)); gkm = fmaxf(gkm, __shfl_xor(gkm, o_)); }
    const float qkbound = 8.f * gqm * gkm * LOG2E * 1.02f;
    LAS float* wsf = (LAS float*)(lds + SW_WS) + wave * 32;
#pragma unroll 1
    for (int qq = 0; qq < 2; ++qq) {
        const int qt = 2 * (wave & 1) + qq, t0 = 128 * nblk + 32 * qt;
        const bf16* qrow = proj + (size_t)(b * SEQ + t0 + r32) * NPROJP + C_QA + hq * 64 + hi * 8;
        bf16x8 qr[4];
#pragma unroll
        for (int d0 = 0; d0 < 4; ++d0) qr[d0] = *(const bf16x8*)(qrow + 16 * d0);
        {
            float ss = 0.f;
#pragma unroll
            for (int d0 = 0; d0 < 4; ++d0) { const v4u w = __builtin_bit_cast(v4u, qr[d0]);
                ss += (bflo(w.x) * bflo(w.x) + bfhi(w.x) * bfhi(w.x)) + (bflo(w.y) * bflo(w.y) + bfhi(w.y) * bfhi(w.y)) + (bflo(w.z) * bflo(w.z) + bfhi(w.z) * bfhi(w.z)) + (bflo(w.w) * bflo(w.w) + bfhi(w.w) * bfhi(w.w)); }
            ss += __shfl_xor(ss, 32);
            const float r = (0.125f * LOG2E) / sqrtf(ss * (1.f / 64.f) + RMS_EPS);
#pragma unroll
            for (int d0 = 0; d0 < 4; ++d0) { const v4u w = __builtin_bit_cast(v4u, qr[d0]);
                const f32x4 g0 = *(const LAS f32x4*)(gql + 16 * d0 + 8 * hi), g1 = *(const LAS f32x4*)(gql + 16 * d0 + 8 * hi + 4);
                v4u o; o.x = cvt_pk_bf16(bflo(w.x) * r * g0.x, bfhi(w.x) * r * g0.y); o.y = cvt_pk_bf16(bflo(w.y) * r * g0.z, bfhi(w.y) * r * g0.w);
                o.z = cvt_pk_bf16(bflo(w.z) * r * g1.x, bfhi(w.z) * r * g1.y); o.w = cvt_pk_bf16(bflo(w.w) * r * g1.z, bfhi(w.w) * r * g1.w);
                qr[d0] = __builtin_bit_cast(bf16x8, o); }
        }
        const float mx = fmaxf(sink2, qkbound);
        const int jlo = (nblk == 0) ? ((4 - qt) > 0 ? (4 - qt) : 0) : 0;
        float lsum = 0.f;
        f32x16 o[2]; o[0] = (f32x16){}; o[1] = (f32x16){};
#pragma unroll 1
        for (int j = jlo; j < 5; ++j) {
            const int kt = qt + j;
            LAS const unsigned char* kb = lds + (32 * kt + r32) * 144 + 16 * hi;
            f32x16 C = {};
#pragma unroll
            for (int d0 = 0; d0 < 4; ++d0) { const bf16x8 kf = *(const LAS bf16x8*)(kb + 32 * d0); C = __builtin_amdgcn_mfma_f32_32x32x16_bf16(kf, qr[d0], C, 0, 0, 0); }
#pragma unroll
            for (int r = 0; r < 16; ++r) { const int rel = (128 + 32 * qt + r32) - (32 * kt + crow(r, hi));
                const float v = (rel >= 0 && rel < 128) ? C[r] - slope2 * (float)rel : NEGBIG; const float p = fast_exp2(v - mx); C[r] = p; lsum += p; }
#pragma unroll
            for (int ks = 0; ks < 2; ++ks) {
                v4u pw; pw.x = cvt_pk_bf16(C[8 * ks + 0], C[8 * ks + 1]); pw.y = cvt_pk_bf16(C[8 * ks + 2], C[8 * ks + 3]);
                pw.z = cvt_pk_bf16(C[8 * ks + 4], C[8 * ks + 5]); pw.w = cvt_pk_bf16(C[8 * ks + 6], C[8 * ks + 7]);
                const bf16x8 pa = __builtin_bit_cast(bf16x8, pw);
#pragma unroll
                for (int d0 = 0; d0 < 2; ++d0) {
                    LAS const unsigned char* vp = lds + SW_V + d0 * 16384 + (32 * kt + 16 * ks + 4 * hi + ((lane & 15) >> 2)) * 64 + ((lane >> 4) & 1) * 32 + (lane & 3) * 8;
                    const s16x4 vl = tr_read(vp), vh = tr_read(vp + 512);
                    const bf16x8 vf = (bf16x8){vl[0], vl[1], vl[2], vl[3], vh[0], vh[1], vh[2], vh[3]};
                    o[d0] = __builtin_amdgcn_mfma_f32_32x32x16_bf16(pa, vf, o[d0], 0, 0, 0);
                }
            }
        }
        lsum += __shfl_xor(lsum, 32); lsum += fast_exp2(sink2 - mx);
        if (hi == 0) wsf[r32] = fast_rcp(lsum);
        LDS_WAIT();
        bf16* orow = oa + (size_t)(b * SEQ + t0) * 1024 + hq * 64 + r32;
#pragma unroll
        for (int r = 0; r < 16; ++r) { const int q = crow(r, hi); const float rl = wsf[q];
            const unsigned w0 = cvt_pk_bf16(o[0][r] * rl, 0.f), w1 = cvt_pk_bf16(o[1][r] * rl, 0.f);
            orow[(size_t)q * 1024] = (bf16)(w0 & 0xffffu); orow[(size_t)q * 1024 + 32] = (bf16)(w1 & 0xffffu); }
        LDS_WAIT();
    }
    __syncthreads();
}

constexpr int DS_VBUF = 5120, DS_WAVE = 3 * DS_VBUF + 512;
struct DsaPre { v2u li; bf16x8 qf0, qf1; };
__device__ __forceinline__ DsaPre dsa_prefetch(const bf16* proj, const unsigned short* idx, int b, int t, int lane) {
    DsaPre p; const int i16 = lane & 15, g = lane >> 4;
    p.li = *(const v2u*)(idx + ((size_t)(b * SEQ + t)) * 256 + lane * 4);
    const bf16* qrow = proj + (size_t)(b * SEQ + t) * NPROJP + C_QB + i16 * 64 + 8 * g;
    p.qf0 = *(const bf16x8*)qrow; p.qf1 = *(const bf16x8*)(qrow + 32); return p;
}
__device__ __forceinline__ void dsa_query(const bf16* proj, const LAS float* gqn, const DsaPre& pre, bf16* ob, LAS unsigned char* wl, int b, int t, int lane) {
    int i16 = lane & 15, g = lane >> 4, l3 = lane >> 3;
    asm volatile("" : "+v"(i16), "+v"(g), "+v"(l3));
    const int nsel = (t + 1) < 256 ? (t + 1) : 256;
    LAS unsigned char* lst = wl + 3 * DS_VBUF;
    *(LAS v2u*)(lst + lane * 8) = pre.li;
    bf16x8 qf0, qf1;
    {
        const v4u w0 = __builtin_bit_cast(v4u, pre.qf0), w1 = __builtin_bit_cast(v4u, pre.qf1);
        float ss = (bflo(w0.x) * bflo(w0.x) + bfhi(w0.x) * bfhi(w0.x)) + (bflo(w0.y) * bflo(w0.y) + bfhi(w0.y) * bfhi(w0.y)) + (bflo(w0.z) * bflo(w0.z) + bfhi(w0.z) * bfhi(w0.z)) + (bflo(w0.w) * bflo(w0.w) + bfhi(w0.w) * bfhi(w0.w));
        ss += (bflo(w1.x) * bflo(w1.x) + bfhi(w1.x) * bfhi(w1.x)) + (bflo(w1.y) * bflo(w1.y) + bfhi(w1.y) * bfhi(w1.y)) + (bflo(w1.z) * bflo(w1.z) + bfhi(w1.z) * bfhi(w1.z)) + (bflo(w1.w) * bflo(w1.w) + bfhi(w1.w) * bfhi(w1.w));
        ss += __shfl_xor(ss, 16); ss += __shfl_xor(ss, 32);
        const float r = (0.125f * LOG2E) / sqrtf(ss * (1.f / 64.f) + RMS_EPS);
        const f32x4 ga = *(const LAS f32x4*)(gqn + 8 * g), gb = *(const LAS f32x4*)(gqn + 8 * g + 4), gc = *(const LAS f32x4*)(gqn + 32 + 8 * g), gd = *(const LAS f32x4*)(gqn + 32 + 8 * g + 4);
        v4u o0, o1;
        o0.x = cvt_pk_bf16(bflo(w0.x) * r * ga.x, bfhi(w0.x) * r * ga.y); o0.y = cvt_pk_bf16(bflo(w0.y) * r * ga.z, bfhi(w0.y) * r * ga.w);
        o0.z = cvt_pk_bf16(bflo(w0.z) * r * gb.x, bfhi(w0.z) * r * gb.y); o0.w = cvt_pk_bf16(bflo(w0.w) * r * gb.z, bfhi(w0.w) * r * gb.w);
        o1.x = cvt_pk_bf16(bflo(w1.x) * r * gc.x, bfhi(w1.x) * r * gc.y); o1.y = cvt_pk_bf16(bflo(w1.y) * r * gc.z, bfhi(w1.y) * r * gc.w);
        o1.z = cvt_pk_bf16(bflo(w1.z) * r * gd.x, bfhi(w1.z) * r * gd.y); o1.w = cvt_pk_bf16(bflo(w1.w) * r * gd.z, bfhi(w1.w) * r * gd.w);
        qf0 = __builtin_bit_cast(bf16x8, o0); qf1 = __builtin_bit_cast(bf16x8, o1);
    }
    const float slope2 = exp2f(-(float)(17 + i16) * 0.25f) * LOG2E;
    const bf16* pb = proj + (size_t)(b * SEQ) * NPROJP;
    LAS const unsigned short* lq = (LAS const unsigned short*)lst + i16;
    LAS const unsigned char* lg4 = lst + 8 * g;
    LAS const unsigned short* lv = (LAS const unsigned short*)lst + l3;
    LAS unsigned char* vwr = wl + l3 * 160 + (lane & 7) * 16;
    LAS const unsigned char* vrd = wl + (4 * g + (i16 >> 2)) * 160 + 8 * (i16 & 3);
    asm volatile("" : "+v"(lq), "+v"(lg4), "+v"(lv), "+v"(vwr), "+v"(vrd));
    LDS_WAIT();
    bf16x8 kA[4], kB[4], kC[4]; v4u vA[4], vB[4], vC[4];
#define DSA_ISSUE(c, KF, VV) do { \
        _Pragma("unroll") for (int tt = 0; tt < 2; ++tt) { const int pos = 32 * (c) + 16 * tt + i16; int kidx = lq[32 * (c) + 16 * tt]; kidx = (pos < nsel) ? kidx : 0; \
            const bf16* krow = pb + (size_t)kidx * NPROJP + C_KB + 8 * g; KF[2 * tt] = *(const bf16x8*)krow; KF[2 * tt + 1] = *(const bf16x8*)(krow + 32); } \
        _Pragma("unroll") for (int i = 0; i < 4; ++i) { const int pos = 32 * (c) + 8 * i + l3; int vidx = lv[32 * (c) + 8 * i]; vidx = (pos < nsel) ? vidx : 0; \
            VV[i] = *(const v4u*)(pb + (size_t)vidx * NPROJP + C_VB + (lane & 7) * 8); } } while (0)
    float m = NEGBIG, lsum = 0.f;
    f32x4 o[4];
#pragma unroll
    for (int dt = 0; dt < 4; ++dt) o[dt] = (f32x4){0.f, 0.f, 0.f, 0.f};
#define DSA_CHUNK(c, KF, VV, buf) do { \
        _Pragma("unroll") for (int i = 0; i < 4; ++i) *(LAS v4u*)(vwr + (buf) * DS_VBUF + 8 * i * 160) = VV[i]; \
        f32x4 s0 = {0.f, 0.f, 0.f, 0.f}, s1 = {0.f, 0.f, 0.f, 0.f}; \
        s0 = __builtin_amdgcn_mfma_f32_16x16x32_bf16(KF[0], qf0, s0, 0, 0, 0); s0 = __builtin_amdgcn_mfma_f32_16x16x32_bf16(KF[1], qf1, s0, 0, 0, 0); \
        s1 = __builtin_amdgcn_mfma_f32_16x16x32_bf16(KF[2], qf0, s1, 0, 0, 0); s1 = __builtin_amdgcn_mfma_f32_16x16x32_bf16(KF[3], qf1, s1, 0, 0, 0); \
        { const v2u i4 = *(const LAS v2u*)(lg4 + 64 * (c)), j4 = *(const LAS v2u*)(lg4 + 64 * (c) + 32); const int p0 = 32 * (c) + 4 * g; \
          s0[0] = (p0 + 0 < nsel) ? s0[0] - slope2 * (float)(t - (int)(i4.x & 0xffff)) : NEGBIG; s0[1] = (p0 + 1 < nsel) ? s0[1] - slope2 * (float)(t - (int)(i4.x >> 16)) : NEGBIG; \
          s0[2] = (p0 + 2 < nsel) ? s0[2] - slope2 * (float)(t - (int)(i4.y & 0xffff)) : NEGBIG; s0[3] = (p0 + 3 < nsel) ? s0[3] - slope2 * (float)(t - (int)(i4.y >> 16)) : NEGBIG; \
          s1[0] = (p0 + 16 < nsel) ? s1[0] - slope2 * (float)(t - (int)(j4.x & 0xffff)) : NEGBIG; s1[1] = (p0 + 17 < nsel) ? s1[1] - slope2 * (float)(t - (int)(j4.x >> 16)) : NEGBIG; \
          s1[2] = (p0 + 18 < nsel) ? s1[2] - slope2 * (float)(t - (int)(j4.y & 0xffff)) : NEGBIG; s1[3] = (p0 + 19 < nsel) ? s1[3] - slope2 * (float)(t - (int)(j4.y >> 16)) : NEGBIG; } \
        float cm = fmaxf(fmaxf(fmaxf(s0[0], s0[1]), fmaxf(s0[2], s0[3])), fmaxf(fmaxf(s1[0], s1[1]), fmaxf(s1[2], s1[3]))); \
        cm = fmaxf(cm, __shfl_xor(cm, 16)); cm = fmaxf(cm, __shfl_xor(cm, 32)); \
        const float mn = fmaxf(m, cm), al = fast_exp2(m - mn); m = mn; \
        _Pragma("unroll") for (int r = 0; r < 4; ++r) { s0[r] = fast_exp2(s0[r] - mn); s1[r] = fast_exp2(s1[r] - mn); } \
        lsum = lsum * al + ((s0[0] + s0[1]) + (s0[2] + s0[3])) + ((s1[0] + s1[1]) + (s1[2] + s1[3])); \
        _Pragma("unroll") for (int dt = 0; dt < 4; ++dt) o[dt] = o[dt] * al; \
        v4u pw; pw.x = cvt_pk_bf16(s0[0], s0[1]); pw.y = cvt_pk_bf16(s0[2], s0[3]); pw.z = cvt_pk_bf16(s1[0], s1[1]); pw.w = cvt_pk_bf16(s1[2], s1[3]); \
        const bf16x8 pbv = __builtin_bit_cast(bf16x8, pw); \
        LDS_WAIT(); \
        _Pragma("unroll") for (int dt = 0; dt < 4; ++dt) { \
            const s16x4 vl = tr_read(vrd + (buf) * DS_VBUF + 32 * dt), vh = tr_read(vrd + (buf) * DS_VBUF + 16 * 160 + 32 * dt); \
            const bf16x8 vf = (bf16x8){vl[0], vl[1], vl[2], vl[3], vh[0], vh[1], vh[2], vh[3]}; \
            o[dt] = __builtin_amdgcn_mfma_f32_16x16x32_bf16(vf, pbv, o[dt], 0, 0, 0); } \
        __builtin_amdgcn_sched_barrier(0); } while (0)
    DSA_ISSUE(0, kA, vA); DSA_ISSUE(1, kB, vB);
    DSA_ISSUE(2, kC, vC); DSA_CHUNK(0, kA, vA, 0);
    DSA_ISSUE(3, kA, vA); DSA_CHUNK(1, kB, vB, 1);
    DSA_ISSUE(4, kB, vB); DSA_CHUNK(2, kC, vC, 2);
    DSA_ISSUE(5, kC, vC); DSA_CHUNK(3, kA, vA, 0);
    DSA_ISSUE(6, kA, vA); DSA_CHUNK(4, kB, vB, 1);
    DSA_ISSUE(7, kB, vB); DSA_CHUNK(5, kC, vC, 2);
    DSA_CHUNK(6, kA, vA, 0);
    DSA_CHUNK(7, kB, vB, 1);
#undef DSA_ISSUE
#undef DSA_CHUNK
    lsum += __shfl_xor(lsum, 16); lsum += __shfl_xor(lsum, 32);
    const float rl = fast_rcp(lsum);
    bf16* orow = ob + (size_t)(b * SEQ + t) * 1024 + i16 * 64 + 4 * g;
#pragma unroll
    for (int dt = 0; dt < 4; ++dt) { v2u w; w.x = cvt_pk_bf16(o[dt][0] * rl, o[dt][1] * rl); w.y = cvt_pk_bf16(o[dt][2] * rl, o[dt][3] * rl); *(v2u*)(orow + 16 * dt) = w; }
}

constexpr int RT_PART = 0, RT_XS = 0, RT_XSW = 32 * 272, RT_RS = 73728, RT_LG = RT_RS + 128;
__device__ __forceinline__ void router_unit(KArgs& a, LAS unsigned char* lds, int u, int tid, int lane, int wave) {
    const bf16* x2 = (const bf16*)(a.ws + WS_X2); const float* modf = (const float*)(a.ws + WS_MODF); const float* g2 = a.in[I_LN2G];
    bf16* H2 = (bf16*)(a.ws + WS_H);
    const bf16* wrh = (const bf16*)(a.ws + WS_WRH); const bf16* wrl = (const bf16*)(a.ws + WS_WRL);
    const int row0 = u * 32, b = row0 >> 11;
    LAS float* rs = (LAS float*)(lds + RT_RS);
    {
        const int m = row0 + 4 * wave;
        const v4u* xr = (const v4u*)(x2 + (size_t)m * DM) + lane;
        v4u v[4][4]; float ss[4];
#pragma unroll
        for (int t4 = 0; t4 < 4; ++t4)
#pragma unroll
            for (int j = 0; j < 4; ++j) v[t4][j] = xr[(size_t)t4 * (DM / 8) + 64 * j];
#pragma unroll
        for (int t4 = 0; t4 < 4; ++t4) { float s_ = 0.f;
#pragma unroll
            for (int j = 0; j < 4; ++j) { const v4u w = v[t4][j];
                s_ += (bflo(w.x) * bflo(w.x) + bfhi(w.x) * bfhi(w.x)) + (bflo(w.y) * bflo(w.y) + bfhi(w.y) * bfhi(w.y)) + (bflo(w.z) * bflo(w.z) + bfhi(w.z) * bfhi(w.z)) + (bflo(w.w) * bflo(w.w) + bfhi(w.w) * bfhi(w.w)); }
            ss[t4] = 1.f / sqrtf(wave_sum(s_) * (1.f / DM) + RMS_EPS); }
        if (lane == 0) { rs[4 * wave] = ss[0]; rs[4 * wave + 1] = ss[1]; rs[4 * wave + 2] = ss[2]; rs[4 * wave + 3] = ss[3]; }
        v4u* o8 = (v4u*)(H2 + (size_t)m * DM) + lane;
#pragma unroll
        for (int j = 0; j < 4; ++j) { const int k = 8 * lane + 512 * j;
            const f32x4 fk0 = *(const f32x4*)(g2 + k) * (*(const f32x4*)(modf + b * 12288 + 8192 + k) + 1.f), fk1 = *(const f32x4*)(g2 + k + 4) * (*(const f32x4*)(modf + b * 12288 + 8192 + k + 4) + 1.f);
            const f32x4 sh0 = *(const f32x4*)(modf + b * 12288 + 6144 + k), sh1 = *(const f32x4*)(modf + b * 12288 + 6144 + k + 4);
#pragma unroll
            for (int t4 = 0; t4 < 4; ++t4) { const v4u w = v[t4][j]; const float r = ss[t4];
                v4u o; o.x = cvt_pk_bf16(bflo(w.x) * r * fk0.x + sh0.x, bfhi(w.x) * r * fk0.y + sh0.y); o.y = cvt_pk_bf16(bflo(w.y) * r * fk0.z + sh0.z, bfhi(w.y) * r * fk0.w + sh0.w);
                o.z = cvt_pk_bf16(bflo(w.z) * r * fk1.x + sh1.x, bfhi(w.z) * r * fk1.y + sh1.y); o.w = cvt_pk_bf16(bflo(w.w) * r * fk1.z + sh1.z, bfhi(w.w) * r * fk1.w + sh1.w);
                o8[(size_t)t4 * (DM / 8) + 64 * j] = o; } }
    }
    {
        const bf16* xg = x2 + (size_t)(row0 + (lane >> 4)) * DM + wave * 256 + 8 * (lane & 15);
        v4u xv[8];
#pragma unroll
        for (int i = 0; i < 8; ++i) xv[i] = *(const v4u*)(xg + (size_t)(4 * i) * DM);
        __syncthreads();
        const int r32 = lane & 31, hh = lane >> 5;
        const float rst = rs[r32];
        LAS unsigned char* xs = lds + RT_XS + wave * RT_XSW;
        const bf16* wrf = (const bf16*)(a.ws + WS_WRH);
        f32x16 acc0 = {}, acc1 = {};
#pragma unroll 1
        for (int ch = 0; ch < 2; ++ch) {
#pragma unroll
            for (int i = 0; i < 8; ++i) *(LAS v4u*)(xs + (4 * i + (lane >> 4)) * 272 + (lane & 15) * 16) = xv[i];
            if (ch < 1) {
#pragma unroll
                for (int i = 0; i < 8; ++i) xv[i] = *(const v4u*)(xg + (size_t)(4 * i) * DM + 128 * (ch + 1));
            }
            LDS_WAIT();
#pragma unroll
            for (int ks = 0; ks < 8; ++ks) {
                const int k = wave * 256 + 128 * ch + 16 * ks + 8 * hh;
                const v4u xw = *(const LAS v4u*)(xs + r32 * 272 + (16 * ks + 8 * hh) * 2);
                const f32x4 xa = {bflo(xw.x), bfhi(xw.x), bflo(xw.y), bfhi(xw.y)}, xb = {bflo(xw.z), bfhi(xw.z), bflo(xw.w), bfhi(xw.w)};
                const f32x4 ga = *(const f32x4*)(g2 + k), gb = *(const f32x4*)(g2 + k + 4);
                const f32x4 sca = *(const f32x4*)(modf + b * 12288 + 8192 + k), scb = *(const f32x4*)(modf + b * 12288 + 8192 + k + 4);
                const f32x4 sha = *(const f32x4*)(modf + b * 12288 + 6144 + k), shb = *(const f32x4*)(modf + b * 12288 + 6144 + k + 4);
                const f32x4 ha = xa * rst * (ga * (sca + 1.f)) + sha, hb = xb * rst * (gb * (scb + 1.f)) + shb;
                v4u hi; hi.x = cvt_pk_bf16(ha.x, ha.y); hi.y = cvt_pk_bf16(ha.z, ha.w); hi.z = cvt_pk_bf16(hb.x, hb.y); hi.w = cvt_pk_bf16(hb.z, hb.w);
                v4u lo; lo.x = cvt_pk_bf16(ha.x - bflo(hi.x), ha.y - bfhi(hi.x)); lo.y = cvt_pk_bf16(ha.z - bflo(hi.y), ha.w - bfhi(hi.y));
                lo.z = cvt_pk_bf16(hb.x - bflo(hi.z), hb.y - bfhi(hi.z)); lo.w = cvt_pk_bf16(hb.z - bflo(hi.w), hb.w - bfhi(hi.w));
                const bf16x8 ah = __builtin_bit_cast(bf16x8, hi), al = __builtin_bit_cast(bf16x8, lo);
                const bf16* wf = wrf + ((size_t)((wave * 16 + 8 * ch + ks) * 4) * 64 + lane) * 8;
                const bf16x8 bh0 = *(const bf16x8*)wf, bl0 = *(const bf16x8*)(wf + 512), bh1 = *(const bf16x8*)(wf + 1024), bl1 = *(const bf16x8*)(wf + 1536);
                acc0 = __builtin_amdgcn_mfma_f32_32x32x16_bf16(al, bh0, acc0, 0, 0, 0); acc0 = __builtin_amdgcn_mfma_f32_32x32x16_bf16(ah, bl0, acc0, 0, 0, 0); acc0 = __builtin_amdgcn_mfma_f32_32x32x16_bf16(ah, bh0, acc0, 0, 0, 0);
                acc1 = __builtin_amdgcn_mfma_f32_32x32x16_bf16(al, bh1, acc1, 0, 0, 0); acc1 = __builtin_amdgcn_mfma_f32_32x32x16_bf16(ah, bl1, acc1, 0, 0, 0); acc1 = __builtin_amdgcn_mfma_f32_32x32x16_bf16(ah, bh1, acc1, 0, 0, 0);
            }
            LDS_WAIT();
        }
        __syncthreads();
        LAS float* part = (LAS float*)(lds + RT_PART) + wave * 2048;
#pragma unroll
        for (int r = 0; r < 16; ++r) { const int tkn = crow(r, hh); part[tkn * 64 + r32] = acc0[r]; part[tkn * 64 + 32 + r32] = acc1[r]; }
    }
    __syncthreads();
    LAS float* lg = (LAS float*)(lds + RT_LG);
    for (int o = tid; o < 32 * 36; o += 512) { const int t2 = o / 36, j = o % 36; float s = 0.f;
#pragma unroll
        for (int q = 0; q < 8; ++q) s += ((LAS float*)(lds + RT_PART))[q * 2048 + t2 * 64 + j];
        lg[t2 * 36 + j] = s + ((j < 32) ? a.in[I_BEXP][j] : a.in[I_BGRP][j - 32]); }
    __syncthreads();
    if (tid < 32) {
        const LAS float* l = lg + tid * 36;
        int gi = 0; float gm = l[32];
#pragma unroll
        for (int j = 1; j < 4; ++j) if (l[32 + j] > gm) { gm = l[32 + j]; gi = j; }
        float gs = 0.f;
#pragma unroll
        for (int j = 0; j < 4; ++j) gs += __expf(l[32 + j] - gm);
        const float pg = 1.f / gs;
        float e[8];
#pragma unroll
        for (int j = 0; j < 8; ++j) e[j] = (gi == 0) ? l[j] : (gi == 1) ? l[8 + j] : (gi == 2) ? l[16 + j] : l[24 + j];
        int i1 = 0; float m1 = e[0];
#pragma unroll
        for (int j = 1; j < 8; ++j) if (e[j] > m1) { m1 = e[j]; i1 = j; }
        int i2 = -1; float m2 = -3.0e38f;
#pragma unroll
        for (int j = 0; j < 8; ++j) if (j != i1 && e[j] > m2) { m2 = e[j]; i2 = j; }
        const float p2 = __expf(m2 - m1), inv = 1.f / (1.f + p2);
        const float c1 = pg * inv, c2 = pg * p2 * inv;
        const int e1 = gi * 8 + i1, e2 = gi * 8 + i2, m = row0 + tid;
        LAS unsigned* lcnt = (LAS unsigned*)(lds + RT_LG + 32 * 36 * 4);
        lcnt[tid] = 0u;
        LDS_WAIT(); __builtin_amdgcn_wave_barrier();
        const unsigned lr1 = __hip_atomic_fetch_add(lcnt + e1, 1u, __ATOMIC_RELAXED, __HIP_MEMORY_SCOPE_WORKGROUP);
        const unsigned lr2 = __hip_atomic_fetch_add(lcnt + e2, 1u, __ATOMIC_RELAXED, __HIP_MEMORY_SCOPE_WORKGROUP);
        LDS_WAIT(); __builtin_amdgcn_wave_barrier();
        unsigned* ecnt = (unsigned*)(a.ws + WS_CTL) + CW_ECNT;
        const unsigned mine = lcnt[tid];
        const unsigned gb = mine ? atomicAdd(ecnt + tid * 32, mine) : 0u;
        lcnt[32 + tid] = gb;
        LDS_WAIT(); __builtin_amdgcn_wave_barrier();
        const int pos1 = (int)(lcnt[32 + e1] + lr1), pos2 = (int)(lcnt[32 + e2] + lr2);
        int* rowtok = (int*)(a.ws + WS_ROWTOK); float* roww = (float*)(a.ws + WS_ROWW);
        rowtok[e1 * ECAP + pos1] = m; roww[e1 * ECAP + pos1] = c1;
        rowtok[e2 * ECAP + pos2] = m; roww[e2 * ECAP + pos2] = c2;
        int* tokinfo = (int*)(a.ws + WS_TOK) + m * 4;
        tokinfo[0] = e1; tokinfo[1] = pos1; tokinfo[2] = e2; tokinfo[3] = pos2;
    }
    __syncthreads();
}
__device__ __forceinline__ void moe_table(KArgs& a, LAS unsigned char* lds, int tid) {
    LAS int* tb = (LAS int*)(lds + MOE_TB_OFF); LAS int* cn = tb + 40;
    if (tid < 64) {
        const int e = tid & 31;
        const unsigned* ecnt = (const unsigned*)(a.ws + WS_CTL) + CW_ECNT;
        const int c = (tid < 32) ? (int)__hip_atomic_load(ecnt + e * 32, RLX_AGENT) : 0;
        const int t = (c + 255) >> 8;
        int sc = t;
#pragma unroll
        for (int d = 1; d < 32; d <<= 1) { const int v = __shfl_up(sc, d); sc += (tid >= d) ? v : 0; }
        if (tid < 32) { tb[e] = sc - t; cn[e] = c; if (e == 31) tb[NEXP] = sc; }
    }
    __syncthreads();
}


namespace wsg {
constexpr int BK = 64, A_STR = 144, B_STR = 288, A_BYTES = 256 * A_STR, B_BYTES = 64 * B_STR, BUF_BYTES = A_BYTES + B_BYTES;
struct Unit { int e, mt, pn, tile; };
struct Order {
    const LAS int* tb; int npn, G, c, total;
    __device__ __forceinline__ bool next(int i, Unit& u) const {
        const int L = i * G + c; if (L >= total) return false;
        int e = 0;
#pragma unroll
        for (int j = 1; j < NEXP; ++j) e += (L >= tb[j] * npn) ? 1 : 0;
        const int idx = L - tb[e] * npn, te = tb[e + 1] - tb[e];
        u.e = e; u.pn = idx / te; u.mt = idx - u.pn * te; u.tile = tb[e] + u.mt; return true;
    }
};
constexpr int A3_BYTES = 32768, A3_RING = 3 * A3_BYTES, B3_OFF = A3_RING;
__device__ __forceinline__ void glds16(const void* gsrc, unsigned lds_dst) { unsigned keep;
    asm volatile("s_mov_b32 %0, m0\n\ts_mov_b32 m0, %2\n\ts_nop 0\n\tglobal_load_lds_dwordx4 %1, off\n\ts_mov_b32 m0, %0" : "=&s"(keep) : "v"(gsrc), "s"(lds_dst) : "memory"); }
template <bool GU>
__device__ __forceinline__ void ws_gemm3(LAS unsigned char* lds, KArgs& a, const Order& S, const LAS int* cnt) {
    const int tid = threadIdx.x, wid = __builtin_amdgcn_readfirstlane(tid >> 6), lane = tid & 63;
    constexpr int K = GU ? DM : DEXP, NK = K / BK, LDW = GU ? DEXP : DM;
    const int nun = (S.total > S.c) ? (S.total - S.c + S.G - 1) / S.G : 0;
    if (nun == 0) return;
    const int total = nun * NK;
    if (wid >= 4) {
        const int p = wid - 4;
        const bf16* Abase = (const bf16*)(a.ws + (GU ? WS_H : WS_ACT));
        const int* rowtok = (const int*)(a.ws + WS_ROWTOK);
        const int k0 = 4 * (2 * p + (lane >> 5)), c4 = 4 * (lane & 31);
        const int kp0 = (k0 & ~12) | ((k0 & 4) << 1) | ((k0 & 8) >> 1);
        Unit UA, UW; int luA = 0, ktA = 0, luW = 0, ktW = 0; (void)S.next(0, UA); UW = UA;
        unsigned aoff[8]; const float* wsrc; int nvalA = 256;
        unsigned tokN[8];
#define WS3_FETCH_TOK(U_) do { _Pragma("unroll") for (int i = 0; i < 8; ++i) { const int row = 8 * (4 * i + p) + (lane >> 3); const int local = (U_).mt * 256 + row; \
            tokN[i] = (local < cnt[(U_).e]) ? (unsigned)rowtok[(U_).e * ECAP + local] : 0u; } } while (0)
#define WS3_SETUP_A() do { nvalA = cnt[UA.e] - UA.mt * 256; \
            _Pragma("unroll") for (int i = 0; i < 8; ++i) { const int row = 8 * (4 * i + p) + (lane >> 3); const unsigned cc = (unsigned)((lane & 7) ^ ((row >> 1) & 7)); \
            if (GU) aoff[i] = tokN[i] * (unsigned)(K * 2) + cc * 16u; \
            else aoff[i] = (unsigned)(UA.tile * 256 + row) * (unsigned)(K * 2) + cc * 16u; } \
            if (GU && luA + 1 < nun) { Unit Un_; (void)S.next(luA + 1, Un_); WS3_FETCH_TOK(Un_); } } while (0)
#define WS3_SETUP_W() do { if (GU) wsrc = ((c4 < 64) ? a.in[I_WGU] : a.in[I_WUP]) + (size_t)UW.e * DM * DEXP + (64 * UW.pn + (c4 & 63)) + (size_t)k0 * LDW; \
            else wsrc = a.in[I_WDN] + (size_t)UW.e * DEXP * DM + (128 * UW.pn + c4) + (size_t)k0 * LDW; } while (0)
        if (GU) WS3_FETCH_TOK(UA);
        WS3_SETUP_A(); WS3_SETUP_W();
        f32x4 wvA[8], wvB[8], wvC[8];
#define WS3_ISSUE_A(slot) do { _Pragma("unroll") for (int i = 0; i < 8; ++i) if (8 * (4 * i + p) < nvalA)   \
                glds16((const char*)Abase + aoff[i] + ktA * 128, (unsigned)__builtin_amdgcn_readfirstlane((slot) * A3_BYTES + (4 * i + p) * 1024)); \
            if (++ktA == NK) { if (luA + 1 < nun) { ktA = 0; ++luA; (void)S.next(luA, UA); WS3_SETUP_A(); } else ktA = NK - 1; } } while (0)
#define WS3_ISSUE_W(WV) do { _Pragma("unroll") for (int i = 0; i < 4; ++i) { \
                WV[i] = *(const f32x4*)(wsrc + (size_t)(ktW * 64 + i) * LDW); \
                WV[4 + i] = *(const f32x4*)(wsrc + (size_t)(ktW * 64 + 32 + i) * LDW); } \
            if (++ktW == NK) { if (luW + 1 < nun) { ktW = 0; ++luW; (void)S.next(luW, UW); WS3_SETUP_W(); } else ktW = NK - 1; } } while (0)
#define WS3_WRITE_W(buf, WV) do { \
            LAS unsigned char* bb_ = lds + B3_OFF + (buf) * B_BYTES; \
            _Pragma("unroll") for (int i = 0; i < 4; ++i) { v2u w_; w_.x = cvt_pk_bf16(WV[i].x, WV[i].y); w_.y = cvt_pk_bf16(WV[i].z, WV[i].w); *(LAS v2u*)(bb_ + (kp0 + i) * B_STR + (lane & 31) * 8) = w_; \
                v2u x_; x_.x = cvt_pk_bf16(WV[4 + i].x, WV[4 + i].y); x_.y = cvt_pk_bf16(WV[4 + i].z, WV[4 + i].w); *(LAS v2u*)(bb_ + (32 + kp0 + i) * B_STR + (lane & 31) * 8) = x_; } } while (0)
#define WS3_BAR() asm volatile("s_waitcnt vmcnt(16) lgkmcnt(0)\n\ts_barrier" ::: "memory")
        WS3_ISSUE_W(wvA); WS3_ISSUE_A(0); WS3_ISSUE_W(wvB); WS3_ISSUE_A(1); WS3_ISSUE_W(wvC);
        WS3_WRITE_W(0, wvA); WS3_BAR();
#define WS3_SUB(j, slotA, WVI, WVW) do { WS3_ISSUE_A(slotA); WS3_ISSUE_W(WVI); WS3_WRITE_W(((j) + 1) & 1, WVW); WS3_BAR(); } while (0)
        int j = 0;
#pragma unroll 1
        for (; j + 3 <= total; j += 3) {
            WS3_SUB(j, 2, wvA, wvB);
            WS3_SUB(j + 1, 0, wvB, wvC);
            WS3_SUB(j + 2, 1, wvC, wvA);
        }
        if (j < total) { WS3_SUB(j, 2, wvA, wvB); if (j + 1 < total) WS3_SUB(j + 1, 0, wvB, wvC); }
        asm volatile("s_waitcnt vmcnt(0)" ::: "memory");
#undef WS3_SETUP_A
#undef WS3_FETCH_TOK
#undef WS3_SETUP_W
#undef WS3_ISSUE_A
#undef WS3_ISSUE_W
#undef WS3_WRITE_W
#undef WS3_BAR
#undef WS3_SUB
    } else {
        const int fr = lane & 15, g = lane >> 4;
        f32x4 acc[4][8];
#pragma unroll
        for (int m = 0; m < 4; ++m)
#pragma unroll
            for (int n = 0; n < 8; ++n) acc[m][n] = (f32x4){0.f, 0.f, 0.f, 0.f};
        Unit U; int cu = 0, kt = 0; (void)S.next(0, U);
        float rw[4] = {0.f, 0.f, 0.f, 0.f};
#define WS3_FETCH_RW() do { if (GU) { const float* roww_ = (const float*)(a.ws + WS_ROWW); _Pragma("unroll") for (int m = 0; m < 4; ++m) { const int local = U.mt * 256 + 64 * wid + 16 * m + fr; \
            rw[m] = (local < cnt[U.e]) ? roww_[U.e * ECAP + local] : 0.f; } } } while (0)
        WS3_FETCH_RW();
        __syncthreads();
        int slot = 0;
#pragma unroll 1
        for (int s = 0; s < total; ++s) {
            LAS const unsigned char* ba = lds + slot * A3_BYTES; LAS const unsigned char* bb = lds + B3_OFF + (s & 1) * B_BYTES;
            {
                bf16x8 af[4], bq[4], bn[4];
#define WS3_LDA(ks) do { _Pragma("unroll") for (int m = 0; m < 4; ++m) { const int row = 64 * wid + 16 * m + fr; af[m] = *(const LAS bf16x8*)(ba + row * 128 + (((4 * (ks) + g) ^ ((row >> 1) & 7)) << 4)); } } while (0)
#define WS3_LDB(dst, ks, h) do { _Pragma("unroll") for (int n = 0; n < 4; ++n) { LAS const unsigned char* pp = bb + (32 * (ks) + 4 * (g & 1) + 16 * (g >> 1) + (fr >> 2)) * B_STR + (16 * (4 * (h) + n) + 4 * (fr & 3)) * 2; \
                    const s16x4 vl = tr_read(pp), vh = tr_read(pp + 8 * B_STR); dst[n] = (bf16x8){vl[0], vl[1], vl[2], vl[3], vh[0], vh[1], vh[2], vh[3]}; } } while (0)
#define WS3_MMA(src, h) do { _Pragma("unroll") for (int m = 0; m < 4; ++m) _Pragma("unroll") for (int n = 0; n < 4; ++n) acc[m][4 * (h) + n] = __builtin_amdgcn_mfma_f32_16x16x32_bf16(src[n], af[m], acc[m][4 * (h) + n], 0, 0, 0); } while (0)
                WS3_LDA(0); WS3_LDB(bq, 0, 0);
                WS3_LDB(bn, 0, 1); WS3_MMA(bq, 0);
                WS3_LDB(bq, 1, 0); WS3_MMA(bn, 1);
                WS3_LDA(1);
                WS3_LDB(bn, 1, 1); WS3_MMA(bq, 0);
                WS3_MMA(bn, 1);
#undef WS3_LDA
#undef WS3_LDB
#undef WS3_MMA
            }
            slot = (slot == 2) ? 0 : slot + 1;
            if (++kt == NK) {
                const size_t prow0 = (size_t)U.tile * 256 + 64 * wid + fr;
                if (GU) {
                    bf16* act = (bf16*)(a.ws + WS_ACT);
#pragma unroll
                    for (int m = 0; m < 4; ++m) { const float w = rw[m];
#pragma unroll
                        for (int n = 0; n < 4; ++n) { float o[4];
#pragma unroll
                            for (int r = 0; r < 4; ++r) { const float gt = acc[m][n][r]; o[r] = gt * sigmoidf_(gt) * acc[m][n + 4][r] * w; }
                            v2u wv2; wv2.x = cvt_pk_bf16(o[0], o[1]); wv2.y = cvt_pk_bf16(o[2], o[3]);
                            *(v2u*)(act + (prow0 + 16 * m) * DEXP + 64 * U.pn + 16 * n + 4 * g) = wv2; } }
                } else {
                    bf16* Y = (bf16*)(a.ws + WS_Y);
#pragma unroll
                    for (int m = 0; m < 4; ++m)
#pragma unroll
                        for (int q = 0; q < 4; ++q) { v4u w4; w4.x = cvt_pk_bf16(acc[m][2 * q][0], acc[m][2 * q][1]); w4.y = cvt_pk_bf16(acc[m][2 * q][2], acc[m][2 * q][3]);
                            w4.z = cvt_pk_bf16(acc[m][2 * q + 1][0], acc[m][2 * q + 1][1]); w4.w = cvt_pk_bf16(acc[m][2 * q + 1][2], acc[m][2 * q + 1][3]);
                            *(v4u*)(Y + (prow0 + 16 * m) * DM + 128 * U.pn + 32 * g + 8 * q) = w4; }
                }
#pragma unroll
                for (int m = 0; m < 4; ++m)
#pragma unroll
                    for (int n = 0; n < 8; ++n) acc[m][n] = (f32x4){0.f, 0.f, 0.f, 0.f};
                kt = 0; ++cu; if (cu < nun) { (void)S.next(cu, U); WS3_FETCH_RW(); }
            }
            __syncthreads();
        }
    }
#undef WS3_FETCH_RW
    __syncthreads();
}
}

__device__ __forceinline__ int fresh_tid() { int t = threadIdx.x; asm volatile("" : "+v"(t)); return t; }
#define PH_IDS const int tid = fresh_tid(), lane = tid & 63, wave = __builtin_amdgcn_readfirstlane(tid >> 6); (void)lane; (void)wave; KArgs& args = *kargs(); unsigned char* ws = args.ws; (void)ws
constexpr int NPHASE = 11;
__global__ void __launch_bounds__(NWAVES * 64, 2) mk_fwd(Args args_) {
    extern __shared__ __attribute__((aligned(16))) unsigned char lds_raw[];
    LAS unsigned char* lds = (LAS unsigned char*)lds_raw;
    volatile LAS unsigned* MISC = (volatile LAS unsigned*)(lds + MISC_OFF);
    const int tid0 = threadIdx.x;
    const int G = gridDim.x; const int bx = blockIdx.x; const int vcu = (G % 8 == 0) ? (bx % 8) * (G / 8) + bx / 8 : bx;
    gu32* ctl = (gu32*)(args_.ws + WS_CTL);
    for (int u = tid0; u < (LDS_BYTES - LDSCTL_OFF) / 4; u += NWAVES * 64) ((LAS unsigned*)(lds + LDSCTL_OFF))[u] = 0u;
    __syncthreads();
    XcdBarrier bar; bar.bar = (unsigned*)ctl + CW_BAR; bar.x = 0; bar.st = nullptr;
    if (!MK_LAUNCH_PER_PHASE) bar = xcd_barrier_post((unsigned*)ctl + CW_BAR, MISC + 8);
    const int lo = args_.ph_lo, hi = args_.ph_hi;
#ifndef PH_MASK
#define PH_MASK 0x7ff
#endif
#ifndef PH_REP
#define PH_REP 0
#endif
#define NREP(k) (1 + ((PH_REP >> (k)) & 1))
#define IN(k) (((PH_MASK >> (k)) & 1) && lo <= (k) && (k) < hi)
#define SEAM(k) do { if (IN(k) && IN((k) + 1)) { if (!MK_LAUNCH_PER_PHASE) xcd_barrier(bar); } } while (0)
    if (IN(0)) { PH_IDS; for (int rep = 0; rep < NREP(0); ++rep) { p0_prologue(args, lds, vcu, G, tid, lane, wave); if (rep) xcd_barrier(bar); } }
    SEAM(0);
    if (IN(1)) { PH_IDS; for (int rep = 0; rep < NREP(1); ++rep) { p1_norm1(args, lds, vcu, G, tid, lane, wave); if (rep) xcd_barrier(bar); } }
    SEAM(1);
    if (IN(2)) { PH_IDS;
        pg8::Gemm g{(const bf16*)(ws + WS_H), nullptr, (const bf16*)(ws + WS_WTIN), nullptr, DM};
        pg8::StaticOrder S; S.init(MTOK, NPROJP, G, bx);
        pg8::EpiStore E{(bf16*)(ws + WS_PROJ), NPROJP};
        for (int rep = 0; rep < NREP(2); ++rep) { pg8::gemm_phase<pg8::EpiStore, pg8::StaticOrder, true, false>(lds, g, S, E); if (rep) xcd_barrier(bar); }
    }
    SEAM(2);
    if (IN(3)) { const int tid = threadIdx.x, lane = tid & 63, wave = __builtin_amdgcn_readfirstlane(tid >> 6); KArgs& args = *kargs(); unsigned char* ws = args.ws;
        bf16* PROJ = (bf16*)(ws + WS_PROJ);
        if (wave >= 4) __builtin_amdgcn_s_setprio(1);
        prep_norms(args, vcu, G, lane, wave);
        if (!(DBG_SKIP & 2)) {
            unsigned short* idxo = (unsigned short*)(ws + WS_IDX);
            for (int rep = 0; rep < NREP(3); ++rep) { for (int i = vcu; i < 512; i += G) { const int u = (i < 256) ? i : 767 - i;
                indexer_unit(PROJ, idxo, lds, (u & 3) * 128 + (u >> 2), tid, lane, wave); } if (rep) xcd_barrier(bar); }
        }
    }
    SEAM(3);
    if (IN(4)) { PH_IDS;
        bf16* PROJ = (bf16*)(ws + WS_PROJ); bf16* OA = (bf16*)(ws + WS_OA); bf16* OB = (bf16*)(ws + WS_OB);
        LAS float* gql = (LAS float*)(lds + MISC_OFF + 192);
        if (tid < 128) gql[tid] = (tid < 64) ? args.in[I_DSAQN][tid] : args.in[I_SWAQN][tid - 64];
        __syncthreads();
        if (!(DBG_SKIP & 1)) { for (int rep = 0; rep < NREP(11); ++rep) { for (int u = vcu; u < 256; u += G) swa_unit(PROJ, OA, args.in[I_SINKS], args.in[I_SWAQN], args.in[I_SWAKN], gql + 64, lds, u, tid, lane, wave); if (rep) xcd_barrier(bar); } }
        else { for (size_t i = (size_t)bx * 512 + tid; i < (size_t)MTOK * 1024 / 8; i += (size_t)G * 512) ((v4u*)OA)[i] = (v4u){0u, 0u, 0u, 0u}; }
        if (!(DBG_SKIP & 2)) {
            const unsigned short* idx = (const unsigned short*)(ws + WS_IDX);
            LAS unsigned char* wl = lds + wave * DS_WAVE;
            const int gw = vcu * NWAVES + wave, NGW = G * NWAVES;
            for (int rep = 0; rep < NREP(4); ++rep) {
                int q = gw; int qq = (q & 1) ? (MTOK - 1 - (q >> 1)) : (q >> 1);
                DsaPre pre = dsa_prefetch(PROJ, idx, qq >> 11, qq & 2047, lane);
                for (; q < MTOK; q += NGW) {
                    const DsaPre cur = pre; const int cb = qq >> 11, ct = qq & 2047;
                    const int qn = q + NGW; if (qn < MTOK) { qq = (qn & 1) ? (MTOK - 1 - (qn >> 1)) : (qn >> 1); pre = dsa_prefetch(PROJ, idx, qq >> 11, qq & 2047, lane); }
                    dsa_query(PROJ, gql, cur, OB, wl, cb, ct, lane);
                }
                if (rep) xcd_barrier(bar); }
        } else { for (size_t i = (size_t)bx * 512 + tid; i < (size_t)MTOK * 1024 / 8; i += (size_t)G * 512) ((v4u*)OB)[i] = (v4u){0u, 0u, 0u, 0u}; }
        __syncthreads();
    }
    __builtin_amdgcn_s_setprio(0);
    SEAM(4);
    if (IN(5)) { PH_IDS;
        pg8::Gemm g{(const bf16*)(ws + WS_OA), (const bf16*)(ws + WS_OB), (const bf16*)(ws + WS_WTA), (const bf16*)(ws + WS_WTB), 1024};
        pg8::PairOrder S; S.init(MTOK, DM, G, bx);
        pg8::EpiGate E{(bf16*)(ws + WS_PROJ), (bf16*)(ws + WS_T), (bf16*)(ws + WS_MRG)};
        for (int rep = 0; rep < NREP(5); ++rep) { pg8::gemm_phase<pg8::EpiGate, pg8::PairOrder, true, false>(lds, g, S, E); if (rep) xcd_barrier(bar); }
    }
    SEAM(5);
    if (IN(6)) { PH_IDS;
        pg8::Gemm g{(const bf16*)(ws + WS_MRG), nullptr, (const bf16*)(ws + WS_WTO), nullptr, DM};
        pg8::StaticOrder S; S.init(MTOK, DM, G, bx);
        pg8::EpiOut E{args.in[I_X], (const float*)(ws + WS_MODF), (bf16*)(ws + WS_X2)};
        for (int rep = 0; rep < NREP(6); ++rep) { pg8::gemm_phase<pg8::EpiOut, pg8::StaticOrder, true, false>(lds, g, S, E); if (rep) xcd_barrier(bar); }
    }
    SEAM(6);
    if (IN(7)) { PH_IDS; if (!(DBG_SKIP & 4)) for (int u = vcu; u < 256; u += G) router_unit(args, lds, u, tid, lane, wave); }
    SEAM(7);
    if (IN(8)) { PH_IDS; if (!(DBG_SKIP & 4)) {
        moe_table(args, lds, tid);
        const LAS int* tb = (const LAS int*)(lds + MOE_TB_OFF); const LAS int* cn = tb + 40;
        wsg::Order S{tb, 8, G, vcu, tb[NEXP] * 8};
        for (int rep = 0; rep < NREP(8); ++rep) { wsg::ws_gemm3<true>(lds, args, S, cn); if (rep) xcd_barrier(bar); }
    } }
    SEAM(8);
    if (IN(9)) { PH_IDS; if (!(DBG_SKIP & 4)) {
        if (MK_LAUNCH_PER_PHASE || !IN(8)) moe_table(args, lds, tid);
        const LAS int* tb = (const LAS int*)(lds + MOE_TB_OFF); const LAS int* cn = tb + 40;
        wsg::Order S{tb, 16, G, vcu, tb[NEXP] * 16};
        for (int rep = 0; rep < NREP(9); ++rep) { wsg::ws_gemm3<false>(lds, args, S, cn); if (rep) xcd_barrier(bar); }
    } }
    SEAM(9);
    if (IN(10)) { PH_IDS; if (!(DBG_SKIP & 4)) {
        if (MK_LAUNCH_PER_PHASE || !IN(8)) moe_table(args, lds, tid);
        const LAS int* tb = (const LAS int*)(lds + MOE_TB_OFF);
        const int gw = vcu * NWAVES + wave, NGW = G * NWAVES;
        const float* modf = (const float*)(ws + WS_MODF); const bf16* Y = (const bf16*)(ws + WS_Y); const bf16* X2 = (const bf16*)(ws + WS_X2);
        typedef int i32x4 __attribute__((ext_vector_type(4)));
        const i32x4* tokinfo = (const i32x4*)(ws + WS_TOK);
        i32x4 tnx = (gw < MTOK) ? tokinfo[gw] : (i32x4){0, 0, 0, 0};
        for (int m = gw; m < MTOK; m += NGW) {
            const int b = m >> 11; const i32x4 ti = tnx;
            if (m + NGW < MTOK) tnx = tokinfo[m + NGW];
            const size_t r1 = (size_t)tb[ti[0]] * 256 + ti[1], r2 = (size_t)tb[ti[2]] * 256 + ti[3];
            float* orow = args.out + (size_t)m * DM;
#pragma unroll
            for (int j = 0; j < 4; ++j) { const int kp = 8 * lane + 512 * j;
                const int k = (kp & ~127) + 32 * ((kp >> 3) & 3) + 4 * ((kp >> 5) & 3), k2 = k + 16;
                const v4u y1 = __builtin_nontemporal_load((const v4u*)(Y + r1 * DM + kp)), y2 = __builtin_nontemporal_load((const v4u*)(Y + r2 * DM + kp));
                const f32x4 g0 = *(const f32x4*)(modf + b * 12288 + 10240 + k), g1 = *(const f32x4*)(modf + b * 12288 + 10240 + k2);
                const v2u xa = __builtin_nontemporal_load((const v2u*)(X2 + (size_t)m * DM + k)), xb = __builtin_nontemporal_load((const v2u*)(X2 + (size_t)m * DM + k2));
                f32x4 x0 = {bflo(xa.x), bfhi(xa.x), bflo(xa.y), bfhi(xa.y)}, x1 = {bflo(xb.x), bfhi(xb.x), bflo(xb.y), bfhi(xb.y)};
                x0.x += g0.x * (bflo(y1.x) + bflo(y2.x)); x0.y += g0.y * (bfhi(y1.x) + bfhi(y2.x)); x0.z += g0.z * (bflo(y1.y) + bflo(y2.y)); x0.w += g0.w * (bfhi(y1.y) + bfhi(y2.y));
                x1.x += g1.x * (bflo(y1.z) + bflo(y2.z)); x1.y += g1.y * (bfhi(y1.z) + bfhi(y2.z)); x1.z += g1.z * (bflo(y1.w) + bflo(y2.w)); x1.w += g1.w * (bfhi(y1.w) + bfhi(y2.w));
                __builtin_nontemporal_store(x0, (f32x4*)(orow + k)); __builtin_nontemporal_store(x1, (f32x4*)(orow + k2)); }
        }
    } }
#undef IN
#undef SEAM
}

extern "C" void kernel_launch(void* const* d_in, const int* in_sizes, int n_in, void* d_out, int out_size, void* d_ws, size_t ws_size, hipStream_t stream) {
    static int grid = 0;
    if (grid == 0) {
        if (n_in != 22 || out_size != MTOK * DM || ws_size < WS_END) { fprintf(stderr, "kernel_launch: unexpected shapes (n_in %d, out %d, ws %zu < %zu)\n", n_in, out_size, ws_size, (size_t)WS_END); grid = -1; return; }
        int dev = 0, cus = 0;
        if (hipGetDevice(&dev) != hipSuccess || hipDeviceGetAttribute(&cus, hipDeviceAttributeMultiprocessorCount, dev) != hipSuccess) { grid = -1; return; }
        if (hipFuncSetAttribute((const void*)mk_fwd, hipFuncAttributeMaxDynamicSharedMemorySize, LDS_BYTES) != hipSuccess) { fprintf(stderr, "kernel_launch: hipFuncSetAttribute failed\n"); grid = -1; return; }
        int per_cu = 0;
        if (hipOccupancyMaxActiveBlocksPerMultiprocessor(&per_cu, (const void*)mk_fwd, NWAVES * 64, LDS_BYTES) != hipSuccess || per_cu < 1) fprintf(stderr, "kernel_launch: occupancy query says %d\n", per_cu);
        (void)hipGetLastError();
        grid = cus;
    }
    if (grid < 0) return;
    if (hipMemsetAsync((char*)d_ws + WS_CTL, 0, CTL_ZERO_BYTES, stream) != hipSuccess) { fprintf(stderr, "kernel_launch: memset failed\n"); return; }
    Args a{};
    for (int i = 0; i < 22; ++i) a.in[i] = (const float*)d_in[i];
    a.out = (float*)d_out; a.ws = (unsigned char*)d_ws;
#if MK_LAUNCH_PER_PHASE
    for (int p = 0; p < NPHASE; ++p) { a.ph_lo = p; a.ph_hi = p + 1; hipLaunchKernelGGL(mk_fwd, dim3(grid), dim3(NWAVES * 64), LDS_BYTES, stream, a); }
#else
    a.ph_lo = 0; a.ph_hi = NPHASE;
    hipLaunchKernelGGL(mk_fwd, dim3(grid), dim3(NWAVES * 64), LDS_BYTES, stream, a);
#endif
    const hipError_t le = hipPeekAtLastError();
    if (le != hipSuccess) fprintf(stderr, "kernel_launch: launch failed: %s\n", hipGetErrorName(le));
}
```
